# Optimizing an MI355X kernel written in HIP

```python
import math
import jax, jax.numpy as jnp
from jax import lax
import numpy as np

D_MODEL = 1024
BATCH = 16
SEQ = 4096
DEPTH = 2

CHUNK = 64
QBLK = 128
MEM_LEN = 256
BRANCH_WIDTH = D_MODEL // 2
SB_HEAD_DIM = 64
SB_HEADS = BRANCH_WIDTH // SB_HEAD_DIM
DIFF_HEAD_DIM = 64
DIFF_HEADS = BRANCH_WIDTH // (2 * DIFF_HEAD_DIM)
MEM_HEAD_DIM = 128
MEM_HEADS = BRANCH_WIDTH // MEM_HEAD_DIM
N_BRANCHES = 3
IN_WIDTH = 7 * BRANCH_WIDTH + N_BRANCHES * D_MODEL
NUM_BUCKETS = 32
MAX_DISTANCE = 128
N_EXPERTS = 32
TOP_K = 4
D_FF = D_MODEL
SWIGLU_LIMIT = 7.0
SWIGLU_ALPHA = 1.702
LN_EPS = 1e-5
RMS_EPS = 1e-5
DEEPNORM_ALPHA = (2 * DEPTH) ** 0.25
DEEPNORM_BETA = (8 * DEPTH) ** -0.25

kernel_name = "hybrid_stickbreak_diffattn_memxattn_moe_deepnorm"

F32 = jnp.float32


def _layer_norm(x, g, b):
    xf = x.astype(F32)
    mu = jnp.mean(xf, axis=-1, keepdims=True)
    xc = xf - mu
    var = jnp.mean(xc * xc, axis=-1, keepdims=True)
    return (xc * lax.rsqrt(var + LN_EPS) * g.astype(F32) + b.astype(F32)).astype(x.dtype)


def _t5_bucket(rel):
    half = NUM_BUCKETS // 2
    max_exact = half // 2
    n = jnp.abs(rel)
    nf = jnp.maximum(n, 1).astype(F32)
    large = max_exact + (jnp.log(nf / max_exact) / math.log(MAX_DISTANCE / max_exact)
                         * (half - max_exact)).astype(jnp.int32)
    large = jnp.minimum(large, half - 1)
    return jnp.where(rel > 0, half, 0) + jnp.where(n < max_exact, n, large)


def _query_blocks(q):
    B, S, H, d = q.shape
    return q.astype(F32).reshape(B, S // QBLK, QBLK, H, d).transpose(1, 0, 3, 2, 4)


def _unblock(o):
    nb, B, Q, H, e = o.shape
    return o.transpose(1, 0, 2, 3, 4).reshape(B, nb * Q, H, e)


def _stick_breaking_attention(q, k, v):
    B, S = q.shape[:2]
    nb = S // QBLK
    kf, vf = k.astype(F32), v.astype(F32)
    kpos = jnp.arange(S)
    scale = SB_HEAD_DIM ** -0.5

    def block(args):
        qblk, i = args
        t = i * QBLK + jnp.arange(QBLK)
        z = jnp.einsum('bhqd,bshd->bhqs', qblk, kf) * scale
        earlier = kpos[None, :] < t[:, None]
        log_1mb = jnp.where(earlier, jax.nn.log_sigmoid(-z), 0.0)
        between = lax.cumsum(log_1mb, axis=3, reverse=True) - log_1mb
        a = jnp.where(earlier, jnp.exp(jax.nn.log_sigmoid(z) + between), 0.0)
        return jnp.einsum('bhqs,bshd->bqhd', a, vf)

    o = _unblock(lax.map(block, (_query_blocks(q), jnp.arange(nb))))
    return o.reshape(B, S, BRANCH_WIDTH).astype(q.dtype)


def _diff_attention(q, k, v, lam, lam_init, subln_g, rel_bias):
    B, S = q.shape[:2]
    nb = S // QBLK
    kf, vf = k.astype(F32), v.astype(F32)
    kpos = jnp.arange(S)
    table = rel_bias.astype(F32)
    scale = DIFF_HEAD_DIM ** -0.5

    def block(args):
        qblk, i = args
        t = i * QBLK + jnp.arange(QBLK)
        bias = table[_t5_bucket(kpos[None, :] - t[:, None])].transpose(2, 0, 1)
        logits = jnp.einsum('bhqd,bshd->bhqs', qblk, kf) * scale + bias
        visible = (kpos[None, :] // CHUNK) <= (t[:, None] // CHUNK)
        p = jax.nn.softmax(jnp.where(visible, logits, -jnp.inf), axis=-1)
        p = p.reshape(B, DIFF_HEADS, 2, QBLK, S)
        a = p[:, :, 0] - lam * p[:, :, 1]
        return jnp.einsum('bhqs,bshe->bqhe', a, vf)

    o = _unblock(lax.map(block, (_query_blocks(q), jnp.arange(nb))))
    o = o * lax.rsqrt(jnp.mean(o * o, axis=-1, keepdims=True) + RMS_EPS) * subln_g.astype(F32)
    return (o * (1.0 - lam_init)).reshape(B, S, BRANCH_WIDTH).astype(q.dtype)


def _memory_attention(q, mem_k, mem_v):
    B, S = q.shape[:2]
    logits = jnp.einsum('bshd,bmhd->bhsm', q.astype(F32), mem_k.astype(F32)) * MEM_HEAD_DIM ** -0.5
    p = jax.nn.softmax(logits, axis=-1)
    o = jnp.einsum('bhsm,bmhd->bshd', p, mem_v.astype(F32))
    return o.reshape(B, S, BRANCH_WIDTH).astype(q.dtype)


def _mixer(x, mem, w_in, b_gate, diff_lambda, diff_subln_g, rel_bias, w_mem_kv, w_branch, w_out, layer_idx):
    B, S, _ = x.shape
    W = BRANCH_WIDTH
    proj = x @ w_in
    sb_q, sb_k, sb_v, df_q, df_k, df_v, mem_q = [proj[..., i * W:(i + 1) * W] for i in range(7)]
    gates = jax.nn.sigmoid((proj[..., 7 * W:] + b_gate).astype(F32)).astype(x.dtype)
    gates = gates.reshape(B, S, N_BRANCHES, D_MODEL)

    hd = (B, S, SB_HEADS, SB_HEAD_DIM)
    y_sb = _stick_breaking_attention(sb_q.reshape(hd), sb_k.reshape(hd), sb_v.reshape(hd))

    lam_init = 0.8 - 0.6 * math.exp(-0.3 * layer_idx)
    lf = diff_lambda.astype(F32)
    lam = jnp.exp(jnp.sum(lf[0] * lf[1])) - jnp.exp(jnp.sum(lf[2] * lf[3])) + lam_init
    qk_shape = (B, S, 2 * DIFF_HEADS, DIFF_HEAD_DIM)
    y_df = _diff_attention(df_q.reshape(qk_shape), df_k.reshape(qk_shape),
                           df_v.reshape(B, S, DIFF_HEADS, 2 * DIFF_HEAD_DIM),
                           lam, lam_init, diff_subln_g, rel_bias)

    M = mem.shape[1]
    mem_kv = mem @ w_mem_kv
    mem_k = mem_kv[..., :W].reshape(B, M, MEM_HEADS, MEM_HEAD_DIM)
    mem_v = mem_kv[..., W:].reshape(B, M, MEM_HEADS, MEM_HEAD_DIM)
    y_mem = _memory_attention(mem_q.reshape(B, S, MEM_HEADS, MEM_HEAD_DIM), mem_k, mem_v)

    merged = (gates[:, :, 0] * (y_sb @ w_branch[0])
              + gates[:, :, 1] * (y_df @ w_branch[1])
              + gates[:, :, 2] * (y_mem @ w_branch[2]))
    return merged @ w_out


def _moe(x, router_w, router_b, w_gate_up, b_gate_up, w_down, b_down):
    B, S, D = x.shape
    xt = x.reshape(B * S, D)
    logits = (xt @ router_w).astype(F32) + router_b.astype(F32)
    top_val, top_idx = lax.top_k(logits, TOP_K)
    top_w = jax.nn.softmax(top_val, axis=-1)
    combine = jnp.einsum('tk,tke->et', top_w,
                         jax.nn.one_hot(top_idx, N_EXPERTS, dtype=F32)).astype(x.dtype)

    def expert(acc, p):
        wgu, bgu, wd, bd, c = p
        h = xt @ wgu + bgu
        gate = jnp.minimum(h[:, :D_FF], SWIGLU_LIMIT)
        up = jnp.clip(h[:, D_FF:], -SWIGLU_LIMIT, SWIGLU_LIMIT)
        y = ((up + 1.0) * (gate * jax.nn.sigmoid(SWIGLU_ALPHA * gate))) @ wd + bd
        return acc + c[:, None] * y, None

    out, _ = lax.scan(expert, jnp.zeros_like(xt), (w_gate_up, b_gate_up, w_down, b_down, combine))
    return out.reshape(B, S, D)


def setup_inputs(seed: int = 0) -> dict:
    key = jax.random.key(seed)
    ks = jax.random.split(key, 20)
    L = DEPTH
    W = BRANCH_WIDTH

    def nrm(k, shape, scale):
        return jax.random.normal(k, shape, F32) * scale

    return {
        "x": nrm(ks[0], (BATCH, SEQ, D_MODEL), 1.0),
        "mem": nrm(ks[1], (BATCH, MEM_LEN, D_MODEL), 1.0),
        "w_in": nrm(ks[2], (L, D_MODEL, IN_WIDTH), D_MODEL ** -0.5),
        "b_gate": nrm(ks[3], (L, N_BRANCHES * D_MODEL), 0.1),
        "diff_lambda": nrm(ks[4], (L, 4, DIFF_HEAD_DIM), 0.1),
        "diff_subln_g": 1.0 + nrm(ks[5], (L, 2 * DIFF_HEAD_DIM), 0.02),
        "rel_bias": nrm(ks[6], (NUM_BUCKETS, 2 * DIFF_HEADS), 0.5),
        "w_mem_kv": nrm(ks[7], (L, D_MODEL, 2 * W), D_MODEL ** -0.5),
        "w_branch": nrm(ks[8], (L, N_BRANCHES, W, D_MODEL), W ** -0.5),
        "w_out": nrm(ks[9], (L, D_MODEL, D_MODEL), D_MODEL ** -0.5 * DEEPNORM_BETA),
        "ln1_g": 1.0 + nrm(ks[10], (L, D_MODEL), 0.02),
        "ln1_b": nrm(ks[11], (L, D_MODEL), 0.02),
        "router_w": nrm(ks[12], (L, D_MODEL, N_EXPERTS), D_MODEL ** -0.5),
        "router_b": nrm(ks[13], (L, N_EXPERTS), 0.01),
        "w_gate_up": nrm(ks[14], (L, N_EXPERTS, D_MODEL, 2 * D_FF), D_MODEL ** -0.5),
        "b_gate_up": nrm(ks[15], (L, N_EXPERTS, 2 * D_FF), 0.02),
        "w_down": nrm(ks[16], (L, N_EXPERTS, D_FF, D_MODEL), D_FF ** -0.5 * DEEPNORM_BETA),
        "b_down": nrm(ks[17], (L, N_EXPERTS, D_MODEL), 0.02),
        "ln2_g": 1.0 + nrm(ks[18], (L, D_MODEL), 0.02),
        "ln2_b": nrm(ks[19], (L, D_MODEL), 0.02),
    }


def reference(x, mem, w_in, b_gate, diff_lambda, diff_subln_g, rel_bias, w_mem_kv, w_branch, w_out,
              ln1_g, ln1_b, router_w, router_b, w_gate_up, b_gate_up, w_down, b_down, ln2_g, ln2_b):
    for l in range(DEPTH):
        h = _mixer(x, mem, w_in[l], b_gate[l], diff_lambda[l], diff_subln_g[l], rel_bias,
                   w_mem_kv[l], w_branch[l], w_out[l], l)
        x = _layer_norm(DEEPNORM_ALPHA * x + h, ln1_g[l], ln1_b[l])
        f = _moe(x, router_w[l], router_b[l], w_gate_up[l], b_gate_up[l], w_down[l], b_down[l])
        x = _layer_norm(DEEPNORM_ALPHA * x + f, ln2_g[l], ln2_b[l])
    return x
```

```cpp
#include <hip/hip_runtime.h>
#include <cstdio>
#include <cstdint>

#ifndef DIS_MASK
#define DIS_MASK 0
#endif
#define PH_EN(k) (((DIS_MASK) >> (k) & 1) == 0)
#ifndef MK_ONE_LAUNCH
#define MK_ONE_LAUNCH 0
#endif

constexpr int BATCH = 16, SEQ = 4096, D = 1024, T = BATCH * SEQ, W = 512, INW = 6656, NE = 32, TOPK = 4, DFF = 1024, MEML = 256, MEMT = BATCH * MEML, DEPTH = 2;
constexpr int GATE0 = 7 * W;
constexpr float LN_EPS = 1e-5f, RMS_EPS = 1e-5f;
constexpr float DN_ALPHA = 1.4142135623730951f;
constexpr int NWAVES = 8;

constexpr size_t MiB = 1u << 20;
constexpr size_t WS_CTL = 0, CTL_ZERO_BYTES = 1 * MiB;
constexpr size_t WS_PERM = 2 * MiB;
constexpr size_t WS_SLOTW = 10 * MiB;
constexpr size_t WS_WIN = 16 * MiB;
constexpr size_t WS_WMEMKV = 42 * MiB;
constexpr size_t WS_WBR = 46 * MiB;
constexpr size_t WS_WOUT = 52 * MiB;
constexpr size_t WS_WGU = 56 * MiB;
constexpr size_t WS_WD = 312 * MiB;
constexpr size_t WS_MEMB = 440 * MiB;
constexpr size_t WS_MEMKV = 448 * MiB;
constexpr size_t WS_XN = 456 * MiB;
constexpr size_t WS_X1 = 584 * MiB;
constexpr size_t WS_BIG = 840 * MiB;
constexpr size_t WS_PROJ = WS_BIG;
constexpr size_t WS_Y = WS_BIG + 832 * MiB;
constexpr size_t WS_MERGED = WS_BIG + 1024 * MiB;
constexpr size_t WS_ACT = WS_BIG;
constexpr size_t WS_CONTRIB = WS_BIG + 528 * MiB;
constexpr size_t WS_END = WS_BIG + 1152 * MiB;
static_assert(WS_CONTRIB + (size_t)T * 4 * D * 2 <= WS_END && WS_MERGED + (size_t)T * D * 2 <= WS_END, "ws map");

constexpr int CW_TMO = 0, CW_CODE = 1;
constexpr int CW_BAR = 4096;
constexpr int CW_CNT = 32768;

constexpr int RING_OFF = 0, RING_BYTES = 131072;
constexpr int LDSCTL_OFF = RING_BYTES;
constexpr int LDS_BYTES = 147456;
constexpr int LW_BAR = 8;
constexpr int LW_TOFF = 64;
constexpr int LW_LCNT = 128;
constexpr int LW_RCNT = 192;
constexpr int LW_RBASE = 256;
constexpr int LW_RSLOT = 320, RSLOT_STRIDE = 256;

#define GAS __attribute__((address_space(1)))
#define LAS __attribute__((address_space(3)))
typedef unsigned short bf16;
typedef unsigned v4u __attribute__((ext_vector_type(4)));
typedef unsigned v2u __attribute__((ext_vector_type(2)));
typedef float f32x4 __attribute__((ext_vector_type(4)));
typedef float f32x2 __attribute__((ext_vector_type(2)));
typedef short bf16x8 __attribute__((ext_vector_type(8)));
typedef GAS unsigned gu32;
#define RLX_AGENT __ATOMIC_RELAXED, __HIP_MEMORY_SCOPE_AGENT
#define LDS_WAIT() asm volatile("s_waitcnt lgkmcnt(0)" ::: "memory")
#define VM_WAIT() asm volatile("s_waitcnt vmcnt(0)" ::: "memory")

__device__ __forceinline__ unsigned f2bf(float f) { unsigned u = __builtin_bit_cast(unsigned, f); return (u + 0x7fffu + ((u >> 16) & 1u)) >> 16; }
__device__ __forceinline__ unsigned pk2(float lo, float hi) { return f2bf(lo) | (f2bf(hi) << 16); }
__device__ __forceinline__ float bflo(unsigned w) { return __uint_as_float(w << 16); }
__device__ __forceinline__ float bfhi(unsigned w) { return __uint_as_float(w & 0xffff0000u); }
__device__ __forceinline__ float bf2f(bf16 b) { return __uint_as_float((unsigned)b << 16); }
__device__ __forceinline__ float fast_exp(float x) { return __builtin_amdgcn_exp2f(x * 1.4426950408889634f); }
__device__ __forceinline__ float fast_sigmoid(float x) { return __builtin_amdgcn_rcpf(1.0f + fast_exp(-x)); }

namespace pg8 {
#define PG8_LAS __attribute__((address_space(3)))
typedef unsigned short bf16_t;
typedef unsigned u32x4 __attribute__((ext_vector_type(4)));
constexpr int BM = 256, BK = 64, HALF = 128, HTB = HALF * BK * 2, STAGE_BYTES = 8 * HTB, NXCD = 8, WGM = 8;

__host__ __device__ __forceinline__ int lds_byte(int r, int c) { const int st = (r >> 4) * 2 + (c >> 5), rr = r & 15, cc = c & 31, ob = rr * 64 + cc * 2; return st * 1024 + (ob ^ (((ob >> 9) & 1) << 5)); }
__host__ __device__ __forceinline__ void stage_rc(int b, int& R, int& C) { const int st = b / 1024, sb = b % 1024, swz = sb ^ (((sb >> 9) & 1) << 5); R = (st >> 1) * 16 + swz / 64; C = (st & 1) * 32 + (swz % 64) / 2; }
__host__ __device__ __forceinline__ int perm32(int rho) { const int n = rho >> 4, i = rho & 15; return 8 * (i >> 2) + 4 * n + (i & 3); }

struct Unit { int pm, pn, e, rt; };

__device__ __forceinline__ bool tile_order(long L, int nM, int nN, int& pm, int& pn) {
    const int nwg = nM * nN; if (L >= nwg) return false;
    int wgid = (int)L; { const int q = nwg / NXCD, r = nwg % NXCD, xcd = wgid % NXCD, off = wgid / NXCD; wgid = (xcd < r ? xcd * (q + 1) : r * (q + 1) + (xcd - r) * q) + off; }
    const int nig = WGM * nN, gid = wgid / nig, fm = gid * WGM, gsz = (nM - fm) < WGM ? (nM - fm) : WGM;
    pm = fm + ((wgid % nig) % gsz); pn = (wgid % nig) / gsz; return true;
}

__device__ __forceinline__ unsigned cvt_pk_bf16(float lo, float hi) { unsigned r; asm volatile("v_cvt_pk_bf16_f32 %0, %1, %2" : "=v"(r) : "v"(lo), "v"(hi)); return r; }

template <class Epi, class Sched, bool GATHER, bool ALIGN_EPI>
__device__ __forceinline__ void gemm_phase(PG8_LAS unsigned char* lds, const int K, const Sched& S, const Epi& E) {
    int tid = threadIdx.x; asm volatile("" : "+v"(tid));
    const int wid = __builtin_amdgcn_readfirstlane(tid >> 6), lane = tid & 63, wr = wid >> 2, wc = wid & 3, fr = lane & 15, fq = lane >> 4;
    const int nt = K / BK;
    unsigned voffA[2], voffB[2]; int gR[2], gC[2];
#pragma unroll
    for (int i = 0; i < 2; ++i) { int R, C; stage_rc(tid * 16 + i * 8192, R, C); const int Rb = Epi::PERM ? ((R & ~31) + perm32(R & 31)) : R;
        voffA[i] = (unsigned)(R * K + C) * 2u; voffB[i] = (unsigned)(Rb * K + C) * 2u; gR[i] = R; gC[i] = C * 2; }
    const size_t kstep = (size_t)(BK * 2);
    const size_t hstep = (size_t)HALF * K * 2;
    const unsigned ldsw = (unsigned)wid * 1024u;
    const int aoff = lds_byte(wr * 64 + fr, fq * 8), boff = lds_byte(wc * 32 + fr, fq * 8);
#define PG8_SA(b, h) (((b) * 2 + (h)) * HTB)
#define PG8_SB(b, h) ((4 + (b) * 2 + (h)) * HTB)
#define PG8_STAGE(bufoff, gbase, voff) do { _Pragma("unroll") for (int _i = 0; _i < 2; ++_i) \
        __builtin_amdgcn_global_load_lds((const unsigned*)((const char*)(gbase) + (voff)[_i]), (PG8_LAS unsigned*)(lds + (bufoff) + ldsw + _i * 8192), 16, 0, 0); } while (0)
#define PG8_STAGE_A(bufoff, kptr, h, G) do { if constexpr (GATHER) { PG8_STAGE(bufoff, kptr, (G)[h]); } else { PG8_STAGE(bufoff, (kptr) + (h) * hstep, voffA); } } while (0)
#define PG8_LDA(dst, b, h) do { _Pragma("unroll") for (int m = 0; m < 4; ++m) _Pragma("unroll") for (int k = 0; k < 2; ++k) dst[m][k] = *(const PG8_LAS bf16x8*)(lds + PG8_SA(b, h) + aoff + m * 2048 + k * 1024); } while (0)
#define PG8_LDB(dst, b, h) do { _Pragma("unroll") for (int n = 0; n < 2; ++n) _Pragma("unroll") for (int k = 0; k < 2; ++k) dst[n][k] = *(const PG8_LAS bf16x8*)(lds + PG8_SB(b, h) + boff + n * 2048 + k * 1024); } while (0)
#define PG8_MMA(ai, bj, At, Bt) do { __builtin_amdgcn_s_setprio(1); _Pragma("unroll") for (int m = 0; m < 4; ++m) _Pragma("unroll") for (int n = 0; n < 2; ++n) _Pragma("unroll") for (int k = 0; k < 2; ++k) \
        acc[ai][bj][m][n] = __builtin_amdgcn_mfma_f32_16x16x32_bf16(Bt[n][k], At[m][k], acc[ai][bj][m][n], 0, 0, 0); __builtin_amdgcn_s_setprio(0); } while (0)
#define PG8_WAIT_V(n) asm volatile("s_waitcnt vmcnt(" #n ")" ::: "memory")
#define PG8_WAIT_L(n) asm volatile("s_waitcnt lgkmcnt(" #n ")" ::: "memory")
#define PG8_BAR __builtin_amdgcn_s_barrier()
#define PG8_SCHED __builtin_amdgcn_sched_barrier(0)
    Unit cur, nxt; int ui = 0;
    if (!S.next(0, cur)) return;
    f32x4 acc[2][2][4][2];
#pragma unroll
    for (int a = 0; a < 2; ++a)
#pragma unroll
        for (int b = 0; b < 2; ++b)
#pragma unroll
            for (int m = 0; m < 4; ++m)
#pragma unroll
                for (int n = 0; n < 2; ++n) acc[a][b][m][n] = (f32x4){0.f, 0.f, 0.f, 0.f};
    bf16x8 At[4][2], B0[2][2], B1[2][2];
    unsigned cG[2][2] = {{0u, 0u}, {0u, 0u}}, nG[2][2] = {{0u, 0u}, {0u, 0u}}, sG[2][2] = {{0u, 0u}, {0u, 0u}};
    if constexpr (GATHER) S.gather(cur, gR, gC, K, cG);
    if constexpr (GATHER) asm volatile("" : "+v"(cG[0][0]), "+v"(cG[0][1]), "+v"(cG[1][0]), "+v"(cG[1][1]));
    const char* cA = S.a_base(cur); const char* cB = S.b_base(cur);
    PG8_STAGE(PG8_SB(0, 0), cB, voffB); PG8_STAGE(PG8_SB(0, 1), cB + hstep, voffB); PG8_STAGE_A(PG8_SA(0, 0), cA, 0, cG); PG8_STAGE_A(PG8_SA(0, 1), cA, 1, cG);
    if (wr == 1) PG8_BAR;
    PG8_WAIT_V(2); PG8_BAR;
    PG8_STAGE(PG8_SB(1, 0), cB + kstep, voffB); PG8_STAGE_A(PG8_SA(1, 0), cA + kstep, 0, cG); PG8_STAGE(PG8_SB(1, 1), cB + hstep + kstep, voffB);
    PG8_WAIT_V(6); PG8_BAR;
    for (;;) {
        const bool has_next = S.next(ui + 1, nxt);
        const char* nA = has_next ? S.a_base(nxt) : cA; const char* nB = has_next ? S.b_base(nxt) : cB;
        if constexpr (GATHER) { if (has_next) S.gather(nxt, gR, gC, K, nG); else { nG[0][0] = cG[0][0]; nG[0][1] = cG[0][1]; nG[1][0] = cG[1][0]; nG[1][1] = cG[1][1]; } }
        if constexpr (GATHER) asm volatile("" : "+v"(nG[0][0]), "+v"(nG[0][1]), "+v"(nG[1][0]), "+v"(nG[1][1]));
        for (int t = 0; t < nt; t += 2) {
            const bool last = (t == nt - 2);
            const char* a1 = cA + (size_t)(t + 1) * kstep;
            const char* a2 = last ? nA : cA + (size_t)(t + 2) * kstep; const char* b2 = last ? nB : cB + (size_t)(t + 2) * kstep;
            const char* a3 = a2 + kstep; const char* b3 = b2 + kstep;
            if constexpr (GATHER) { sG[0][0] = last ? nG[0][0] : cG[0][0]; sG[0][1] = last ? nG[0][1] : cG[0][1]; sG[1][0] = last ? nG[1][0] : cG[1][0]; sG[1][1] = last ? nG[1][1] : cG[1][1]; }
            PG8_LDB(B0, 0, 0); PG8_LDB(B1, 0, 1); PG8_SCHED; PG8_LDA(At, 0, 0); PG8_STAGE_A(PG8_SA(1, 1), a1, 1, cG);
            PG8_WAIT_V(8); PG8_WAIT_L(0); PG8_BAR; PG8_MMA(0, 0, At, B0); PG8_MMA(0, 1, At, B1); PG8_BAR; PG8_SCHED;
            PG8_LDA(At, 0, 1); PG8_STAGE(PG8_SB(0, 0), b2, voffB); PG8_STAGE(PG8_SB(0, 1), b2 + hstep, voffB); PG8_STAGE_A(PG8_SA(0, 0), a2, 0, sG);
            PG8_WAIT_V(8); PG8_WAIT_L(0); PG8_BAR; PG8_MMA(1, 0, At, B0); PG8_MMA(1, 1, At, B1); PG8_BAR; PG8_SCHED;
            PG8_LDB(B0, 1, 0); PG8_LDB(B1, 1, 1); PG8_SCHED; PG8_LDA(At, 1, 0); PG8_STAGE_A(PG8_SA(0, 1), a2, 1, sG);
            PG8_WAIT_V(8); PG8_WAIT_L(0); PG8_BAR; PG8_MMA(0, 0, At, B0); PG8_MMA(0, 1, At, B1); PG8_BAR; PG8_SCHED;
            PG8_LDA(At, 1, 1); PG8_STAGE(PG8_SB(1, 0), b3, voffB); PG8_STAGE(PG8_SB(1, 1), b3 + hstep, voffB); PG8_STAGE_A(PG8_SA(1, 0), a3, 0, sG);
            PG8_WAIT_V(8); PG8_WAIT_L(0); PG8_BAR; PG8_MMA(1, 0, At, B0); PG8_MMA(1, 1, At, B1); PG8_BAR; PG8_SCHED;
        }
        if constexpr (ALIGN_EPI) { if (wr == 0) PG8_BAR; }
        E(acc, cur, wr, wc, fr, fq);
        if constexpr (Epi::DRAIN_AFTER) __builtin_amdgcn_s_waitcnt(0x0F70);
        if (!has_next) break;
#pragma unroll
        for (int a = 0; a < 2; ++a)
#pragma unroll
            for (int b = 0; b < 2; ++b)
#pragma unroll
                for (int m = 0; m < 4; ++m)
#pragma unroll
                    for (int n = 0; n < 2; ++n) acc[a][b][m][n] = (f32x4){0.f, 0.f, 0.f, 0.f};
        cur = nxt; cA = nA; cB = nB; ++ui;
        if constexpr (GATHER) { cG[0][0] = nG[0][0]; cG[0][1] = nG[0][1]; cG[1][0] = nG[1][0]; cG[1][1] = nG[1][1]; }
        if constexpr (ALIGN_EPI) { if (wr == 1) PG8_BAR; }
    }
    PG8_WAIT_V(0);
    if constexpr (!ALIGN_EPI) { if (wr == 0) PG8_BAR; }
    PG8_BAR;
#undef PG8_SA
#undef PG8_SB
#undef PG8_STAGE
#undef PG8_STAGE_A
#undef PG8_LDA
#undef PG8_LDB
#undef PG8_MMA
#undef PG8_WAIT_V
#undef PG8_WAIT_L
#undef PG8_BAR
#undef PG8_SCHED
}

struct DenseOrder {
    const char* A; const char* Bt; int nM, nN, G, c, K;
    __device__ __forceinline__ bool next(int i, Unit& u) const { u.e = 0; u.rt = 0; return tile_order((long)i * G + c, nM, nN, u.pm, u.pn); }
    __device__ __forceinline__ const char* a_base(const Unit& u) const { return A + (size_t)u.pm * BM * K * 2; }
    __device__ __forceinline__ const char* b_base(const Unit& u) const { return Bt + (size_t)u.pn * BM * K * 2; }
};
struct BranchOrder {
    const char* Y; const char* Wb; int nM, nN, G, c;
    __device__ __forceinline__ bool next(int i, Unit& u) const { u.e = i % 3; u.rt = 0; return tile_order((long)(i / 3) * G + c, nM, nN, u.pm, u.pn); }
    __device__ __forceinline__ const char* a_base(const Unit& u) const { return Y + (size_t)u.e * T * W * 2 + (size_t)u.pm * BM * W * 2; }
    __device__ __forceinline__ const char* b_base(const Unit& u) const { return Wb + (size_t)u.e * D * W * 2 + (size_t)u.pn * BM * W * 2; }
};
struct MoeOrder {
    const char* A; const char* Wt; int nN, NT, G, c, K; size_t wstride;
    const PG8_LAS int* toff; const PG8_LAS int* lcnt; const int* perm;
    __device__ __forceinline__ bool next(int i, Unit& u) const {
        if (!tile_order((long)i * G + c, NT, nN, u.pm, u.pn)) return false;
        int e = 0;
#pragma unroll 1
        for (int j = 1; j < NE; ++j) e += (toff[j] <= u.pm) ? 1 : 0;
        u.e = e; u.rt = u.pm - toff[e]; return true;
    }
    __device__ __forceinline__ const char* a_base(const Unit& u) const { return A; }
    __device__ __forceinline__ const char* a_dense(const Unit& u) const { return A + (size_t)u.pm * BM * K * 2; }
    __device__ __forceinline__ const char* b_base(const Unit& u) const { return Wt + (size_t)u.e * wstride + (size_t)u.pn * BM * K * 2; }
    __device__ __forceinline__ void gather(const Unit& u, const int (&gR)[2], const int (&gC)[2], int K_, unsigned (&Gv)[2][2]) const {
        const int n = lcnt[u.e] - u.rt * BM; const int* p = perm + (size_t)u.e * T + u.rt * BM;
#pragma unroll
        for (int h = 0; h < 2; ++h)
#pragma unroll
            for (int i = 0; i < 2; ++i) { const int r = h * HALF + gR[i]; const int tok = (r < n) ? (p[r] >> 2) : 0; Gv[h][i] = (unsigned)tok * (unsigned)(K_ * 2) + (unsigned)gC[i]; }
    }
};
struct MoeDenseOrder : MoeOrder {
    __device__ __forceinline__ const char* a_base(const Unit& u) const { return a_dense(u); }
};

struct EpiProj {
    static constexpr bool PERM = true, DRAIN_AFTER = false;
    bf16_t* O; int ldc; const float* bias; int act_from;
    __device__ __forceinline__ void operator()(const f32x4 (&acc)[2][2][4][2], const Unit& u, int wr, int wc, int fr, int fq) const {
        const int row0 = u.pm * BM + wr * 64 + fr, colt = u.pn * BM, col0 = colt + wc * 32 + 8 * fq;
        const bool gate = colt >= act_from;
        f32x4 bv[2][2];
#pragma unroll
        for (int bj = 0; bj < 2; ++bj)
#pragma unroll
            for (int n = 0; n < 2; ++n) bv[bj][n] = gate ? *(const f32x4*)(bias + (col0 - act_from) + bj * HALF + 4 * n) : (f32x4){0.f, 0.f, 0.f, 0.f};
#pragma unroll
        for (int ai = 0; ai < 2; ++ai)
#pragma unroll
            for (int m = 0; m < 4; ++m) { bf16_t* rowp = O + (size_t)(row0 + ai * HALF + m * 16) * ldc + col0;
#pragma unroll
                for (int bj = 0; bj < 2; ++bj) { f32x4 v0 = acc[ai][bj][m][0] + bv[bj][0], v1 = acc[ai][bj][m][1] + bv[bj][1];
                    if (gate) {
#pragma unroll
                        for (int j = 0; j < 4; ++j) { v0[j] = fast_sigmoid(v0[j]); v1[j] = fast_sigmoid(v1[j]); } }
                    u32x4 w; w.x = cvt_pk_bf16(v0[0], v0[1]); w.y = cvt_pk_bf16(v0[2], v0[3]); w.z = cvt_pk_bf16(v1[0], v1[1]); w.w = cvt_pk_bf16(v1[2], v1[3]);
                    *(u32x4*)(rowp + bj * HALF) = w; } }
    }
};
struct EpiBranch {
    static constexpr bool PERM = true, DRAIN_AFTER = false;
    const bf16_t* P; bf16_t* Mg;
    __device__ __forceinline__ void operator()(const f32x4 (&acc)[2][2][4][2], const Unit& u, int wr, int wc, int fr, int fq) const {
        const int row0 = u.pm * BM + wr * 64 + fr, col0 = u.pn * BM + wc * 32 + 8 * fq; const int br = u.e;
#pragma unroll
        for (int ai = 0; ai < 2; ++ai)
#pragma unroll
            for (int m = 0; m < 4; ++m) { const size_t row = (size_t)(row0 + ai * HALF + m * 16);
                const bf16_t* gp = P + row * INW + GATE0 + br * D + col0; bf16_t* mp = Mg + row * D + col0;
#pragma unroll
                for (int bj = 0; bj < 2; ++bj) {
                    const u32x4 g = *(const u32x4*)(gp + bj * HALF); u32x4 pv = (u32x4){0u, 0u, 0u, 0u}; if (br) pv = *(const u32x4*)(mp + bj * HALF);
                    const f32x4 a0 = acc[ai][bj][m][0], a1 = acc[ai][bj][m][1];
                    u32x4 w;
                    w.x = cvt_pk_bf16(bflo(pv.x) + bflo(g.x) * a0[0], bfhi(pv.x) + bfhi(g.x) * a0[1]);
                    w.y = cvt_pk_bf16(bflo(pv.y) + bflo(g.y) * a0[2], bfhi(pv.y) + bfhi(g.y) * a0[3]);
                    w.z = cvt_pk_bf16(bflo(pv.z) + bflo(g.z) * a1[0], bfhi(pv.z) + bfhi(g.z) * a1[1]);
                    w.w = cvt_pk_bf16(bflo(pv.w) + bflo(g.w) * a1[2], bfhi(pv.w) + bfhi(g.w) * a1[3]);
                    *(u32x4*)(mp + bj * HALF) = w; } }
    }
};
struct EpiOut {
    static constexpr bool PERM = false, DRAIN_AFTER = false;
    const float* X; float* V1;
    __device__ __forceinline__ void operator()(const f32x4 (&acc)[2][2][4][2], const Unit& u, int wr, int wc, int fr, int fq) const {
        const int row0 = u.pm * BM + wr * 64 + fr, col0 = u.pn * BM + wc * 32 + 4 * fq;
#pragma unroll
        for (int ai = 0; ai < 2; ++ai)
#pragma unroll
            for (int m = 0; m < 4; ++m) { const size_t off = (size_t)(row0 + ai * HALF + m * 16) * D + col0;
#pragma unroll
                for (int bj = 0; bj < 2; ++bj)
#pragma unroll
                    for (int n = 0; n < 2; ++n) { const f32x4 xv = *(const f32x4*)(X + off + bj * HALF + n * 16); *(f32x4*)(V1 + off + bj * HALF + n * 16) = xv * DN_ALPHA + acc[ai][bj][m][n]; } }
    }
};
struct EpiGateUp {
    static constexpr bool PERM = true, DRAIN_AFTER = false;
    bf16_t* Act; const float* bgu;
    __device__ __forceinline__ void operator()(const f32x4 (&acc)[2][2][4][2], const Unit& u, int wr, int wc, int fr, int fq) const {
        const int row0 = u.pm * BM + wr * 64 + fr, c0 = u.pn * HALF + wc * 32 + 8 * fq;
        const float* bg = bgu + (size_t)u.e * 2 * DFF + c0;
        const f32x4 bg0 = *(const f32x4*)(bg), bg1 = *(const f32x4*)(bg + 4), bu0 = *(const f32x4*)(bg + DFF), bu1 = *(const f32x4*)(bg + DFF + 4);
#pragma unroll
        for (int ai = 0; ai < 2; ++ai)
#pragma unroll
            for (int m = 0; m < 4; ++m) {
                f32x4 g0 = acc[ai][0][m][0] + bg0, g1 = acc[ai][0][m][1] + bg1, u0 = acc[ai][1][m][0] + bu0, u1 = acc[ai][1][m][1] + bu1;
                float o[8];
#pragma unroll
                for (int j = 0; j < 4; ++j) {
                    const float ga = __builtin_fminf(g0[j], 7.0f), gb = __builtin_fminf(g1[j], 7.0f);
                    const float ua = __builtin_fminf(__builtin_fmaxf(u0[j], -7.0f), 7.0f), ub = __builtin_fminf(__builtin_fmaxf(u1[j], -7.0f), 7.0f);
                    o[j] = (ua + 1.0f) * (ga * fast_sigmoid(1.702f * ga)); o[4 + j] = (ub + 1.0f) * (gb * fast_sigmoid(1.702f * gb)); }
                u32x4 w; w.x = cvt_pk_bf16(o[0], o[1]); w.y = cvt_pk_bf16(o[2], o[3]); w.z = cvt_pk_bf16(o[4], o[5]); w.w = cvt_pk_bf16(o[6], o[7]);
                *(u32x4*)(Act + (size_t)(row0 + ai * HALF + m * 16) * DFF + c0) = w; }
    }
};
struct EpiDown {
    static constexpr bool PERM = true, DRAIN_AFTER = true;
    bf16_t* C; const float* bd; const int* perm; const float* slotw; const PG8_LAS int* lcnt;
    __device__ __forceinline__ void operator()(const f32x4 (&acc)[2][2][4][2], const Unit& u, int wr, int wc, int fr, int fq) const {
        const int lr0 = u.rt * BM + wr * 64 + fr, col0 = u.pn * BM + wc * 32 + 8 * fq; const int n = lcnt[u.e];
        const int* p = perm + (size_t)u.e * T;
        f32x4 bv[2][2];
#pragma unroll
        for (int bj = 0; bj < 2; ++bj)
#pragma unroll
            for (int nn = 0; nn < 2; ++nn) bv[bj][nn] = *(const f32x4*)(bd + (size_t)u.e * D + col0 + bj * HALF + 4 * nn);
#pragma unroll
        for (int ai = 0; ai < 2; ++ai)
#pragma unroll
            for (int m = 0; m < 4; ++m) { const int lr = lr0 + ai * HALF + m * 16;
                if (lr < n) { const int ts = p[lr]; const float cw = slotw[ts]; bf16_t* rowp = C + (size_t)ts * D + col0;
#pragma unroll
                    for (int bj = 0; bj < 2; ++bj) { const f32x4 v0 = (acc[ai][bj][m][0] + bv[bj][0]) * cw, v1 = (acc[ai][bj][m][1] + bv[bj][1]) * cw;
                        u32x4 w; w.x = cvt_pk_bf16(v0[0], v0[1]); w.y = cvt_pk_bf16(v0[2], v0[3]); w.z = cvt_pk_bf16(v1[0], v1[1]); w.w = cvt_pk_bf16(v1[2], v1[3]);
                        *(u32x4*)(rowp + bj * HALF) = w; } } }
    }
};
}

#define XB_TMO      128
#define XB_XCNT(j)  (256  + 64 * (j))
#define XB_XSUB(j)  (1280 + 64 * (j))
#define XB_XGEN(j)  (2304 + 64 * (j))
#define XB_TOP      3328
#define XB_TOPGEN   3392
#define XCD_BAR_WORDS 3456
#define XB_SPIN_CAP (1u << 18)
__device__ __forceinline__ unsigned xb_ld(unsigned* p)              { return __hip_atomic_load(p, __ATOMIC_RELAXED, __HIP_MEMORY_SCOPE_AGENT); }
__device__ __forceinline__ unsigned xb_add(unsigned* p, unsigned v) { return __hip_atomic_fetch_add(p, v, __ATOMIC_RELAXED, __HIP_MEMORY_SCOPE_AGENT); }
__device__ __forceinline__ unsigned xb_xcc_id() { return (unsigned)__builtin_amdgcn_s_getreg((3 << 11) | 20) & 0xFu; }
#define XB_SPIN(cond, bar) do { unsigned _sp = 0; while (cond) { __builtin_amdgcn_s_sleep(1); \
    if ((++_sp & 255u) == 0u) { if (xb_ld(&(bar)[XB_TMO])) break; if (_sp > XB_SPIN_CAP) { atomicAdd(&(bar)[XB_TMO], 1u); break; } } } } while (0)
struct XcdBarrier { unsigned* bar; unsigned x; volatile LAS unsigned* st; };
__device__ __forceinline__ XcdBarrier xcd_barrier_post(unsigned* bar, volatile LAS unsigned* st) {
    XcdBarrier b; b.bar = bar; b.x = xb_xcc_id(); b.st = st;
    if (threadIdx.x == 0) (void)xb_add(&bar[XB_XCNT(b.x)], 1u);
    return b;
}
__device__ __forceinline__ void xcd_barrier_complete(unsigned* bar, unsigned x, unsigned& nloc, unsigned& nx) {
    const unsigned G = gridDim.x * gridDim.y * gridDim.z;
    unsigned sum, cnt, mine, sp = 0u;
    for (;;) {
        sum = 0u; cnt = 0u; mine = 0u;
#pragma unroll
        for (unsigned j = 0; j < 16; ++j) { const unsigned c = xb_ld(&bar[XB_XCNT(j)]); sum += c; cnt += (c > 0u) ? 1u : 0u; mine = (j == x) ? c : mine; }
        if (sum == G) break;
        __builtin_amdgcn_s_sleep(1);
        if ((++sp & 255u) == 0u) { if (xb_ld(&bar[XB_TMO])) break; if (sp > XB_SPIN_CAP) { atomicAdd(&bar[XB_TMO], 1u); break; } }
    }
    nloc = mine > 0u ? mine : 1u; nx = cnt > 0u ? cnt : 1u;
}
__device__ __forceinline__ void xcd_barrier(const XcdBarrier& b) {
    asm volatile("s_waitcnt vmcnt(0)" ::: "memory");
    __syncthreads();
    if (threadIdx.x == 0) {
        unsigned* bar = b.bar;
        __builtin_amdgcn_s_waitcnt(0);
        unsigned nloc = b.st[0], nx = b.st[1];
        if (nloc == 0u) { xcd_barrier_complete(bar, b.x, nloc, nx); b.st[0] = nloc; b.st[1] = nx; }
        const unsigned old = xb_add(&bar[XB_XSUB(b.x)], 1u);
        const unsigned gen = old / nloc;
        if (old + 1u == (gen + 1u) * nloc) {
            __builtin_amdgcn_fence(__ATOMIC_RELEASE, "agent");
            asm volatile("s_waitcnt vmcnt(0)" ::: "memory");
            const unsigned og = xb_add(&bar[XB_TOP], 1u);
            const unsigned tg = og / nx;
            if (og + 1u == (tg + 1u) * nx) xb_add(&bar[XB_TOPGEN], 1u);
            else XB_SPIN(xb_ld(&bar[XB_TOPGEN]) == tg, bar);
            __builtin_amdgcn_fence(__ATOMIC_ACQUIRE, "agent");
            xb_add(&bar[XB_XGEN(b.x)], 1u);
            asm volatile("s_waitcnt vmcnt(0)" ::: "memory");
        } else {
            XB_SPIN(xb_ld(&bar[XB_XGEN(b.x)]) == gen, bar);
            __builtin_amdgcn_fence(__ATOMIC_ACQUIRE, "agent");
            asm volatile("s_waitcnt vmcnt(0)" ::: "memory");
        }
    }
    __syncthreads();
}

__device__ __forceinline__ float wave_sum(float v) {
#pragma unroll
    for (int o = 1; o < 64; o <<= 1) v += __shfl_xor(v, o);
    return v;
}
__device__ __forceinline__ float wave_max(float v) {
#pragma unroll
    for (int o = 1; o < 64; o <<= 1) v = __builtin_fmaxf(v, __shfl_xor(v, o));
    return v;
}
__device__ __forceinline__ int wave_min_i(int v) {
#pragma unroll
    for (int o = 1; o < 64; o <<= 1) { const int w = __shfl_xor(v, o); v = w < v ? w : v; }
    return v;
}

struct Args { const float* in[20]; float* out; unsigned char* ws; int ph_lo, ph_hi; };
typedef const __attribute__((address_space(4))) Args* KArgs;
__device__ __forceinline__ KArgs ka_opaque() { unsigned long long p = (unsigned long long)__builtin_amdgcn_kernarg_segment_ptr(); asm volatile("" : "+s"(p)); return (KArgs)p; }
__device__ __forceinline__ int tid_opaque() { int t = threadIdx.x; asm volatile("" : "+v"(t)); return t; }

__device__ __forceinline__ void p0_transpose_item(const float* Wsrc, int K, int N, bf16* WT, int drow0, int k0, int n0, LAS float* scr, int lane) {
#pragma unroll 8
    for (int i = 0; i < 32; ++i) { const int kk = 2 * i + (lane >> 5); scr[kk * 33 + (lane & 31)] = Wsrc[(size_t)(k0 + kk) * N + n0 + (lane & 31)]; }
    LDS_WAIT(); asm volatile("" ::: "memory");
    const int c = lane & 7;
#pragma unroll
    for (int j = 0; j < 4; ++j) { const int n = (lane >> 3) + 8 * j; const LAS float* s = scr + (8 * c) * 33 + n;
        v4u o; o.x = pk2(s[0 * 33], s[1 * 33]); o.y = pk2(s[2 * 33], s[3 * 33]); o.z = pk2(s[4 * 33], s[5 * 33]); o.w = pk2(s[6 * 33], s[7 * 33]);
        *(GAS v4u*)(WT + (size_t)(drow0 + n) * K + k0 + 8 * c) = o; }
    LDS_WAIT(); asm volatile("" ::: "memory");
}
__device__ __forceinline__ bool p0_matrix(int& r, const float* src, int K, int N, bf16* dst, bool gu_rows, LAS float* scr, int lane) {
    const int nblk = N / 32, items = (K / 64) * nblk;
    if (r >= items) { r -= items; return false; }
    const int kb = r / nblk, nb = r % nblk, n0 = 32 * nb;
    int drow0 = n0;
    if (gu_rows) { const int cc = (n0 >= DFF) ? n0 - DFF : n0; drow0 = (cc >> 7) * 256 + (n0 >= DFF ? 128 : 0) + (cc & 127); }
    p0_transpose_item(src, K, N, dst, drow0, 64 * kb, n0, scr, lane);
    return true;
}
__device__ __forceinline__ void row_to_bf16(const float* xrow, bf16* orow, int lane) {
    const GAS f32x4* xr = (const GAS f32x4*)xrow + lane; GAS unsigned long long* o8 = (GAS unsigned long long*)orow + lane;
#pragma unroll
    for (int j = 0; j < 4; ++j) { const f32x4 v = xr[64 * j]; o8[64 * j] = (unsigned long long)pk2(v.x, v.y) | ((unsigned long long)pk2(v.z, v.w) << 32); }
}

#define PH_LOCALS() KArgs ka = ka_opaque(); unsigned char* ws = ka->ws; const int tid = tid_opaque(), lane = tid & 63, wave = __builtin_amdgcn_readfirstlane(tid >> 6); \
    const int G = gridDim.x, bx = blockIdx.x, vcu = (G % 8 == 0) ? (bx % 8) * (G / 8) + bx / 8 : bx, gw = vcu * NWAVES + wave, NGW = G * NWAVES; \
    (void)ws; (void)lane; (void)wave; (void)gw; (void)NGW; (void)vcu; (void)bx
__global__ void __launch_bounds__(NWAVES * 64, 2) mk_fwd(Args args) {
    extern __shared__ __attribute__((aligned(16))) unsigned char lds_raw[];
    LAS unsigned char* lds = (LAS unsigned char*)lds_raw;
    volatile LAS unsigned* LW = (volatile LAS unsigned*)(lds + LDSCTL_OFF);
    for (int u = threadIdx.x; u < (LDS_BYTES - LDSCTL_OFF) / 4; u += NWAVES * 64) ((LAS unsigned*)(lds + LDSCTL_OFF))[u] = 0u;
    __syncthreads();
#if MK_ONE_LAUNCH
    XcdBarrier bar = xcd_barrier_post((unsigned*)((gu32*)(args.ws + WS_CTL) + CW_BAR), LW + LW_BAR);
#define GRID_BAR() xcd_barrier(bar)
#else
#define GRID_BAR() do {} while (0)
#endif
    const int lo = args.ph_lo, hi = args.ph_hi;
#define IN(k) (lo <= (k) && (k) < hi)
#define BOTH(k) (IN(k) && IN((k) + 1))

    if (PH_EN(0) && IN(0)) {
        PH_LOCALS();
        LAS float* scr = (LAS float*)(lds + RING_OFF + wave * 16384);
        constexpr int I_IN = 16 * (INW / 32), I_SQ = 16 * 32, I_BR = 8 * 32, I_GU = 16 * 64, I_D = 16 * 32;
        constexpr int PER_LAYER = I_IN + I_SQ + 3 * I_BR + I_SQ + NE * I_GU + NE * I_D;
#pragma unroll 1
        for (int it = gw; it < DEPTH * PER_LAYER; it += NGW) {
            const int l = it / PER_LAYER; int r = it % PER_LAYER;
            if (p0_matrix(r, ka->in[2] + (size_t)l * D * INW, D, INW, (bf16*)(ws + WS_WIN) + (size_t)l * INW * D, false, scr, lane)) continue;
            if (p0_matrix(r, ka->in[7] + (size_t)l * D * 1024, D, 1024, (bf16*)(ws + WS_WMEMKV) + (size_t)l * 1024 * D, false, scr, lane)) continue;
            if (r < 3 * I_BR) { const int b = r / I_BR; int rr = r % I_BR;
                p0_matrix(rr, ka->in[8] + ((size_t)l * 3 + b) * W * D, W, D, (bf16*)(ws + WS_WBR) + ((size_t)l * 3 + b) * D * W, false, scr, lane); continue; }
            r -= 3 * I_BR;
            if (p0_matrix(r, ka->in[9] + (size_t)l * D * D, D, D, (bf16*)(ws + WS_WOUT) + (size_t)l * D * D, false, scr, lane)) continue;
            if (r < NE * I_GU) { const int e = r / I_GU; int rr = r % I_GU;
                p0_matrix(rr, ka->in[14] + ((size_t)l * NE + e) * D * 2 * DFF, D, 2 * DFF, (bf16*)(ws + WS_WGU) + ((size_t)l * NE + e) * 2 * DFF * D, true, scr, lane); continue; }
            r -= NE * I_GU;
            { const int e = r / I_D; int rr = r % I_D;
                p0_matrix(rr, ka->in[16] + ((size_t)l * NE + e) * DFF * D, DFF, D, (bf16*)(ws + WS_WD) + ((size_t)l * NE + e) * D * DFF, false, scr, lane); }
        }
        { const float* x_in = ka->in[0]; bf16* XN = (bf16*)(ws + WS_XN);
#pragma unroll 1
          for (int m = gw; m < T; m += NGW) row_to_bf16(x_in + (size_t)m * D, XN + (size_t)m * D, lane); }
        { const float* mem_in = ka->in[1]; bf16* MEMB = (bf16*)(ws + WS_MEMB);
#pragma unroll 1
          for (int m = gw; m < MEMT; m += NGW) row_to_bf16(mem_in + (size_t)m * D, MEMB + (size_t)m * D, lane); }
        if (BOTH(0)) GRID_BAR();
    }

#pragma unroll 1
    for (int l = 0; l < DEPTH; ++l) {
        const int pb = 1 + 8 * l;
        if (PH_EN(1) && IN(pb + 0)) {
            { PH_LOCALS();
              pg8::DenseOrder S{(const char*)(ws + WS_XN), (const char*)((bf16*)(ws + WS_WIN) + (size_t)l * INW * D), T / 256, INW / 256, G, bx, D};
              pg8::EpiProj E{(bf16*)(ws + WS_PROJ), INW, ka->in[3] + (size_t)l * 3 * D, GATE0};
              pg8::gemm_phase<pg8::EpiProj, pg8::DenseOrder, false, true>(lds + RING_OFF, D, S, E); }
            { PH_LOCALS();
              pg8::DenseOrder S{(const char*)(ws + WS_MEMB), (const char*)((bf16*)(ws + WS_WMEMKV) + (size_t)l * 1024 * D), MEMT / 256, 1024 / 256, G, bx, D};
              pg8::EpiProj E{(bf16*)(ws + WS_MEMKV), 1024, nullptr, 1 << 30};
              pg8::gemm_phase<pg8::EpiProj, pg8::DenseOrder, false, true>(lds + RING_OFF, D, S, E); }
            if (BOTH(pb + 0)) GRID_BAR();
        }
        if (PH_EN(2) && IN(pb + 1)) {
            if (BOTH(pb + 1)) GRID_BAR();
        }
        if (PH_EN(3) && IN(pb + 2)) {
            PH_LOCALS();
            pg8::BranchOrder S{(const char*)(ws + WS_Y), (const char*)((bf16*)(ws + WS_WBR) + (size_t)l * 3 * D * W), T / 256, D / 256, G, bx};
            pg8::EpiBranch E{(const bf16*)(ws + WS_PROJ), (bf16*)(ws + WS_MERGED)};
            pg8::gemm_phase<pg8::EpiBranch, pg8::BranchOrder, false, true>(lds + RING_OFF, W, S, E);
            if (BOTH(pb + 2)) GRID_BAR();
        }
        if (PH_EN(4) && IN(pb + 3)) {
            PH_LOCALS();
            const float* xprev = (l == 0) ? ka->in[0] : ka->out;
            pg8::DenseOrder S{(const char*)(ws + WS_MERGED), (const char*)((bf16*)(ws + WS_WOUT) + (size_t)l * D * D), T / 256, D / 256, G, bx, D};
            pg8::EpiOut E{xprev, (float*)(ws + WS_X1)};
            pg8::gemm_phase<pg8::EpiOut, pg8::DenseOrder, false, true>(lds + RING_OFF, D, S, E);
            if (BOTH(pb + 3)) GRID_BAR();
        }
        if (PH_EN(5) && IN(pb + 4)) {
            PH_LOCALS();
            gu32* ctl = (gu32*)(ws + WS_CTL); float* X1 = (float*)(ws + WS_X1); bf16* XN = (bf16*)(ws + WS_XN); int* PERM = (int*)(ws + WS_PERM); float* SLOTW = (float*)(ws + WS_SLOTW);
            LAS float* WT = (LAS float*)(lds + RING_OFF);
            const float* rw = ka->in[12] + (size_t)l * D * NE; const float* rb = ka->in[13] + (size_t)l * NE;
            for (int i = tid; i < D * NE; i += NWAVES * 64) { const int k = i >> 5, e = i & 31; WT[e * D + k] = rw[i]; }
            if (tid < NE) LW[LW_RCNT + tid] = 0u;
            __syncthreads();
            const float* g1 = ka->in[10] + (size_t)l * D; const float* b1 = ka->in[11] + (size_t)l * D;
            f32x4 gv[4], bv[4];
#pragma unroll
            for (int j = 0; j < 4; ++j) { gv[j] = *(const f32x4*)(g1 + 256 * j + 4 * lane); bv[j] = *(const f32x4*)(b1 + 256 * j + 4 * lane); }
            const int rows_per_wg = (T + G - 1) / G, rows_per_wave = (rows_per_wg + NWAVES - 1) / NWAVES;
            const int rbase = vcu * rows_per_wg + wave * rows_per_wave;
            const float myrb = rb[(lane >> 1) & 31];
#pragma unroll 1
            for (int ri = 0; ri < rows_per_wave; ++ri) {
                const int m = rbase + ri; if (m >= T || (wave * rows_per_wave + ri) >= rows_per_wg) break;
                GAS f32x4* xr = (GAS f32x4*)(X1 + (size_t)m * D) + lane;
                f32x4 v[4]; float s = 0.f;
#pragma unroll
                for (int j = 0; j < 4; ++j) { v[j] = xr[64 * j]; s += (v[j].x + v[j].y) + (v[j].z + v[j].w); }
                const float mean = wave_sum(s) * (1.f / D); float s2 = 0.f;
#pragma unroll
                for (int j = 0; j < 4; ++j) { v[j] = v[j] - mean; s2 += (v[j].x * v[j].x + v[j].y * v[j].y) + (v[j].z * v[j].z + v[j].w * v[j].w); }
                const float rstd = 1.f / sqrtf(wave_sum(s2) * (1.f / D) + LN_EPS);
                GAS unsigned long long* o8 = (GAS unsigned long long*)(XN + (size_t)m * D) + lane;
#pragma unroll
                for (int j = 0; j < 4; ++j) { v[j] = v[j] * rstd * gv[j] + bv[j]; xr[64 * j] = v[j];
                    o8[64 * j] = (unsigned long long)pk2(v[j].x, v[j].y) | ((unsigned long long)pk2(v[j].z, v[j].w) << 32); }
                float p[NE];
#pragma unroll
                for (int e = 0; e < NE; ++e) { float a = 0.f;
#pragma unroll
                    for (int j = 0; j < 4; ++j) { const f32x4 w = *(const LAS f32x4*)(WT + e * D + 256 * j + 4 * lane); a += (v[j].x * w.x + v[j].y * w.y) + (v[j].z * w.z + v[j].w * w.w); }
                    p[e] = a; }
#pragma unroll
                for (int e = 0; e < 16; ++e) { const bool up = (lane & 32) != 0; const float keep = up ? p[e + 16] : p[e], send = up ? p[e] : p[e + 16]; p[e] = keep + __shfl_xor(send, 32); }
#pragma unroll
                for (int e = 0; e < 8; ++e) { const bool up = (lane & 16) != 0; const float keep = up ? p[e + 8] : p[e], send = up ? p[e] : p[e + 8]; p[e] = keep + __shfl_xor(send, 16); }
#pragma unroll
                for (int e = 0; e < 4; ++e) { const bool up = (lane & 8) != 0; const float keep = up ? p[e + 4] : p[e], send = up ? p[e] : p[e + 4]; p[e] = keep + __shfl_xor(send, 8); }
#pragma unroll
                for (int e = 0; e < 2; ++e) { const bool up = (lane & 4) != 0; const float keep = up ? p[e + 2] : p[e], send = up ? p[e] : p[e + 2]; p[e] = keep + __shfl_xor(send, 4); }
                { const bool up = (lane & 2) != 0; const float keep = up ? p[1] : p[0], send = up ? p[0] : p[1]; p[0] = keep + __shfl_xor(send, 2); }
                float logit = p[0] + __shfl_xor(p[0], 1) + myrb;
                const int myexp = (lane >> 1) & 31;
                float tv[TOPK]; int te[TOPK];
#pragma unroll
                for (int k = 0; k < TOPK; ++k) { const float mx = wave_max(logit); const int cand = (logit == mx) ? myexp : 99; const int em = wave_min_i(cand); tv[k] = mx; te[k] = em; if (myexp == em) logit = -INFINITY; }
                float ew[TOPK], es = 0.f;
#pragma unroll
                for (int k = 0; k < TOPK; ++k) { ew[k] = fast_exp(tv[k] - tv[0]); es += ew[k]; }
                const float inv = 1.0f / es;
                if (lane < TOPK) {
                    const int ek = lane == 0 ? te[0] : lane == 1 ? te[1] : lane == 2 ? te[2] : te[3];
                    const float wk = (lane == 0 ? ew[0] : lane == 1 ? ew[1] : lane == 2 ? ew[2] : ew[3]) * inv;
                    const unsigned lr = __hip_atomic_fetch_add((LAS unsigned*)(LW + LW_RCNT + ek), 1u, __ATOMIC_RELAXED, __HIP_MEMORY_SCOPE_WORKGROUP);
                    LW[LW_RSLOT + wave * RSLOT_STRIDE + ri * 4 + lane] = ((unsigned)ek << 16) | lr;
                    SLOTW[(size_t)m * 4 + lane] = wk;
                }
            }
            __syncthreads();
            if (tid < NE) { const unsigned c = LW[LW_RCNT + tid]; LW[LW_RBASE + tid] = c ? __hip_atomic_fetch_add(ctl + CW_CNT + (l * NE + tid) * 64, c, RLX_AGENT) : 0u; }
            __syncthreads();
            for (int q = lane; q < rows_per_wave * 4; q += 64) { const int ri = q >> 2, m = rbase + ri;
                if (m < T && (wave * rows_per_wave + ri) < rows_per_wg) { const unsigned ent = LW[LW_RSLOT + wave * RSLOT_STRIDE + q]; const unsigned e = ent >> 16, lr = ent & 0xffffu;
                    PERM[(size_t)e * T + LW[LW_RBASE + e] + lr] = m * 4 + (q & 3); } }
            if (BOTH(pb + 4)) GRID_BAR();
        }
        if ((PH_EN(6) && IN(pb + 5)) || (PH_EN(7) && IN(pb + 6))) {
            PH_LOCALS();
            gu32* ctl = (gu32*)(ws + WS_CTL);
            __syncthreads();
            if (tid == 0) { int acc_t = 0;
                for (int e = 0; e < NE; ++e) { const int c = (int)__hip_atomic_load(ctl + CW_CNT + (l * NE + e) * 64, RLX_AGENT); LW[LW_LCNT + e] = (unsigned)c; LW[LW_TOFF + e] = (unsigned)acc_t; acc_t += (c + 255) >> 8; }
                LW[LW_TOFF + NE] = (unsigned)acc_t; }
            __syncthreads();
        }
        if (PH_EN(6) && IN(pb + 5)) {
            PH_LOCALS();
            const LAS int* toff = (const LAS int*)(lds + LDSCTL_OFF) + LW_TOFF; const LAS int* lcnt = (const LAS int*)(lds + LDSCTL_OFF) + LW_LCNT;
            pg8::MoeOrder S{(const char*)(ws + WS_XN), (const char*)((bf16*)(ws + WS_WGU) + (size_t)l * NE * 2 * DFF * D), 2 * DFF / 256, toff[NE], G, bx, D, (size_t)2 * DFF * D * 2, toff, lcnt, (const int*)(ws + WS_PERM)};
            pg8::EpiGateUp E{(bf16*)(ws + WS_ACT), ka->in[15] + (size_t)l * NE * 2 * DFF};
            pg8::gemm_phase<pg8::EpiGateUp, pg8::MoeOrder, true, true>(lds + RING_OFF, D, S, E);
            if (BOTH(pb + 5)) GRID_BAR();
        }
        if (PH_EN(7) && IN(pb + 6)) {
            PH_LOCALS();
            const LAS int* toff = (const LAS int*)(lds + LDSCTL_OFF) + LW_TOFF; const LAS int* lcnt = (const LAS int*)(lds + LDSCTL_OFF) + LW_LCNT;
            pg8::MoeDenseOrder S{{(const char*)(ws + WS_ACT), (const char*)((bf16*)(ws + WS_WD) + (size_t)l * NE * D * DFF), D / 256, toff[NE], G, bx, DFF, (size_t)D * DFF * 2, toff, lcnt, (const int*)(ws + WS_PERM)}};
            pg8::EpiDown E{(bf16*)(ws + WS_CONTRIB), ka->in[17] + (size_t)l * NE * D, (const int*)(ws + WS_PERM), (const float*)(ws + WS_SLOTW), lcnt};
            pg8::gemm_phase<pg8::EpiDown, pg8::MoeDenseOrder, false, true>(lds + RING_OFF, DFF, S, E);
            if (BOTH(pb + 6)) GRID_BAR();
        }
        if (PH_EN(8) && IN(pb + 7)) {
            PH_LOCALS();
            const float* X1 = (const float*)(ws + WS_X1); bf16* XN = (bf16*)(ws + WS_XN); const bf16* CONTRIB = (const bf16*)(ws + WS_CONTRIB); float* outp = ka->out;
            const float* g2 = ka->in[18] + (size_t)l * D; const float* b2 = ka->in[19] + (size_t)l * D;
            f32x4 gv[4], bv[4];
#pragma unroll
            for (int j = 0; j < 4; ++j) { gv[j] = *(const f32x4*)(g2 + 256 * j + 4 * lane); bv[j] = *(const f32x4*)(b2 + 256 * j + 4 * lane); }
#pragma unroll 1
            for (int m = gw; m < T; m += NGW) {
                const GAS f32x4* xr = (const GAS f32x4*)(X1 + (size_t)m * D) + lane;
                f32x4 v[4]; float s = 0.f;
#pragma unroll
                for (int j = 0; j < 4; ++j) v[j] = xr[64 * j] * DN_ALPHA;
#pragma unroll
                for (int k = 0; k < TOPK; ++k) { const GAS v2u* cr = (const GAS v2u*)(CONTRIB + ((size_t)m * 4 + k) * D) + lane;
#pragma unroll
                    for (int j = 0; j < 4; ++j) { const v2u c = cr[64 * j]; v[j].x += bflo(c.x); v[j].y += bfhi(c.x); v[j].z += bflo(c.y); v[j].w += bfhi(c.y); } }
#pragma unroll
                for (int j = 0; j < 4; ++j) s += (v[j].x + v[j].y) + (v[j].z + v[j].w);
                const float mean = wave_sum(s) * (1.f / D); float s2 = 0.f;
#pragma unroll
                for (int j = 0; j < 4; ++j) { v[j] = v[j] - mean; s2 += (v[j].x * v[j].x + v[j].y * v[j].y) + (v[j].z * v[j].z + v[j].w * v[j].w); }
                const float rstd = 1.f / sqrtf(wave_sum(s2) * (1.f / D) + LN_EPS);
                GAS f32x4* orow = (GAS f32x4*)(outp + (size_t)m * D) + lane;
                GAS unsigned long long* o8 = (GAS unsigned long long*)(XN + (size_t)m * D) + lane;
#pragma unroll
                for (int j = 0; j < 4; ++j) { v[j] = v[j] * rstd * gv[j] + bv[j]; orow[64 * j] = v[j];
                    o8[64 * j] = (unsigned long long)pk2(v[j].x, v[j].y) | ((unsigned long long)pk2(v[j].z, v[j].w) << 32); }
            }
            if (BOTH(pb + 7)) GRID_BAR();
        }
    }
#undef IN
#undef BOTH
}

__device__ __forceinline__ int t5_bucket(int rel) {
    const int n = rel < 0 ? -rel : rel;
    int b;
    if (n < 8) b = n; else b = 8 + (n >= 12) + (n >= 16) + (n >= 23) + (n >= 32) + (n >= 46) + (n >= 64) + (n >= 91);
    return (rel > 0 ? 16 : 0) + b;
}
__device__ __forceinline__ void load64(const bf16* p, float (&q)[64]) {
#pragma unroll
    for (int i = 0; i < 8; ++i) { const v4u w = *(const v4u*)(p + 8 * i); q[8 * i] = bflo(w.x); q[8 * i + 1] = bfhi(w.x); q[8 * i + 2] = bflo(w.y); q[8 * i + 3] = bfhi(w.y); q[8 * i + 4] = bflo(w.z); q[8 * i + 5] = bfhi(w.z); q[8 * i + 6] = bflo(w.w); q[8 * i + 7] = bfhi(w.w); }
}
__device__ __forceinline__ float dot64(const bf16* p, const float (&q)[64]) {
    float a = 0.f;
#pragma unroll
    for (int i = 0; i < 8; ++i) { const v4u w = *(const v4u*)(p + 8 * i); a += q[8 * i] * bflo(w.x) + q[8 * i + 1] * bfhi(w.x) + q[8 * i + 2] * bflo(w.y) + q[8 * i + 3] * bfhi(w.y) + q[8 * i + 4] * bflo(w.z) + q[8 * i + 5] * bfhi(w.z) + q[8 * i + 6] * bflo(w.w) + q[8 * i + 7] * bfhi(w.w); }
    return a;
}
__device__ __forceinline__ void axpy64(const bf16* p, float a, float (&o)[64]) {
#pragma unroll
    for (int i = 0; i < 8; ++i) { const v4u w = *(const v4u*)(p + 8 * i); o[8 * i] += a * bflo(w.x); o[8 * i + 1] += a * bfhi(w.x); o[8 * i + 2] += a * bflo(w.y); o[8 * i + 3] += a * bfhi(w.y); o[8 * i + 4] += a * bflo(w.z); o[8 * i + 5] += a * bfhi(w.z); o[8 * i + 6] += a * bflo(w.w); o[8 * i + 7] += a * bfhi(w.w); }
}
__device__ __forceinline__ void store64(bf16* p, const float (&o)[64], float sc) {
#pragma unroll
    for (int i = 0; i < 8; ++i) { v4u w; w.x = pk2(o[8 * i] * sc, o[8 * i + 1] * sc); w.y = pk2(o[8 * i + 2] * sc, o[8 * i + 3] * sc); w.z = pk2(o[8 * i + 4] * sc, o[8 * i + 5] * sc); w.w = pk2(o[8 * i + 6] * sc, o[8 * i + 7] * sc); *(v4u*)(p + 8 * i) = w; }
}
__global__ void __launch_bounds__(256) naive_sb(const bf16* proj, bf16* ysb) {
    const int gid = blockIdx.x * 256 + threadIdx.x, t = gid & (SEQ - 1), bh = gid >> 12, h = bh & 7, b = bh >> 3;
    const size_t row = (size_t)b * SEQ + t;
    float q[64], o[64];
    load64(proj + row * INW + h * 64, q);
#pragma unroll
    for (int i = 0; i < 64; ++i) o[i] = 0.f;
    float R = 0.f;
    for (int s = t - 1; s >= 0; --s) {
        const bf16* kr = proj + ((size_t)b * SEQ + s) * INW + W + h * 64;
        const float z = dot64(kr, q) * 0.125f;
        const float sp = __builtin_fmaxf(z, 0.f) + log1pf(expf(-fabsf(z)));
        R += sp;
        const float a = expf(z - R);
        axpy64(kr + W, a, o);
        if (R > 104.f) break;
    }
    store64(ysb + row * W + h * 64, o, 1.0f);
}
__global__ void __launch_bounds__(256) naive_df(const bf16* proj, const float* rel_bias, float* tmp) {
    const int gid = blockIdx.x * 256 + threadIdx.x, t = gid & (SEQ - 1), r = gid >> 12, half = r & 1, h2 = (r >> 1) & 7, b = r >> 4, H = h2 >> 1;
    const size_t row = (size_t)b * SEQ + t;
    float q[64], o[64];
    load64(proj + row * INW + 3 * W + h2 * 64, q);
#pragma unroll
    for (int i = 0; i < 64; ++i) o[i] = 0.f;
    const int nk = ((t >> 6) + 1) * 64;
    float m = -INFINITY, lsum = 0.f;
    for (int s = 0; s < nk; ++s) {
        const bf16* kr = proj + ((size_t)b * SEQ + s) * INW + 4 * W + h2 * 64;
        const float z = dot64(kr, q) * 0.125f + rel_bias[t5_bucket(s - t) * 8 + h2];
        if (z > m) { const float f = expf(m - z); lsum *= f;
#pragma unroll
            for (int i = 0; i < 64; ++i) o[i] *= f;
            m = z; }
        const float p = expf(z - m); lsum += p;
        axpy64(proj + ((size_t)b * SEQ + s) * INW + 5 * W + H * 128 + half * 64, p, o);
    }
    const float inv = 1.0f / lsum;
    float* op = tmp + (row * 8 + h2) * 128 + half * 64;
#pragma unroll
    for (int i = 0; i < 64; ++i) op[i] = o[i] * inv;
}
__global__ void __launch_bounds__(256) naive_df_combine(const float* tmp, const float* dlam, const float* subg, bf16* ydf, int l) {
    const int gid = blockIdx.x * 256 + threadIdx.x, t = gid & (SEQ - 1), r = gid >> 12, H = r & 3, b = r >> 2;
    const size_t row = (size_t)b * SEQ + t;
    const float lam_init = 0.8f - 0.6f * expf(-0.3f * (float)l);
    float s1 = 0.f, s2 = 0.f;
    for (int i = 0; i < 64; ++i) { s1 += dlam[i] * dlam[64 + i]; s2 += dlam[128 + i] * dlam[192 + i]; }
    const float lam = expf(s1) - expf(s2) + lam_init;
    const float* t0 = tmp + (row * 8 + 2 * H) * 128; const float* t1 = t0 + 128;
    float ss = 0.f;
    for (int i = 0; i < 128; ++i) { const float a = t0[i] - lam * t1[i]; ss += a * a; }
    const float rs = 1.0f / sqrtf(ss * (1.0f / 128.f) + RMS_EPS) * (1.0f - lam_init);
    for (int i = 0; i < 128; i += 2) { const float a0 = (t0[i] - lam * t1[i]) * rs * subg[i], a1 = (t0[i + 1] - lam * t1[i + 1]) * rs * subg[i + 1]; *(unsigned*)(ydf + row * W + H * 128 + i) = pk2(a0, a1); }
}
__global__ void __launch_bounds__(256) naive_mem(const bf16* proj, const bf16* memkv, bf16* ymem) {
    const int gid = blockIdx.x * 256 + threadIdx.x, t = gid & (SEQ - 1), r = gid >> 12, half = r & 1, h = (r >> 1) & 3, b = r >> 3;
    const size_t row = (size_t)b * SEQ + t;
    float q0[64], q1[64], o[64];
    load64(proj + row * INW + 6 * W + h * 128, q0); load64(proj + row * INW + 6 * W + h * 128 + 64, q1);
#pragma unroll
    for (int i = 0; i < 64; ++i) o[i] = 0.f;
    float m = -INFINITY, lsum = 0.f;
    for (int s = 0; s < MEML; ++s) {
        const bf16* kr = memkv + ((size_t)b * MEML + s) * 1024 + h * 128;
        const float z = (dot64(kr, q0) + dot64(kr + 64, q1)) * 0.08838834764831845f;
        if (z > m) { const float f = expf(m - z); lsum *= f;
#pragma unroll
            for (int i = 0; i < 64; ++i) o[i] *= f;
            m = z; }
        const float p = expf(z - m); lsum += p;
        axpy64(kr + W + half * 64, p, o);
    }
    store64(ymem + row * W + h * 128 + half * 64, o, 1.0f / lsum);
}

extern "C" void kernel_launch(void* const* d_in, const int* in_sizes, int n_in, void* d_out, int out_size, void* d_ws, size_t ws_size, hipStream_t stream) {
    static int grid = 0;
    if (grid == 0) {
        if (n_in != 20 || in_sizes[0] != T * D || out_size != T * D || ws_size < WS_END) { fprintf(stderr, "kernel_launch: unexpected shapes / workspace (n_in %d, ws %zu, need %zu)\n", n_in, ws_size, (size_t)WS_END); grid = -1; return; }
        int dev = 0, cus = 0, per_cu = 0;
        if (hipGetDevice(&dev) != hipSuccess || hipDeviceGetAttribute(&cus, hipDeviceAttributeMultiprocessorCount, dev) != hipSuccess) { grid = -1; return; }
        if (hipFuncSetAttribute((const void*)mk_fwd, hipFuncAttributeMaxDynamicSharedMemorySize, LDS_BYTES) != hipSuccess) { fprintf(stderr, "kernel_launch: hipFuncSetAttribute failed\n"); grid = -1; return; }
        if (hipOccupancyMaxActiveBlocksPerMultiprocessor(&per_cu, (const void*)mk_fwd, NWAVES * 64, LDS_BYTES) != hipSuccess || per_cu < 1) fprintf(stderr, "kernel_launch: occupancy query reports %d\n", per_cu);
        (void)hipGetLastError();
        grid = cus;
    }
    if (grid < 0) return;
    (void)hipMemsetAsync((char*)d_ws + WS_CTL, 0, CTL_ZERO_BYTES, stream);
    Args a{};
    for (int i = 0; i < 20; ++i) a.in[i] = (const float*)d_in[i];
    a.out = (float*)d_out; a.ws = (unsigned char*)d_ws;
    unsigned char* ws = (unsigned char*)d_ws;
    const bf16* PROJ = (const bf16*)(ws + WS_PROJ); bf16* YB = (bf16*)(ws + WS_Y); float* TMP = (float*)(ws + WS_X1);
#if MK_ONE_LAUNCH
    a.ph_lo = 0; a.ph_hi = 1 + 8 * DEPTH;
    hipLaunchKernelGGL(mk_fwd, dim3(grid), dim3(NWAVES * 64), LDS_BYTES, stream, a);
#else
    for (int ph = 0; ph < 1 + 8 * DEPTH; ++ph) {
        const int l = (ph - 1) / 8;
        if (ph >= 1 && (ph - 1) % 8 == 1) {
            hipLaunchKernelGGL(naive_sb, dim3(T * 8 / 256), dim3(256), 0, stream, PROJ, YB);
            hipLaunchKernelGGL(naive_df, dim3(T * 16 / 256), dim3(256), 0, stream, PROJ, (const float*)d_in[6], TMP);
            hipLaunchKernelGGL(naive_df_combine, dim3(T * 4 / 256), dim3(256), 0, stream, (const float*)TMP, (const float*)d_in[4] + (size_t)l * 256, (const float*)d_in[5] + (size_t)l * 128, YB + (size_t)T * W, l);
            hipLaunchKernelGGL(naive_mem, dim3(T * 8 / 256), dim3(256), 0, stream, PROJ, (const bf16*)(ws + WS_MEMKV), YB + (size_t)2 * T * W);
            continue;
        }
        a.ph_lo = ph; a.ph_hi = ph + 1;
        hipLaunchKernelGGL(mk_fwd, dim3(grid), dim3(NWAVES * 64), LDS_BYTES, stream, a);
    }
#endif
}
```

```cpp
#include <hip/hip_runtime.h>
#include <cstdio>
#include <cstdint>

#ifndef DIS_MASK
#define DIS_MASK 0
#endif
#define PH_EN(k) (((DIS_MASK) >> (k) & 1) == 0)
#ifndef ATT_MASK
#define ATT_MASK 0
#endif
#define ATT_EN(k) (((ATT_MASK) >> (k) & 1) == 0)
#ifndef MK_ONE_LAUNCH
#define MK_ONE_LAUNCH 1
#endif

constexpr int BATCH = 16, SEQ = 4096, D = 1024, T = BATCH * SEQ, W = 512, INW = 6656, NE = 32, TOPK = 4, DFF = 1024, MEML = 256, MEMT = BATCH * MEML, DEPTH = 2;
constexpr int GATE0 = 7 * W;
constexpr float LN_EPS = 1e-5f, RMS_EPS = 1e-5f;
constexpr float DN_ALPHA = 1.4142135623730951f;
constexpr int NWAVES = 8;

constexpr size_t MiB = 1u << 20;
constexpr size_t WS_CTL = 0, CTL_ZERO_BYTES = 1 * MiB;
constexpr size_t WS_PERM = 2 * MiB;
constexpr size_t WS_SLOTW = 10 * MiB;
constexpr size_t WS_WIN = 16 * MiB;
constexpr size_t WS_WMEMKV = 42 * MiB;
constexpr size_t WS_WBR = 46 * MiB;
constexpr size_t WS_WOUT = 52 * MiB;
constexpr size_t WS_WGU = 56 * MiB;
constexpr size_t WS_WD = 312 * MiB;
constexpr size_t WS_MEMB = 440 * MiB;
constexpr size_t WS_MEMKV = 448 * MiB;
constexpr size_t WS_XN = 456 * MiB;
constexpr size_t WS_X1 = 584 * MiB;
constexpr size_t WS_BIG = 840 * MiB;
constexpr size_t WS_PROJ = WS_BIG;
constexpr size_t WS_Y = WS_BIG + 832 * MiB;
constexpr size_t WS_MERGED = WS_BIG + 1024 * MiB;
constexpr size_t WS_ACT = WS_BIG;
constexpr size_t WS_CONTRIB = WS_BIG + 528 * MiB;
constexpr size_t WS_END = WS_BIG + 1152 * MiB;
static_assert(WS_CONTRIB + (size_t)T * 4 * D * 2 <= WS_END && WS_MERGED + (size_t)T * D * 2 <= WS_END, "ws map");

constexpr int CW_TMO = 0, CW_CODE = 1;
constexpr int CW_BAR = 4096;
constexpr int CW_CNT = 32768;

constexpr int RING_OFF = 0, RING_BYTES = 131072;
constexpr int LDSCTL_OFF = RING_BYTES;
constexpr int LDS_BYTES = 147456;
constexpr int LW_BAR = 8;
constexpr int LW_TOFF = 64;
constexpr int LW_LCNT = 128;
constexpr int LW_RCNT = 192;
constexpr int LW_RBASE = 256;
constexpr int LW_RSLOT = 320, RSLOT_STRIDE = 256;

#define GAS __attribute__((address_space(1)))
#define LAS __attribute__((address_space(3)))
typedef unsigned short bf16;
typedef unsigned v4u __attribute__((ext_vector_type(4)));
typedef unsigned v2u __attribute__((ext_vector_type(2)));
typedef float f32x4 __attribute__((ext_vector_type(4)));
typedef float f32x2 __attribute__((ext_vector_type(2)));
typedef short bf16x8 __attribute__((ext_vector_type(8)));
typedef GAS unsigned gu32;
#define RLX_AGENT __ATOMIC_RELAXED, __HIP_MEMORY_SCOPE_AGENT
#define LDS_WAIT() asm volatile("s_waitcnt lgkmcnt(0)" ::: "memory")
#define VM_WAIT() asm volatile("s_waitcnt vmcnt(0)" ::: "memory")

__device__ __forceinline__ unsigned f2bf(float f) { unsigned u = __builtin_bit_cast(unsigned, f); return (u + 0x7fffu + ((u >> 16) & 1u)) >> 16; }
__device__ __forceinline__ unsigned pk2(float lo, float hi) { return f2bf(lo) | (f2bf(hi) << 16); }
__device__ __forceinline__ float bflo(unsigned w) { return __uint_as_float(w << 16); }
__device__ __forceinline__ float bfhi(unsigned w) { return __uint_as_float(w & 0xffff0000u); }
__device__ __forceinline__ float bf2f(bf16 b) { return __uint_as_float((unsigned)b << 16); }
__device__ __forceinline__ float fast_exp(float x) { return __builtin_amdgcn_exp2f(x * 1.4426950408889634f); }
__device__ __forceinline__ float fast_sigmoid(float x) { return __builtin_amdgcn_rcpf(1.0f + fast_exp(-x)); }

namespace pg8 {
#define PG8_LAS __attribute__((address_space(3)))
typedef unsigned short bf16_t;
typedef unsigned u32x4 __attribute__((ext_vector_type(4)));
constexpr int BM = 256, BK = 64, HALF = 128, HTB = HALF * BK * 2, STAGE_BYTES = 8 * HTB, NXCD = 8, WGM = 8;

__host__ __device__ __forceinline__ int lds_byte(int r, int c) { const int st = (r >> 4) * 2 + (c >> 5), rr = r & 15, cc = c & 31, ob = rr * 64 + cc * 2; return st * 1024 + (ob ^ (((ob >> 9) & 1) << 5)); }
__host__ __device__ __forceinline__ void stage_rc(int b, int& R, int& C) { const int st = b / 1024, sb = b % 1024, swz = sb ^ (((sb >> 9) & 1) << 5); R = (st >> 1) * 16 + swz / 64; C = (st & 1) * 32 + (swz % 64) / 2; }
__host__ __device__ __forceinline__ int perm32(int rho) { const int n = rho >> 4, i = rho & 15; return 8 * (i >> 2) + 4 * n + (i & 3); }

struct Unit { int pm, pn, e, rt; };

__device__ __forceinline__ bool tile_order(long L, int nM, int nN, int& pm, int& pn) {
    const int nwg = nM * nN; if (L >= nwg) return false;
    int wgid = (int)L; { const int q = nwg / NXCD, r = nwg % NXCD, xcd = wgid % NXCD, off = wgid / NXCD; wgid = (xcd < r ? xcd * (q + 1) : r * (q + 1) + (xcd - r) * q) + off; }
    const int nig = WGM * nN, gid = wgid / nig, fm = gid * WGM, gsz = (nM - fm) < WGM ? (nM - fm) : WGM;
    pm = fm + ((wgid % nig) % gsz); pn = (wgid % nig) / gsz; return true;
}

__device__ __forceinline__ unsigned cvt_pk_bf16(float lo, float hi) { unsigned r; asm volatile("v_cvt_pk_bf16_f32 %0, %1, %2" : "=v"(r) : "v"(lo), "v"(hi)); return r; }

template <class Epi, class Sched, bool GATHER, bool ALIGN_EPI>
__device__ __forceinline__ void gemm_phase(PG8_LAS unsigned char* lds, const int K, const Sched& S, const Epi& E) {
    int tid = threadIdx.x; asm volatile("" : "+v"(tid));
    const int wid = __builtin_amdgcn_readfirstlane(tid >> 6), lane = tid & 63, wr = wid >> 2, wc = wid & 3, fr = lane & 15, fq = lane >> 4;
    const int nt = K / BK;
    unsigned voffA[2], voffB[2]; int gR[2], gC[2];
#pragma unroll
    for (int i = 0; i < 2; ++i) { int R, C; stage_rc(tid * 16 + i * 8192, R, C); const int Rb = Epi::PERM ? ((R & ~31) + perm32(R & 31)) : R;
        voffA[i] = (unsigned)(R * K + C) * 2u; voffB[i] = (unsigned)(Rb * K + C) * 2u; gR[i] = R; gC[i] = C * 2; }
    const size_t kstep = (size_t)(BK * 2);
    const size_t hstep = (size_t)HALF * K * 2;
    const unsigned ldsw = (unsigned)wid * 1024u;
    const int aoff = lds_byte(wr * 64 + fr, fq * 8), boff = lds_byte(wc * 32 + fr, fq * 8);
#define PG8_SA(b, h) (((b) * 2 + (h)) * HTB)
#define PG8_SB(b, h) ((4 + (b) * 2 + (h)) * HTB)
#define PG8_STAGE(bufoff, gbase, voff) do { _Pragma("unroll") for (int _i = 0; _i < 2; ++_i) \
        __builtin_amdgcn_global_load_lds((const unsigned*)((const char*)(gbase) + (voff)[_i]), (PG8_LAS unsigned*)(lds + (bufoff) + ldsw + _i * 8192), 16, 0, 0); } while (0)
#define PG8_STAGE_A(bufoff, kptr, h, G) do { if constexpr (GATHER) { PG8_STAGE(bufoff, kptr, (G)[h]); } else { PG8_STAGE(bufoff, (kptr) + (h) * hstep, voffA); } } while (0)
#define PG8_LDA(dst, b, h) do { _Pragma("unroll") for (int m = 0; m < 4; ++m) _Pragma("unroll") for (int k = 0; k < 2; ++k) dst[m][k] = *(const PG8_LAS bf16x8*)(lds + PG8_SA(b, h) + aoff + m * 2048 + k * 1024); } while (0)
#define PG8_LDB(dst, b, h) do { _Pragma("unroll") for (int n = 0; n < 2; ++n) _Pragma("unroll") for (int k = 0; k < 2; ++k) dst[n][k] = *(const PG8_LAS bf16x8*)(lds + PG8_SB(b, h) + boff + n * 2048 + k * 1024); } while (0)
#define PG8_MMA(ai, bj, At, Bt) do { __builtin_amdgcn_s_setprio(1); _Pragma("unroll") for (int m = 0; m < 4; ++m) _Pragma("unroll") for (int n = 0; n < 2; ++n) _Pragma("unroll") for (int k = 0; k < 2; ++k) \
        acc[ai][bj][m][n] = __builtin_amdgcn_mfma_f32_16x16x32_bf16(Bt[n][k], At[m][k], acc[ai][bj][m][n], 0, 0, 0); __builtin_amdgcn_s_setprio(0); } while (0)
#define PG8_WAIT_V(n) asm volatile("s_waitcnt vmcnt(" #n ")" ::: "memory")
#define PG8_WAIT_L(n) asm volatile("s_waitcnt lgkmcnt(" #n ")" ::: "memory")
#define PG8_BAR __builtin_amdgcn_s_barrier()
#define PG8_SCHED __builtin_amdgcn_sched_barrier(0)
    Unit cur, nxt; int ui = 0;
    if (!S.next(0, cur)) return;
    f32x4 acc[2][2][4][2];
#pragma unroll
    for (int a = 0; a < 2; ++a)
#pragma unroll
        for (int b = 0; b < 2; ++b)
#pragma unroll
            for (int m = 0; m < 4; ++m)
#pragma unroll
                for (int n = 0; n < 2; ++n) acc[a][b][m][n] = (f32x4){0.f, 0.f, 0.f, 0.f};
    bf16x8 At[4][2], B0[2][2], B1[2][2];
    unsigned cG[2][2] = {{0u, 0u}, {0u, 0u}}, nG[2][2] = {{0u, 0u}, {0u, 0u}}, sG[2][2] = {{0u, 0u}, {0u, 0u}};
    if constexpr (GATHER) S.gather(cur, gR, gC, K, cG);
    if constexpr (GATHER) asm volatile("" : "+v"(cG[0][0]), "+v"(cG[0][1]), "+v"(cG[1][0]), "+v"(cG[1][1]));
    const char* cA = S.a_base(cur); const char* cB = S.b_base(cur);
    PG8_STAGE(PG8_SB(0, 0), cB, voffB); PG8_STAGE(PG8_SB(0, 1), cB + hstep, voffB); PG8_STAGE_A(PG8_SA(0, 0), cA, 0, cG); PG8_STAGE_A(PG8_SA(0, 1), cA, 1, cG);
    if (wr == 1) PG8_BAR;
    PG8_WAIT_V(2); PG8_BAR;
    PG8_STAGE(PG8_SB(1, 0), cB + kstep, voffB); PG8_STAGE_A(PG8_SA(1, 0), cA + kstep, 0, cG); PG8_STAGE(PG8_SB(1, 1), cB + hstep + kstep, voffB);
    PG8_WAIT_V(6); PG8_BAR;
    for (;;) {
        const bool has_next = S.next(ui + 1, nxt);
        const char* nA = has_next ? S.a_base(nxt) : cA; const char* nB = has_next ? S.b_base(nxt) : cB;
        if constexpr (GATHER) { if (has_next) S.gather(nxt, gR, gC, K, nG); else { nG[0][0] = cG[0][0]; nG[0][1] = cG[0][1]; nG[1][0] = cG[1][0]; nG[1][1] = cG[1][1]; } }
        if constexpr (GATHER) asm volatile("" : "+v"(nG[0][0]), "+v"(nG[0][1]), "+v"(nG[1][0]), "+v"(nG[1][1]));
        for (int t = 0; t < nt; t += 2) {
            const bool last = (t == nt - 2);
            const char* a1 = cA + (size_t)(t + 1) * kstep;
            const char* a2 = last ? nA : cA + (size_t)(t + 2) * kstep; const char* b2 = last ? nB : cB + (size_t)(t + 2) * kstep;
            const char* a3 = a2 + kstep; const char* b3 = b2 + kstep;
            if constexpr (GATHER) { sG[0][0] = last ? nG[0][0] : cG[0][0]; sG[0][1] = last ? nG[0][1] : cG[0][1]; sG[1][0] = last ? nG[1][0] : cG[1][0]; sG[1][1] = last ? nG[1][1] : cG[1][1]; }
            PG8_LDB(B0, 0, 0); PG8_LDB(B1, 0, 1); PG8_SCHED; PG8_LDA(At, 0, 0); PG8_STAGE_A(PG8_SA(1, 1), a1, 1, cG);
            PG8_WAIT_V(8); PG8_WAIT_L(0); PG8_BAR; PG8_MMA(0, 0, At, B0); PG8_MMA(0, 1, At, B1); PG8_BAR; PG8_SCHED;
            PG8_LDA(At, 0, 1); PG8_STAGE(PG8_SB(0, 0), b2, voffB); PG8_STAGE(PG8_SB(0, 1), b2 + hstep, voffB); PG8_STAGE_A(PG8_SA(0, 0), a2, 0, sG);
            PG8_WAIT_V(8); PG8_WAIT_L(0); PG8_BAR; PG8_MMA(1, 0, At, B0); PG8_MMA(1, 1, At, B1); PG8_BAR; PG8_SCHED;
            PG8_LDB(B0, 1, 0); PG8_LDB(B1, 1, 1); PG8_SCHED; PG8_LDA(At, 1, 0); PG8_STAGE_A(PG8_SA(0, 1), a2, 1, sG);
            PG8_WAIT_V(8); PG8_WAIT_L(0); PG8_BAR; PG8_MMA(0, 0, At, B0); PG8_MMA(0, 1, At, B1); PG8_BAR; PG8_SCHED;
            PG8_LDA(At, 1, 1); PG8_STAGE(PG8_SB(1, 0), b3, voffB); PG8_STAGE(PG8_SB(1, 1), b3 + hstep, voffB); PG8_STAGE_A(PG8_SA(1, 0), a3, 0, sG);
            PG8_WAIT_V(8); PG8_WAIT_L(0); PG8_BAR; PG8_MMA(1, 0, At, B0); PG8_MMA(1, 1, At, B1); PG8_BAR; PG8_SCHED;
        }
        if constexpr (ALIGN_EPI) { if (wr == 0) PG8_BAR; }
        E(acc, cur, wr, wc, fr, fq);
        if constexpr (Epi::DRAIN_AFTER) __builtin_amdgcn_s_waitcnt(0x0F70);
        if (!has_next) break;
#pragma unroll
        for (int a = 0; a < 2; ++a)
#pragma unroll
            for (int b = 0; b < 2; ++b)
#pragma unroll
                for (int m = 0; m < 4; ++m)
#pragma unroll
                    for (int n = 0; n < 2; ++n) acc[a][b][m][n] = (f32x4){0.f, 0.f, 0.f, 0.f};
        cur = nxt; cA = nA; cB = nB; ++ui;
        if constexpr (GATHER) { cG[0][0] = nG[0][0]; cG[0][1] = nG[0][1]; cG[1][0] = nG[1][0]; cG[1][1] = nG[1][1]; }
        if constexpr (ALIGN_EPI) { if (wr == 1) PG8_BAR; }
    }
    PG8_WAIT_V(0);
    if constexpr (!ALIGN_EPI) { if (wr == 0) PG8_BAR; }
    PG8_BAR;
#undef PG8_SA
#undef PG8_SB
#undef PG8_STAGE
#undef PG8_STAGE_A
#undef PG8_LDA
#undef PG8_LDB
#undef PG8_MMA
#undef PG8_WAIT_V
#undef PG8_WAIT_L
#undef PG8_BAR
#undef PG8_SCHED
}

struct DenseOrder {
    const char* A; const char* Bt; int nM, nN, G, c, K;
    __device__ __forceinline__ bool next(int i, Unit& u) const { u.e = 0; u.rt = 0; return tile_order((long)i * G + c, nM, nN, u.pm, u.pn); }
    __device__ __forceinline__ const char* a_base(const Unit& u) const { return A + (size_t)u.pm * BM * K * 2; }
    __device__ __forceinline__ const char* b_base(const Unit& u) const { return Bt + (size_t)u.pn * BM * K * 2; }
};
struct BranchOrder {
    const char* Y; const char* Wb; int nM, nN, G, c;
    __device__ __forceinline__ bool next(int i, Unit& u) const { u.e = i % 3; u.rt = 0; return tile_order((long)(i / 3) * G + c, nM, nN, u.pm, u.pn); }
    __device__ __forceinline__ const char* a_base(const Unit& u) const { return Y + (size_t)u.e * T * W * 2 + (size_t)u.pm * BM * W * 2; }
    __device__ __forceinline__ const char* b_base(const Unit& u) const { return Wb + (size_t)u.e * D * W * 2 + (size_t)u.pn * BM * W * 2; }
};
struct MoeOrder {
    const char* A; const char* Wt; int nN, NT, G, c, K; size_t wstride;
    const PG8_LAS int* toff; const PG8_LAS int* lcnt; const int* perm;
    __device__ __forceinline__ bool next(int i, Unit& u) const {
        if (!tile_order((long)i * G + c, NT, nN, u.pm, u.pn)) return false;
        int e = 0;
#pragma unroll 1
        for (int j = 1; j < NE; ++j) e += (toff[j] <= u.pm) ? 1 : 0;
        u.e = e; u.rt = u.pm - toff[e]; return true;
    }
    __device__ __forceinline__ const char* a_base(const Unit& u) const { return A; }
    __device__ __forceinline__ const char* a_dense(const Unit& u) const { return A + (size_t)u.pm * BM * K * 2; }
    __device__ __forceinline__ const char* b_base(const Unit& u) const { return Wt + (size_t)u.e * wstride + (size_t)u.pn * BM * K * 2; }
    __device__ __forceinline__ void gather(const Unit& u, const int (&gR)[2], const int (&gC)[2], int K_, unsigned (&Gv)[2][2]) const {
        const int n = lcnt[u.e] - u.rt * BM; const int* p = perm + (size_t)u.e * T + u.rt * BM;
#pragma unroll
        for (int h = 0; h < 2; ++h)
#pragma unroll
            for (int i = 0; i < 2; ++i) { const int r = h * HALF + gR[i]; const int tok = (r < n) ? (p[r] >> 2) : 0; Gv[h][i] = (unsigned)tok * (unsigned)(K_ * 2) + (unsigned)gC[i]; }
    }
};
struct MoeDenseOrder : MoeOrder {
    __device__ __forceinline__ const char* a_base(const Unit& u) const { return a_dense(u); }
};

struct EpiProj {
    static constexpr bool PERM = true, DRAIN_AFTER = false;
    bf16_t* O; int ldc; const float* bias; int act_from;
    __device__ __forceinline__ void operator()(const f32x4 (&acc)[2][2][4][2], const Unit& u, int wr, int wc, int fr, int fq) const {
        const int row0 = u.pm * BM + wr * 64 + fr, colt = u.pn * BM, col0 = colt + wc * 32 + 8 * fq;
        const bool gate = colt >= act_from;
        f32x4 bv[2][2];
#pragma unroll
        for (int bj = 0; bj < 2; ++bj)
#pragma unroll
            for (int n = 0; n < 2; ++n) bv[bj][n] = gate ? *(const f32x4*)(bias + (col0 - act_from) + bj * HALF + 4 * n) : (f32x4){0.f, 0.f, 0.f, 0.f};
#pragma unroll
        for (int ai = 0; ai < 2; ++ai)
#pragma unroll
            for (int m = 0; m < 4; ++m) { bf16_t* rowp = O + (size_t)(row0 + ai * HALF + m * 16) * ldc + col0;
#pragma unroll
                for (int bj = 0; bj < 2; ++bj) { f32x4 v0 = acc[ai][bj][m][0] + bv[bj][0], v1 = acc[ai][bj][m][1] + bv[bj][1];
                    if (gate) {
#pragma unroll
                        for (int j = 0; j < 4; ++j) { v0[j] = fast_sigmoid(v0[j]); v1[j] = fast_sigmoid(v1[j]); } }
                    u32x4 w; w.x = cvt_pk_bf16(v0[0], v0[1]); w.y = cvt_pk_bf16(v0[2], v0[3]); w.z = cvt_pk_bf16(v1[0], v1[1]); w.w = cvt_pk_bf16(v1[2], v1[3]);
                    *(u32x4*)(rowp + bj * HALF) = w; } }
    }
};
struct EpiBranch {
    static constexpr bool PERM = true, DRAIN_AFTER = false;
    const bf16_t* P; bf16_t* Mg;
    __device__ __forceinline__ void operator()(const f32x4 (&acc)[2][2][4][2], const Unit& u, int wr, int wc, int fr, int fq) const {
        const int row0 = u.pm * BM + wr * 64 + fr, col0 = u.pn * BM + wc * 32 + 8 * fq; const int br = u.e;
#pragma unroll
        for (int ai = 0; ai < 2; ++ai)
#pragma unroll
            for (int m = 0; m < 4; ++m) { const size_t row = (size_t)(row0 + ai * HALF + m * 16);
                const bf16_t* gp = P + row * INW + GATE0 + br * D + col0; bf16_t* mp = Mg + row * D + col0;
#pragma unroll
                for (int bj = 0; bj < 2; ++bj) {
                    const u32x4 g = *(const u32x4*)(gp + bj * HALF); u32x4 pv = (u32x4){0u, 0u, 0u, 0u}; if (br) pv = *(const u32x4*)(mp + bj * HALF);
                    const f32x4 a0 = acc[ai][bj][m][0], a1 = acc[ai][bj][m][1];
                    u32x4 w;
                    w.x = cvt_pk_bf16(bflo(pv.x) + bflo(g.x) * a0[0], bfhi(pv.x) + bfhi(g.x) * a0[1]);
                    w.y = cvt_pk_bf16(bflo(pv.y) + bflo(g.y) * a0[2], bfhi(pv.y) + bfhi(g.y) * a0[3]);
                    w.z = cvt_pk_bf16(bflo(pv.z) + bflo(g.z) * a1[0], bfhi(pv.z) + bfhi(g.z) * a1[1]);
                    w.w = cvt_pk_bf16(bflo(pv.w) + bflo(g.w) * a1[2], bfhi(pv.w) + bfhi(g.w) * a1[3]);
                    *(u32x4*)(mp + bj * HALF) = w; } }
    }
};
struct EpiOut {
    static constexpr bool PERM = false, DRAIN_AFTER = false;
    const float* X; float* V1;
    __device__ __forceinline__ void operator()(const f32x4 (&acc)[2][2][4][2], const Unit& u, int wr, int wc, int fr, int fq) const {
        const int row0 = u.pm * BM + wr * 64 + fr, col0 = u.pn * BM + wc * 32 + 4 * fq;
#pragma unroll
        for (int ai = 0; ai < 2; ++ai)
#pragma unroll
            for (int m = 0; m < 4; ++m) { const size_t off = (size_t)(row0 + ai * HALF + m * 16) * D + col0;
#pragma unroll
                for (int bj = 0; bj < 2; ++bj)
#pragma unroll
                    for (int n = 0; n < 2; ++n) { const f32x4 xv = *(const f32x4*)(X + off + bj * HALF + n * 16); *(f32x4*)(V1 + off + bj * HALF + n * 16) = xv * DN_ALPHA + acc[ai][bj][m][n]; } }
    }
};
struct EpiGateUp {
    static constexpr bool PERM = true, DRAIN_AFTER = false;
    bf16_t* Act; const float* bgu;
    __device__ __forceinline__ void operator()(const f32x4 (&acc)[2][2][4][2], const Unit& u, int wr, int wc, int fr, int fq) const {
        const int row0 = u.pm * BM + wr * 64 + fr, c0 = u.pn * HALF + wc * 32 + 8 * fq;
        const float* bg = bgu + (size_t)u.e * 2 * DFF + c0;
        const f32x4 bg0 = *(const f32x4*)(bg), bg1 = *(const f32x4*)(bg + 4), bu0 = *(const f32x4*)(bg + DFF), bu1 = *(const f32x4*)(bg + DFF + 4);
#pragma unroll
        for (int ai = 0; ai < 2; ++ai)
#pragma unroll
            for (int m = 0; m < 4; ++m) {
                f32x4 g0 = acc[ai][0][m][0] + bg0, g1 = acc[ai][0][m][1] + bg1, u0 = acc[ai][1][m][0] + bu0, u1 = acc[ai][1][m][1] + bu1;
                float o[8];
#pragma unroll
                for (int j = 0; j < 4; ++j) {
                    const float ga = __builtin_fminf(g0[j], 7.0f), gb = __builtin_fminf(g1[j], 7.0f);
                    const float ua = __builtin_fminf(__builtin_fmaxf(u0[j], -7.0f), 7.0f), ub = __builtin_fminf(__builtin_fmaxf(u1[j], -7.0f), 7.0f);
                    o[j] = (ua + 1.0f) * (ga * fast_sigmoid(1.702f * ga)); o[4 + j] = (ub + 1.0f) * (gb * fast_sigmoid(1.702f * gb)); }
                u32x4 w; w.x = cvt_pk_bf16(o[0], o[1]); w.y = cvt_pk_bf16(o[2], o[3]); w.z = cvt_pk_bf16(o[4], o[5]); w.w = cvt_pk_bf16(o[6], o[7]);
                *(u32x4*)(Act + (size_t)(row0 + ai * HALF + m * 16) * DFF + c0) = w; }
    }
};
struct EpiDown {
    static constexpr bool PERM = true, DRAIN_AFTER = true;
    bf16_t* C; const float* bd; const int* perm; const float* slotw; const PG8_LAS int* lcnt;
    __device__ __forceinline__ void operator()(const f32x4 (&acc)[2][2][4][2], const Unit& u, int wr, int wc, int fr, int fq) const {
        const int lr0 = u.rt * BM + wr * 64 + fr, col0 = u.pn * BM + wc * 32 + 8 * fq; const int n = lcnt[u.e];
        const int* p = perm + (size_t)u.e * T;
        f32x4 bv[2][2];
#pragma unroll
        for (int bj = 0; bj < 2; ++bj)
#pragma unroll
            for (int nn = 0; nn < 2; ++nn) bv[bj][nn] = *(const f32x4*)(bd + (size_t)u.e * D + col0 + bj * HALF + 4 * nn);
#pragma unroll
        for (int ai = 0; ai < 2; ++ai)
#pragma unroll
            for (int m = 0; m < 4; ++m) { const int lr = lr0 + ai * HALF + m * 16;
                if (lr < n) { const int ts = p[lr]; const float cw = slotw[ts]; bf16_t* rowp = C + (size_t)ts * D + col0;
#pragma unroll
                    for (int bj = 0; bj < 2; ++bj) { const f32x4 v0 = (acc[ai][bj][m][0] + bv[bj][0]) * cw, v1 = (acc[ai][bj][m][1] + bv[bj][1]) * cw;
                        u32x4 w; w.x = cvt_pk_bf16(v0[0], v0[1]); w.y = cvt_pk_bf16(v0[2], v0[3]); w.z = cvt_pk_bf16(v1[0], v1[1]); w.w = cvt_pk_bf16(v1[2], v1[3]);
                        *(u32x4*)(rowp + bj * HALF) = w; } } }
    }
};
}

#define XB_TMO      128
#define XB_XCNT(j)  (256  + 64 * (j))
#define XB_XSUB(j)  (1280 + 64 * (j))
#define XB_XGEN(j)  (2304 + 64 * (j))
#define XB_TOP      3328
#define XB_TOPGEN   3392
#define XCD_BAR_WORDS 3456
#define XB_SPIN_CAP (1u << 18)
__device__ __forceinline__ unsigned xb_ld(unsigned* p)              { return __hip_atomic_load(p, __ATOMIC_RELAXED, __HIP_MEMORY_SCOPE_AGENT); }
__device__ __forceinline__ unsigned xb_add(unsigned* p, unsigned v) { return __hip_atomic_fetch_add(p, v, __ATOMIC_RELAXED, __HIP_MEMORY_SCOPE_AGENT); }
__device__ __forceinline__ unsigned xb_xcc_id() { return (unsigned)__builtin_amdgcn_s_getreg((3 << 11) | 20) & 0xFu; }
#define XB_SPIN(cond, bar) do { unsigned _sp = 0; while (cond) { __builtin_amdgcn_s_sleep(1); \
    if ((++_sp & 255u) == 0u) { if (xb_ld(&(bar)[XB_TMO])) break; if (_sp > XB_SPIN_CAP) { atomicAdd(&(bar)[XB_TMO], 1u); break; } } } } while (0)
struct XcdBarrier { unsigned* bar; unsigned x; volatile LAS unsigned* st; };
__device__ __forceinline__ XcdBarrier xcd_barrier_post(unsigned* bar, volatile LAS unsigned* st) {
    XcdBarrier b; b.bar = bar; b.x = xb_xcc_id(); b.st = st;
    if (threadIdx.x == 0) (void)xb_add(&bar[XB_XCNT(b.x)], 1u);
    return b;
}
__device__ __forceinline__ void xcd_barrier_complete(unsigned* bar, unsigned x, unsigned& nloc, unsigned& nx) {
    const unsigned G = gridDim.x * gridDim.y * gridDim.z;
    unsigned sum, cnt, mine, sp = 0u;
    for (;;) {
        sum = 0u; cnt = 0u; mine = 0u;
#pragma unroll
        for (unsigned j = 0; j < 16; ++j) { const unsigned c = xb_ld(&bar[XB_XCNT(j)]); sum += c; cnt += (c > 0u) ? 1u : 0u; mine = (j == x) ? c : mine; }
        if (sum == G) break;
        __builtin_amdgcn_s_sleep(1);
        if ((++sp & 255u) == 0u) { if (xb_ld(&bar[XB_TMO])) break; if (sp > XB_SPIN_CAP) { atomicAdd(&bar[XB_TMO], 1u); break; } }
    }
    nloc = mine > 0u ? mine : 1u; nx = cnt > 0u ? cnt : 1u;
}
__device__ __forceinline__ void xcd_barrier(const XcdBarrier& b) {
    asm volatile("s_waitcnt vmcnt(0)" ::: "memory");
    __syncthreads();
    if (threadIdx.x == 0) {
        unsigned* bar = b.bar;
        __builtin_amdgcn_s_waitcnt(0);
        unsigned nloc = b.st[0], nx = b.st[1];
        if (nloc == 0u) { xcd_barrier_complete(bar, b.x, nloc, nx); b.st[0] = nloc; b.st[1] = nx; }
        const unsigned old = xb_add(&bar[XB_XSUB(b.x)], 1u);
        const unsigned gen = old / nloc;
        if (old + 1u == (gen + 1u) * nloc) {
            __builtin_amdgcn_fence(__ATOMIC_RELEASE, "agent");
            asm volatile("s_waitcnt vmcnt(0)" ::: "memory");
            const unsigned og = xb_add(&bar[XB_TOP], 1u);
            const unsigned tg = og / nx;
            if (og + 1u == (tg + 1u) * nx) xb_add(&bar[XB_TOPGEN], 1u);
            else XB_SPIN(xb_ld(&bar[XB_TOPGEN]) == tg, bar);
            __builtin_amdgcn_fence(__ATOMIC_ACQUIRE, "agent");
            xb_add(&bar[XB_XGEN(b.x)], 1u);
            asm volatile("s_waitcnt vmcnt(0)" ::: "memory");
        } else {
            XB_SPIN(xb_ld(&bar[XB_XGEN(b.x)]) == gen, bar);
            __builtin_amdgcn_fence(__ATOMIC_ACQUIRE, "agent");
            asm volatile("s_waitcnt vmcnt(0)" ::: "memory");
        }
    }
    __syncthreads();
}

__device__ __forceinline__ float wave_sum(float v) {
#pragma unroll
    for (int o = 1; o < 64; o <<= 1) v += __shfl_xor(v, o);
    return v;
}
__device__ __forceinline__ float wave_max(float v) {
#pragma unroll
    for (int o = 1; o < 64; o <<= 1) v = __builtin_fmaxf(v, __shfl_xor(v, o));
    return v;
}
__device__ __forceinline__ int wave_min_i(int v) {
#pragma unroll
    for (int o = 1; o < 64; o <<= 1) { const int w = __shfl_xor(v, o); v = w < v ? w : v; }
    return v;
}

struct Args { const float* in[20]; float* out; unsigned char* ws; int ph_lo, ph_hi; };
typedef const __attribute__((address_space(4))) Args* KArgs;
__device__ __forceinline__ KArgs ka_opaque() { unsigned long long p = (unsigned long long)__builtin_amdgcn_kernarg_segment_ptr(); asm volatile("" : "+s"(p)); return (KArgs)p; }
__device__ __forceinline__ int tid_opaque() { int t = threadIdx.x; asm volatile("" : "+v"(t)); return t; }

__device__ __forceinline__ void p0_transpose_item(const float* Wsrc, int K, int N, bf16* WT, int drow0, int k0, int n0, LAS float* scr, int lane) {
#pragma unroll 8
    for (int i = 0; i < 32; ++i) { const int kk = 2 * i + (lane >> 5); scr[kk * 33 + (lane & 31)] = Wsrc[(size_t)(k0 + kk) * N + n0 + (lane & 31)]; }
    LDS_WAIT(); asm volatile("" ::: "memory");
    const int c = lane & 7;
#pragma unroll
    for (int j = 0; j < 4; ++j) { const int n = (lane >> 3) + 8 * j; const LAS float* s = scr + (8 * c) * 33 + n;
        v4u o; o.x = pk2(s[0 * 33], s[1 * 33]); o.y = pk2(s[2 * 33], s[3 * 33]); o.z = pk2(s[4 * 33], s[5 * 33]); o.w = pk2(s[6 * 33], s[7 * 33]);
        *(GAS v4u*)(WT + (size_t)(drow0 + n) * K + k0 + 8 * c) = o; }
    LDS_WAIT(); asm volatile("" ::: "memory");
}
__device__ __forceinline__ bool p0_matrix(int& r, const float* src, int K, int N, bf16* dst, bool gu_rows, LAS float* scr, int lane) {
    const int nblk = N / 32, items = (K / 64) * nblk;
    if (r >= items) { r -= items; return false; }
    const int kb = r / nblk, nb = r % nblk, n0 = 32 * nb;
    int drow0 = n0;
    if (gu_rows) { const int cc = (n0 >= DFF) ? n0 - DFF : n0; drow0 = (cc >> 7) * 256 + (n0 >= DFF ? 128 : 0) + (cc & 127); }
    p0_transpose_item(src, K, N, dst, drow0, 64 * kb, n0, scr, lane);
    return true;
}
__device__ __forceinline__ void row_to_bf16(const float* xrow, bf16* orow, int lane) {
    const GAS f32x4* xr = (const GAS f32x4*)xrow + lane; GAS unsigned long long* o8 = (GAS unsigned long long*)orow + lane;
#pragma unroll
    for (int j = 0; j < 4; ++j) { const f32x4 v = xr[64 * j]; o8[64 * j] = (unsigned long long)pk2(v.x, v.y) | ((unsigned long long)pk2(v.z, v.w) << 32); }
}

__device__ __forceinline__ int t5_bucket(int rel) {
    const int n = rel < 0 ? -rel : rel;
    int b;
    if (n < 8) b = n; else b = 8 + (n >= 12) + (n >= 16) + (n >= 23) + (n >= 32) + (n >= 46) + (n >= 64) + (n >= 91);
    return (rel > 0 ? 16 : 0) + b;
}
namespace att {
typedef float f32x16 __attribute__((ext_vector_type(16)));
typedef short s16x4 __attribute__((ext_vector_type(4)));
typedef short v4i16_t __attribute__((ext_vector_type(4)));
typedef __bf16 bf16x2_t __attribute__((ext_vector_type(2)));
constexpr float LOG2E = 1.4426950408889634f;
constexpr int SLOT = 16384, LDS_K = 0, LDS_V = 2 * SLOT, LDS_STG = 4 * SLOT, STG_W = 8192;
constexpr int LW_WSF = 320, LW_FLAG = 832, LW_TAB = 896;
__device__ __forceinline__ int crow(int r, int hi) { return (r & 3) + 8 * (r >> 2) + 4 * hi; }
__device__ __forceinline__ void glds16(const void* gsrc, unsigned lds_dst) { unsigned keep;
    asm volatile("s_mov_b32 %0, m0\n\ts_mov_b32 m0, %2\n\ts_nop 0\n\tglobal_load_lds_dwordx4 %1, off\n\ts_mov_b32 m0, %0" : "=&s"(keep) : "v"(gsrc), "s"(lds_dst) : "memory"); }
__device__ __forceinline__ unsigned cvtpk(float lo, float hi) { f32x2 v = {lo, hi}; bf16x2_t b = __builtin_convertvector(v, bf16x2_t); return __builtin_bit_cast(unsigned, b); }
template <int N> __device__ __forceinline__ void wait_bar() {
    if constexpr (N == 0) asm volatile("s_waitcnt vmcnt(0) lgkmcnt(0)\n\ts_barrier" ::: "memory");
    else if constexpr (N == 2) asm volatile("s_waitcnt vmcnt(2) lgkmcnt(0)\n\ts_barrier" ::: "memory");
    else if constexpr (N == 3) asm volatile("s_waitcnt vmcnt(3) lgkmcnt(0)\n\ts_barrier" ::: "memory");
    else asm volatile("s_waitcnt vmcnt(4) lgkmcnt(0)\n\ts_barrier" ::: "memory");
}
__device__ __forceinline__ void lds_bar() { asm volatile("s_waitcnt lgkmcnt(0)\n\ts_barrier" ::: "memory"); }
typedef LAS const char* lptr;
template <int ND0> __device__ __forceinline__ void qkt(f32x16& p0, f32x16& p1, lptr kslot, const bf16x8* qr, int r32, int hi) {
    lptr kb = kslot + hi * 1024 + r32 * 16;
    p0 = (f32x16){}; p1 = (f32x16){};
#pragma unroll
    for (int d0 = 0; d0 < ND0; ++d0) {
        const bf16x8 b0 = *(const LAS bf16x8*)(kb + d0 * 2048), b1 = *(const LAS bf16x8*)(kb + d0 * 2048 + 512);
        p0 = __builtin_amdgcn_mfma_f32_32x32x16_bf16(b0, qr[d0], p0, 0, 0, 0); p1 = __builtin_amdgcn_mfma_f32_32x32x16_bf16(b1, qr[d0], p1, 0, 0, 0); }
}
__device__ __forceinline__ s16x4 vtr(lptr p) { return __builtin_bit_cast(s16x4, __builtin_amdgcn_ds_read_tr16_b64_v4i16((LAS v4i16_t*)p)); }
template <int NDB> __device__ __forceinline__ void pv(f32x16* o, lptr vb, v4u pw0, v4u pw1, v4u pw2, v4u pw3) {
#pragma unroll
    for (int db = 0; db < NDB; ++db) {
#pragma unroll
        for (int ks = 0; ks < 4; ++ks) {
            const s16x4 lo = vtr(vb + db * 4096 + ks * 1024), hh = vtr(vb + db * 4096 + ks * 1024 + 512);
            const bf16x8 vf = (bf16x8){lo[0], lo[1], lo[2], lo[3], hh[0], hh[1], hh[2], hh[3]};
            const v4u pw = ks == 0 ? pw0 : ks == 1 ? pw1 : ks == 2 ? pw2 : pw3;
            o[db] = __builtin_amdgcn_mfma_f32_32x32x16_bf16(__builtin_bit_cast(bf16x8, pw), vf, o[db], 0, 0, 0); }
    }
}
__device__ __forceinline__ void pack_p(const f32x16& p0, const f32x16& p1, v4u& pw0, v4u& pw1, v4u& pw2, v4u& pw3) {
    pw0 = (v4u){cvtpk(p0[0], p0[1]), cvtpk(p0[2], p0[3]), cvtpk(p0[4], p0[5]), cvtpk(p0[6], p0[7])};
    pw1 = (v4u){cvtpk(p0[8], p0[9]), cvtpk(p0[10], p0[11]), cvtpk(p0[12], p0[13]), cvtpk(p0[14], p0[15])};
    pw2 = (v4u){cvtpk(p1[0], p1[1]), cvtpk(p1[2], p1[3]), cvtpk(p1[4], p1[5]), cvtpk(p1[6], p1[7])};
    pw3 = (v4u){cvtpk(p1[8], p1[9]), cvtpk(p1[10], p1[11]), cvtpk(p1[12], p1[13]), cvtpk(p1[14], p1[15])};
}
__device__ __forceinline__ float half_swap(float x, int hi) {
    auto rr = __builtin_amdgcn_permlane32_swap(__float_as_uint(x), __float_as_uint(x), false, false);
    return __uint_as_float(hi ? rr[0] : rr[1]);
}
__device__ __forceinline__ float rowmax32(const f32x16& p0, const f32x16& p1, int hi) {
    float a = __builtin_fmaxf(p0[0], p1[0]);
#pragma unroll
    for (int r = 1; r < 16; ++r) a = __builtin_fmaxf(a, __builtin_fmaxf(p0[r], p1[r]));
    return __builtin_fmaxf(a, half_swap(a, hi));
}
template <int NKC  , int NVP  >
__device__ __forceinline__ void dma_tile(const bf16* Kt, const bf16* Vt, int pitch, unsigned kdst, unsigned vdst, int wid, int lane) {
#pragma unroll
    for (int i = 0; i < NKC; ++i) { const int c = wid + 8 * i; glds16(Kt + (size_t)lane * pitch + c * 8, (unsigned)__builtin_amdgcn_readfirstlane(kdst + c * 1024)); }
#pragma unroll
    for (int i = 0; i < NVP; ++i) { const int pc = wid + 8 * i, dh = pc >> 2, rg = pc & 3;
        glds16(Vt + (size_t)(16 * rg + (lane >> 2)) * pitch + dh * 32 + (lane & 3) * 8, (unsigned)__builtin_amdgcn_readfirstlane(vdst + pc * 1024)); }
}
template <int NDB> __device__ __forceinline__ void store_o(const f32x16* o, const float* rsc  , LAS unsigned char* stg, bf16* Yw  , int lane, int r32, int hi) {
    LAS bf16* st = (LAS bf16*)stg;
#pragma unroll
    for (int r = 0; r < 16; ++r) { const int orow = crow(r, hi);
#pragma unroll
        for (int db = 0; db < NDB; ++db) st[orow * (NDB * 32) + db * 32 + r32] = (bf16)f2bf(o[db][r] * rsc[r]); }
    LDS_WAIT();
    constexpr int CPR = NDB * 4;
#pragma unroll
    for (int i = 0; i < (32 * CPR) / 64; ++i) { const int idx = i * 64 + lane, row = idx / CPR, ch = idx % CPR;
        const v4u v = *(const LAS v4u*)(stg + row * (NDB * 64) + ch * 16); *(v4u*)(Yw + (size_t)row * W + ch * 8) = v; }
    LDS_WAIT();
}

__device__ __forceinline__ void sb_unit(LAS unsigned char* lds, volatile LAS unsigned* LWv, const bf16* proj, bf16* ysb, int b, int h, int qt, int, int) {
    const int tid_ = tid_opaque(), lane = tid_ & 63, wid = __builtin_amdgcn_readfirstlane(tid_ >> 6);
    const int r32 = lane & 31, hi = lane >> 5, q0 = qt * 256, qw0 = q0 + 32 * wid;
    const size_t rowb = (size_t)b * SEQ;
    const bf16* Qw = proj + (rowb + qw0) * INW + h * 64; const bf16* Kh = proj + rowb * INW + W + h * 64; const bf16* Vh = proj + rowb * INW + 2 * W + h * 64;
    const unsigned lds0 = (unsigned)(uintptr_t)lds;
    bf16x8 qr[4];
#pragma unroll
    for (int d0 = 0; d0 < 4; ++d0) qr[d0] = *(const bf16x8*)(Qw + (size_t)r32 * INW + d0 * 16 + hi * 8);
    f32x16 o[2]; o[0] = (f32x16){}; o[1] = (f32x16){};
    float R = 0.f;
    const float SC = 0.125f * LOG2E, RTH = 104.0f * LOG2E;
    bool done = false;
    const int jmax = q0 / 64 + 3;
    lptr vb = (lptr)lds + LDS_V + ((lane >> 4) & 1) * 32 + (lane & 3) * 8 + (4 * hi + ((lane & 15) >> 2)) * 64;
    dma_tile<1, 1>(Kh + (size_t)jmax * 64 * INW, Vh + (size_t)jmax * 64 * INW, INW, lds0 + LDS_K, lds0 + LDS_V, wid, lane);
    int slot = 0;
#pragma unroll 1
    for (int j = jmax; j >= 0; --j) {
        if (j > 0) { dma_tile<1, 1>(Kh + (size_t)(j - 1) * 64 * INW, Vh + (size_t)(j - 1) * 64 * INW, INW, lds0 + LDS_K + (slot ^ 1) * SLOT, lds0 + LDS_V + (slot ^ 1) * SLOT, wid, lane); wait_bar<2>(); }
        else wait_bar<0>();
        const int delta = qw0 - 64 * j;
        if (!done && delta > -31) {
            f32x16 p0, p1;
            qkt<4>((f32x16&)p0, (f32x16&)p1, (lptr)lds + LDS_K + slot * SLOT, qr, r32, hi);
#pragma unroll
            for (int r = 0; r < 16; ++r) { p0[r] *= SC; p1[r] *= SC; }
            if (delta < 64 + 31) {
#pragma unroll
                for (int r = 0; r < 16; ++r) { const int kv = crow(r, hi) - r32; if (!(kv < delta)) p0[r] = -INFINITY; if (!(kv + 32 < delta)) p1[r] = -INFINITY; }
            }
            f32x16 s0, s1;
#pragma unroll
            for (int r = 0; r < 16; ++r) {
                s0[r] = __builtin_fmaxf(p0[r], 0.f) + __builtin_amdgcn_logf(1.0f + __builtin_amdgcn_exp2f(-__builtin_fabsf(p0[r])));
                s1[r] = __builtin_fmaxf(p1[r], 0.f) + __builtin_amdgcn_logf(1.0f + __builtin_amdgcn_exp2f(-__builtin_fabsf(p1[r]))); }
#pragma unroll
            for (int g = 0; g < 4; ++g) { s0[4 * g + 2] += s0[4 * g + 3]; s0[4 * g + 1] += s0[4 * g + 2]; s0[4 * g] += s0[4 * g + 1]; s1[4 * g + 2] += s1[4 * g + 3]; s1[4 * g + 1] += s1[4 * g + 2]; s1[4 * g] += s1[4 * g + 1]; }
            float To[8], Tp[8], F[8];
#pragma unroll
            for (int g = 0; g < 4; ++g) { To[g] = s0[4 * g]; To[4 + g] = s1[4 * g]; }
#pragma unroll
            for (int g = 0; g < 8; ++g) Tp[g] = half_swap(To[g], hi);
            F[7] = 0.f;
#pragma unroll
            for (int g = 6; g >= 0; --g) F[g] = F[g + 1] + (To[g + 1] + Tp[g + 1]);
            const float total = F[0] + (To[0] + Tp[0]);
#pragma unroll
            for (int g = 0; g < 8; ++g) { const float E = R + F[g] + (hi == 0 ? Tp[g] : 0.f);
#pragma unroll
                for (int i = 0; i < 4; ++i) { if (g < 4) p0[4 * g + i] = __builtin_amdgcn_exp2f(p0[4 * g + i] - (E + s0[4 * g + i])); else p1[4 * (g - 4) + i] = __builtin_amdgcn_exp2f(p1[4 * (g - 4) + i] - (E + s1[4 * (g - 4) + i])); } }
            R += total;
            v4u pw0, pw1, pw2, pw3; pack_p(p0, p1, pw0, pw1, pw2, pw3);
            pv<2>(o, vb + slot * SLOT, pw0, pw1, pw2, pw3);
            done = __all(R > RTH);
        }
        if (lane == 0) LWv[LW_FLAG + wid] = (done || j == 0) ? 1u : 0u;
        lds_bar();
        unsigned alld = 1u;
#pragma unroll
        for (int w = 0; w < 8; ++w) alld &= LWv[LW_FLAG + w];
        slot ^= 1;
        if (alld) break;
    }
    wait_bar<0>();
    float ones[16];
#pragma unroll
    for (int r = 0; r < 16; ++r) ones[r] = 1.0f;
    store_o<2>(o, ones, lds + LDS_STG + wid * STG_W, ysb + (rowb + qw0) * W + h * 64, lane, r32, hi);
}

template <int NDB> __device__ __forceinline__ void softmax_tile(f32x16& p0, f32x16& p1, f32x16* o, float& m, float& l, float sc, float cb, const LAS float* tabp, volatile LAS float* wsf, int r32, int hi) {
    if (tabp) {
#pragma unroll
        for (int r = 0; r < 16; ++r) { p0[r] = p0[r] * sc + tabp[crow(r, 0)]; p1[r] = p1[r] * sc + tabp[32 + crow(r, 0)]; }
    } else {
#pragma unroll
        for (int r = 0; r < 16; ++r) { p0[r] = p0[r] * sc + cb; p1[r] = p1[r] * sc + cb; }
    }
    const float rm = rowmax32(p0, p1, hi);
    if (__any(rm > m + 8.0f)) {
        const float mn = __builtin_fmaxf(m, rm), f = __builtin_amdgcn_exp2f(m - mn);
        l *= f; m = mn;
        if (hi == 0) wsf[r32] = f;
        LDS_WAIT();
#pragma unroll
        for (int r = 0; r < 16; ++r) { const float fr_ = wsf[crow(r, hi)];
#pragma unroll
            for (int db = 0; db < NDB; ++db) o[db][r] *= fr_; }
        LDS_WAIT();
    }
    float s = 0.f;
#pragma unroll
    for (int r = 0; r < 16; ++r) { p0[r] = __builtin_amdgcn_exp2f(p0[r] - m); p1[r] = __builtin_amdgcn_exp2f(p1[r] - m); s += p0[r] + p1[r]; }
    l += s;
}
__device__ __forceinline__ void row_inv_l(float l, float* rli, volatile LAS float* wsf, int r32, int hi) {
    l += half_swap(l, hi);
    if (hi == 0) wsf[r32] = l;
    LDS_WAIT();
#pragma unroll
    for (int r = 0; r < 16; ++r) rli[r] = __builtin_amdgcn_rcpf(wsf[crow(r, hi)]);
    LDS_WAIT();
}

__device__ __forceinline__ void df_unit(LAS unsigned char* lds, volatile LAS unsigned* LWv, const bf16* proj, bf16* ydf, const float* subg, float lam, float outscale, int b, int H, int qt, int, int) {
    const int tid_ = tid_opaque(), lane = tid_ & 63, wid = __builtin_amdgcn_readfirstlane(tid_ >> 6);
    const int r32 = lane & 31, hi = lane >> 5, q0 = qt * 256, qw0 = q0 + 32 * wid;
    const size_t rowb = (size_t)b * SEQ;
    const bf16* Vh = proj + rowb * INW + 5 * W + H * 128;
    const unsigned lds0 = (unsigned)(uintptr_t)lds;
    volatile LAS float* wsf = (volatile LAS float*)(LWv + LW_WSF + wid * 64);
    LAS unsigned char* stg = lds + LDS_STG + wid * STG_W;
    lptr vb = (lptr)lds + LDS_V + ((lane >> 4) & 1) * 32 + (lane & 3) * 8 + (4 * hi + ((lane & 15) >> 2)) * 64;
    const int jmax = q0 / 64 + 3, jw = qw0 / 64;
    const float SC = 0.125f * LOG2E;
    f32x16 o[4];
#pragma unroll 1
    for (int mp = 0; mp < 2; ++mp) {
        const int h2 = 2 * H + mp;
        const bf16* Qw = proj + (rowb + qw0) * INW + 3 * W + h2 * 64; const bf16* Kh = proj + rowb * INW + 4 * W + h2 * 64;
        const LAS float* tab = (const LAS float*)(LWv + LW_TAB) + h2 * 256;
        const float cfar = tab[0];
        bf16x8 qr[4];
#pragma unroll
        for (int d0 = 0; d0 < 4; ++d0) qr[d0] = *(const bf16x8*)(Qw + (size_t)r32 * INW + d0 * 16 + hi * 8);
#pragma unroll
        for (int db = 0; db < 4; ++db) o[db] = (f32x16){};
        float m = -INFINITY, l = 0.f;
        dma_tile<1, 2>(Kh, Vh, INW, lds0 + LDS_K, lds0 + LDS_V, wid, lane);
        int slot = 0;
#pragma unroll 1
        for (int j = 0; j <= jmax; ++j) {
            if (j < jmax) { dma_tile<1, 2>(Kh + (size_t)(j + 1) * 64 * INW, Vh + (size_t)(j + 1) * 64 * INW, INW, lds0 + LDS_K + (slot ^ 1) * SLOT, lds0 + LDS_V + (slot ^ 1) * SLOT, wid, lane); wait_bar<3>(); }
            else wait_bar<0>();
            if (j <= jw) {
                f32x16 p0, p1;
                qkt<4>(p0, p1, (lptr)lds + LDS_K + slot * SLOT, qr, r32, hi);
                const int relmax = 64 * j + 63 - qw0;
                const LAS float* tabp = (relmax > -91) ? tab + (64 * j - qw0 + 192 + 4 * hi - r32) : nullptr;
                softmax_tile<4>(p0, p1, o, m, l, SC, cfar, tabp, wsf, r32, hi);
                v4u pw0, pw1, pw2, pw3; pack_p(p0, p1, pw0, pw1, pw2, pw3);
                pv<4>(o, vb + slot * SLOT, pw0, pw1, pw2, pw3);
            }
            lds_bar();
            slot ^= 1;
        }
        float rli[16]; row_inv_l(l, rli, wsf, r32, hi);
        LAS bf16* st = (LAS bf16*)stg;
        if (mp == 0) {
#pragma unroll
            for (int r = 0; r < 16; ++r) { const int orow = crow(r, hi);
#pragma unroll
                for (int db = 0; db < 4; ++db) st[orow * 128 + db * 32 + r32] = (bf16)f2bf(o[db][r] * rli[r]); }
            LDS_WAIT();
        } else {
            float ss[16];
#pragma unroll
            for (int r = 0; r < 16; ++r) { const int orow = crow(r, hi); float q = 0.f;
#pragma unroll
                for (int db = 0; db < 4; ++db) { const float a = bf2f(st[orow * 128 + db * 32 + r32]) - lam * (o[db][r] * rli[r]); o[db][r] = a; q += a * a; }
                ss[r] = q; }
#pragma unroll
            for (int r = 0; r < 16; ++r) { float q = ss[r];
#pragma unroll
                for (int x = 1; x < 32; x <<= 1) q += __shfl_xor(q, x);
                ss[r] = __builtin_amdgcn_rsqf(q * (1.0f / 128.0f) + RMS_EPS) * outscale; }
#pragma unroll
            for (int db = 0; db < 4; ++db) { const float g = subg[db * 32 + r32];
#pragma unroll
                for (int r = 0; r < 16; ++r) o[db][r] *= g; }
            LDS_WAIT();
            store_o<4>(o, ss, stg, ydf + (rowb + qw0) * W + H * 128, lane, r32, hi);
        }
    }
}

__device__ __forceinline__ void mem_unit(LAS unsigned char* lds, volatile LAS unsigned* LWv, const bf16* proj, const bf16* memkv, bf16* ymem, int b, int h, int qt, int, int) {
    const int tid_ = tid_opaque(), lane = tid_ & 63, wid = __builtin_amdgcn_readfirstlane(tid_ >> 6);
    const int r32 = lane & 31, hi = lane >> 5, q0 = qt * 256, qw0 = q0 + 32 * wid;
    const size_t rowb = (size_t)b * SEQ;
    const bf16* Qw = proj + (rowb + qw0) * INW + 6 * W + h * 128; const bf16* Kh = memkv + (size_t)b * MEML * 1024 + h * 128; const bf16* Vh = Kh + W;
    const unsigned lds0 = (unsigned)(uintptr_t)lds;
    volatile LAS float* wsf = (volatile LAS float*)(LWv + LW_WSF + wid * 64);
    lptr vb = (lptr)lds + LDS_V + ((lane >> 4) & 1) * 32 + (lane & 3) * 8 + (4 * hi + ((lane & 15) >> 2)) * 64;
    bf16x8 qr[8];
#pragma unroll
    for (int d0 = 0; d0 < 8; ++d0) qr[d0] = *(const bf16x8*)(Qw + (size_t)r32 * INW + d0 * 16 + hi * 8);
    f32x16 o[4];
#pragma unroll
    for (int db = 0; db < 4; ++db) o[db] = (f32x16){};
    float m = -INFINITY, l = 0.f;
    const float SC = 0.08838834764831845f * LOG2E;
    dma_tile<2, 2>(Kh, Vh, 1024, lds0 + LDS_K, lds0 + LDS_V, wid, lane);
    int slot = 0;
#pragma unroll 1
    for (int j = 0; j < MEML / 64; ++j) {
        if (j + 1 < MEML / 64) { dma_tile<2, 2>(Kh + (size_t)(j + 1) * 64 * 1024, Vh + (size_t)(j + 1) * 64 * 1024, 1024, lds0 + LDS_K + (slot ^ 1) * SLOT, lds0 + LDS_V + (slot ^ 1) * SLOT, wid, lane); wait_bar<4>(); }
        else wait_bar<0>();
        f32x16 p0, p1;
        qkt<8>(p0, p1, (lptr)lds + LDS_K + slot * SLOT, qr, r32, hi);
        softmax_tile<4>(p0, p1, o, m, l, SC, 0.f, nullptr, wsf, r32, hi);
        v4u pw0, pw1, pw2, pw3; pack_p(p0, p1, pw0, pw1, pw2, pw3);
        pv<4>(o, vb + slot * SLOT, pw0, pw1, pw2, pw3);
        lds_bar();
        slot ^= 1;
    }
    float rli[16]; row_inv_l(l, rli, wsf, r32, hi);
    store_o<4>(o, rli, lds + LDS_STG + wid * STG_W, ymem + (rowb + qw0) * W + h * 128, lane, r32, hi);
}
}

#define PH_LOCALS() KArgs ka = ka_opaque(); unsigned char* ws = ka->ws; const int tid = tid_opaque(), lane = tid & 63, wave = __builtin_amdgcn_readfirstlane(tid >> 6); \
    const int G = gridDim.x, bx = blockIdx.x, vcu = (G % 8 == 0) ? (bx % 8) * (G / 8) + bx / 8 : bx, gw = vcu * NWAVES + wave, NGW = G * NWAVES; \
    (void)ws; (void)lane; (void)wave; (void)gw; (void)NGW; (void)vcu; (void)bx
__global__ void __launch_bounds__(NWAVES * 64, 2) mk_fwd(Args args) {
    extern __shared__ __attribute__((aligned(16))) unsigned char lds_raw[];
    LAS unsigned char* lds = (LAS unsigned char*)lds_raw;
    volatile LAS unsigned* LW = (volatile LAS unsigned*)(lds + LDSCTL_OFF);
    for (int u = threadIdx.x; u < (LDS_BYTES - LDSCTL_OFF) / 4; u += NWAVES * 64) ((LAS unsigned*)(lds + LDSCTL_OFF))[u] = 0u;
    __syncthreads();
#if MK_ONE_LAUNCH
    XcdBarrier bar = xcd_barrier_post((unsigned*)((gu32*)(args.ws + WS_CTL) + CW_BAR), LW + LW_BAR);
#define GRID_BAR() xcd_barrier(bar)
#else
#define GRID_BAR() do {} while (0)
#endif
    const int lo = args.ph_lo, hi = args.ph_hi;
#define IN(k) (lo <= (k) && (k) < hi)
#define BOTH(k) (IN(k) && IN((k) + 1))

    if (PH_EN(0) && IN(0)) {
        PH_LOCALS();
        LAS float* scr = (LAS float*)(lds + RING_OFF + wave * 16384);
        constexpr int I_IN = 16 * (INW / 32), I_SQ = 16 * 32, I_BR = 8 * 32, I_GU = 16 * 64, I_D = 16 * 32;
        constexpr int PER_LAYER = I_IN + I_SQ + 3 * I_BR + I_SQ + NE * I_GU + NE * I_D;
#pragma unroll 1
        for (int it = gw; it < DEPTH * PER_LAYER; it += NGW) {
            const int l = it / PER_LAYER; int r = it % PER_LAYER;
            if (p0_matrix(r, ka->in[2] + (size_t)l * D * INW, D, INW, (bf16*)(ws + WS_WIN) + (size_t)l * INW * D, false, scr, lane)) continue;
            if (p0_matrix(r, ka->in[7] + (size_t)l * D * 1024, D, 1024, (bf16*)(ws + WS_WMEMKV) + (size_t)l * 1024 * D, false, scr, lane)) continue;
            if (r < 3 * I_BR) { const int b = r / I_BR; int rr = r % I_BR;
                p0_matrix(rr, ka->in[8] + ((size_t)l * 3 + b) * W * D, W, D, (bf16*)(ws + WS_WBR) + ((size_t)l * 3 + b) * D * W, false, scr, lane); continue; }
            r -= 3 * I_BR;
            if (p0_matrix(r, ka->in[9] + (size_t)l * D * D, D, D, (bf16*)(ws + WS_WOUT) + (size_t)l * D * D, false, scr, lane)) continue;
            if (r < NE * I_GU) { const int e = r / I_GU; int rr = r % I_GU;
                p0_matrix(rr, ka->in[14] + ((size_t)l * NE + e) * D * 2 * DFF, D, 2 * DFF, (bf16*)(ws + WS_WGU) + ((size_t)l * NE + e) * 2 * DFF * D, true, scr, lane); continue; }
            r -= NE * I_GU;
            { const int e = r / I_D; int rr = r % I_D;
                p0_matrix(rr, ka->in[16] + ((size_t)l * NE + e) * DFF * D, DFF, D, (bf16*)(ws + WS_WD) + ((size_t)l * NE + e) * D * DFF, false, scr, lane); }
        }
        { const float* x_in = ka->in[0]; bf16* XN = (bf16*)(ws + WS_XN);
#pragma unroll 1
          for (int m = gw; m < T; m += NGW) row_to_bf16(x_in + (size_t)m * D, XN + (size_t)m * D, lane); }
        { const float* mem_in = ka->in[1]; bf16* MEMB = (bf16*)(ws + WS_MEMB);
#pragma unroll 1
          for (int m = gw; m < MEMT; m += NGW) row_to_bf16(mem_in + (size_t)m * D, MEMB + (size_t)m * D, lane); }
        if (BOTH(0)) GRID_BAR();
    }

#pragma unroll 1
    for (int l = 0; l < DEPTH; ++l) {
        const int pb = 1 + 8 * l;
        if (PH_EN(1) && IN(pb + 0)) {
            { PH_LOCALS();
              pg8::DenseOrder S{(const char*)(ws + WS_XN), (const char*)((bf16*)(ws + WS_WIN) + (size_t)l * INW * D), T / 256, INW / 256, G, bx, D};
              pg8::EpiProj E{(bf16*)(ws + WS_PROJ), INW, ka->in[3] + (size_t)l * 3 * D, GATE0};
              pg8::gemm_phase<pg8::EpiProj, pg8::DenseOrder, false, true>(lds + RING_OFF, D, S, E); }
            { PH_LOCALS();
              pg8::DenseOrder S{(const char*)(ws + WS_MEMB), (const char*)((bf16*)(ws + WS_WMEMKV) + (size_t)l * 1024 * D), MEMT / 256, 1024 / 256, G, bx, D};
              pg8::EpiProj E{(bf16*)(ws + WS_MEMKV), 1024, nullptr, 1 << 30};
              pg8::gemm_phase<pg8::EpiProj, pg8::DenseOrder, false, true>(lds + RING_OFF, D, S, E); }
            if (BOTH(pb + 0)) GRID_BAR();
        }
        if (PH_EN(2) && IN(pb + 1)) {
            PH_LOCALS();
            const bf16* PROJ = (const bf16*)(ws + WS_PROJ); bf16* YB = (bf16*)(ws + WS_Y);
            { LAS float* tab = (LAS float*)(lds + LDSCTL_OFF) + att::LW_TAB; const float* rel_bias = ka->in[6];
              for (int i = tid; i < 8 * 256; i += NWAVES * 64) tab[i] = rel_bias[t5_bucket((i & 255) - 192) * 8 + (i >> 8)] * att::LOG2E; }
            float lam, outscale;
            { const float* dl = ka->in[4] + (size_t)l * 256; float s1 = 0.f, s2 = 0.f;
              for (int i = 0; i < 64; ++i) { s1 += dl[i] * dl[64 + i]; s2 += dl[128 + i] * dl[192 + i]; }
              const float lam_init = 0.8f - 0.6f * expf(-0.3f * (float)l); lam = expf(s1) - expf(s2) + lam_init; outscale = 1.0f - lam_init; }
            __syncthreads();
            const float* subg = ka->in[5] + (size_t)l * 128;
#pragma unroll 1
            for (int it = vcu; ATT_EN(0) && it < BATCH * 4 * 8; it += G) { const int bH = it >> 3, s8 = it & 7;
#pragma unroll 1
                for (int z = 0; z < 2; ++z) att::df_unit(lds, LW, PROJ, YB + (size_t)T * W, subg, lam, outscale, bH >> 2, bH & 3, z ? s8 : 15 - s8, wave, lane); }
#pragma unroll 1
            for (int u = vcu; ATT_EN(1) && u < BATCH * 8 * 16; u += G) { const int bh = u >> 4; att::sb_unit(lds, LW, PROJ, YB, bh >> 3, bh & 7, u & 15, wave, lane); }
#pragma unroll 1
            for (int u = vcu; ATT_EN(2) && u < BATCH * 4 * 16; u += G) { const int bh = u >> 4; att::mem_unit(lds, LW, PROJ, (const bf16*)(ws + WS_MEMKV), YB + (size_t)2 * T * W, bh >> 2, bh & 3, u & 15, wave, lane); }
            if (BOTH(pb + 1)) GRID_BAR();
        }
        if (PH_EN(3) && IN(pb + 2)) {
            PH_LOCALS();
            pg8::BranchOrder S{(const char*)(ws + WS_Y), (const char*)((bf16*)(ws + WS_WBR) + (size_t)l * 3 * D * W), T / 256, D / 256, G, bx};
            pg8::EpiBranch E{(const bf16*)(ws + WS_PROJ), (bf16*)(ws + WS_MERGED)};
            pg8::gemm_phase<pg8::EpiBranch, pg8::BranchOrder, false, true>(lds + RING_OFF, W, S, E);
            if (BOTH(pb + 2)) GRID_BAR();
        }
        if (PH_EN(4) && IN(pb + 3)) {
            PH_LOCALS();
            const float* xprev = (l == 0) ? ka->in[0] : ka->out;
            pg8::DenseOrder S{(const char*)(ws + WS_MERGED), (const char*)((bf16*)(ws + WS_WOUT) + (size_t)l * D * D), T / 256, D / 256, G, bx, D};
            pg8::EpiOut E{xprev, (float*)(ws + WS_X1)};
            pg8::gemm_phase<pg8::EpiOut, pg8::DenseOrder, false, true>(lds + RING_OFF, D, S, E);
            if (BOTH(pb + 3)) GRID_BAR();
        }
        if (PH_EN(5) && IN(pb + 4)) {
            PH_LOCALS();
            gu32* ctl = (gu32*)(ws + WS_CTL); float* X1 = (float*)(ws + WS_X1); bf16* XN = (bf16*)(ws + WS_XN); int* PERM = (int*)(ws + WS_PERM); float* SLOTW = (float*)(ws + WS_SLOTW);
            LAS float* WT = (LAS float*)(lds + RING_OFF);
            const float* rw = ka->in[12] + (size_t)l * D * NE; const float* rb = ka->in[13] + (size_t)l * NE;
            for (int i = tid; i < D * NE; i += NWAVES * 64) { const int k = i >> 5, e = i & 31; WT[e * D + k] = rw[i]; }
            if (tid < NE) LW[LW_RCNT + tid] = 0u;
            __syncthreads();
            const float* g1 = ka->in[10] + (size_t)l * D; const float* b1 = ka->in[11] + (size_t)l * D;
            f32x4 gv[4], bv[4];
#pragma unroll
            for (int j = 0; j < 4; ++j) { gv[j] = *(const f32x4*)(g1 + 256 * j + 4 * lane); bv[j] = *(const f32x4*)(b1 + 256 * j + 4 * lane); }
            const int rows_per_wg = (T + G - 1) / G, rows_per_wave = (rows_per_wg + NWAVES - 1) / NWAVES;
            const int rbase = vcu * rows_per_wg + wave * rows_per_wave;
            const float myrb = rb[(lane >> 1) & 31];
#pragma unroll 1
            for (int ri = 0; ri < rows_per_wave; ++ri) {
                const int m = rbase + ri; if (m >= T || (wave * rows_per_wave + ri) >= rows_per_wg) break;
                GAS f32x4* xr = (GAS f32x4*)(X1 + (size_t)m * D) + lane;
                f32x4 v[4]; float s = 0.f;
#pragma unroll
                for (int j = 0; j < 4; ++j) { v[j] = xr[64 * j]; s += (v[j].x + v[j].y) + (v[j].z + v[j].w); }
                const float mean = wave_sum(s) * (1.f / D); float s2 = 0.f;
#pragma unroll
                for (int j = 0; j < 4; ++j) { v[j] = v[j] - mean; s2 += (v[j].x * v[j].x + v[j].y * v[j].y) + (v[j].z * v[j].z + v[j].w * v[j].w); }
                const float rstd = 1.f / sqrtf(wave_sum(s2) * (1.f / D) + LN_EPS);
                GAS unsigned long long* o8 = (GAS unsigned long long*)(XN + (size_t)m * D) + lane;
#pragma unroll
                for (int j = 0; j < 4; ++j) { v[j] = v[j] * rstd * gv[j] + bv[j]; xr[64 * j] = v[j];
                    o8[64 * j] = (unsigned long long)pk2(v[j].x, v[j].y) | ((unsigned long long)pk2(v[j].z, v[j].w) << 32); }
                float p[NE];
#pragma unroll
                for (int e = 0; e < NE; ++e) { float a = 0.f;
#pragma unroll
                    for (int j = 0; j < 4; ++j) { const f32x4 w = *(const LAS f32x4*)(WT + e * D + 256 * j + 4 * lane); a += (v[j].x * w.x + v[j].y * w.y) + (v[j].z * w.z + v[j].w * w.w); }
                    p[e] = a; }
#pragma unroll
                for (int e = 0; e < 16; ++e) { const bool up = (lane & 32) != 0; const float keep = up ? p[e + 16] : p[e], send = up ? p[e] : p[e + 16]; p[e] = keep + __shfl_xor(send, 32); }
#pragma unroll
                for (int e = 0; e < 8; ++e) { const bool up = (lane & 16) != 0; const float keep = up ? p[e + 8] : p[e], send = up ? p[e] : p[e + 8]; p[e] = keep + __shfl_xor(send, 16); }
#pragma unroll
                for (int e = 0; e < 4; ++e) { const bool up = (lane & 8) != 0; const float keep = up ? p[e + 4] : p[e], send = up ? p[e] : p[e + 4]; p[e] = keep + __shfl_xor(send, 8); }
#pragma unroll
                for (int e = 0; e < 2; ++e) { const bool up = (lane & 4) != 0; const float keep = up ? p[e + 2] : p[e], send = up ? p[e] : p[e + 2]; p[e] = keep + __shfl_xor(send, 4); }
                { const bool up = (lane & 2) != 0; const float keep = up ? p[1] : p[0], send = up ? p[0] : p[1]; p[0] = keep + __shfl_xor(send, 2); }
                float logit = p[0] + __shfl_xor(p[0], 1) + myrb;
                const int myexp = (lane >> 1) & 31;
                float tv[TOPK]; int te[TOPK];
#pragma unroll
                for (int k = 0; k < TOPK; ++k) { const float mx = wave_max(logit); const int cand = (logit == mx) ? myexp : 99; const int em = wave_min_i(cand); tv[k] = mx; te[k] = em; if (myexp == em) logit = -INFINITY; }
                float ew[TOPK], es = 0.f;
#pragma unroll
                for (int k = 0; k < TOPK; ++k) { ew[k] = fast_exp(tv[k] - tv[0]); es += ew[k]; }
                const float inv = 1.0f / es;
                if (lane < TOPK) {
                    const int ek = lane == 0 ? te[0] : lane == 1 ? te[1] : lane == 2 ? te[2] : te[3];
                    const float wk = (lane == 0 ? ew[0] : lane == 1 ? ew[1] : lane == 2 ? ew[2] : ew[3]) * inv;
                    const unsigned lr = __hip_atomic_fetch_add((LAS unsigned*)(LW + LW_RCNT + ek), 1u, __ATOMIC_RELAXED, __HIP_MEMORY_SCOPE_WORKGROUP);
                    LW[LW_RSLOT + wave * RSLOT_STRIDE + ri * 4 + lane] = ((unsigned)ek << 16) | lr;
                    SLOTW[(size_t)m * 4 + lane] = wk;
                }
            }
            __syncthreads();
            if (tid < NE) { const unsigned c = LW[LW_RCNT + tid]; LW[LW_RBASE + tid] = c ? __hip_atomic_fetch_add(ctl + CW_CNT + (l * NE + tid) * 64, c, RLX_AGENT) : 0u; }
            __syncthreads();
            for (int q = lane; q < rows_per_wave * 4; q += 64) { const int ri = q >> 2, m = rbase + ri;
                if (m < T && (wave * rows_per_wave + ri) < rows_per_wg) { const unsigned ent = LW[LW_RSLOT + wave * RSLOT_STRIDE + q]; const unsigned e = ent >> 16, lr = ent & 0xffffu;
                    PERM[(size_t)e * T + LW[LW_RBASE + e] + lr] = m * 4 + (q & 3); } }
            if (BOTH(pb + 4)) GRID_BAR();
        }
        if ((PH_EN(6) && IN(pb + 5)) || (PH_EN(7) && IN(pb + 6))) {
            PH_LOCALS();
            gu32* ctl = (gu32*)(ws + WS_CTL);
            __syncthreads();
            if (tid == 0) { int acc_t = 0;
                for (int e = 0; e < NE; ++e) { const int c = (int)__hip_atomic_load(ctl + CW_CNT + (l * NE + e) * 64, RLX_AGENT); LW[LW_LCNT + e] = (unsigned)c; LW[LW_TOFF + e] = (unsigned)acc_t; acc_t += (c + 255) >> 8; }
                LW[LW_TOFF + NE] = (unsigned)acc_t; }
            __syncthreads();
        }
        if (PH_EN(6) && IN(pb + 5)) {
            PH_LOCALS();
            const LAS int* toff = (const LAS int*)(lds + LDSCTL_OFF) + LW_TOFF; const LAS int* lcnt = (const LAS int*)(lds + LDSCTL_OFF) + LW_LCNT;
            pg8::MoeOrder S{(const char*)(ws + WS_XN), (const char*)((bf16*)(ws + WS_WGU) + (size_t)l * NE * 2 * DFF * D), 2 * DFF / 256, toff[NE], G, bx, D, (size_t)2 * DFF * D * 2, toff, lcnt, (const int*)(ws + WS_PERM)};
            pg8::EpiGateUp E{(bf16*)(ws + WS_ACT), ka->in[15] + (size_t)l * NE * 2 * DFF};
            pg8::gemm_phase<pg8::EpiGateUp, pg8::MoeOrder, true, true>(lds + RING_OFF, D, S, E);
            if (BOTH(pb + 5)) GRID_BAR();
        }
        if (PH_EN(7) && IN(pb + 6)) {
            PH_LOCALS();
            const LAS int* toff = (const LAS int*)(lds + LDSCTL_OFF) + LW_TOFF; const LAS int* lcnt = (const LAS int*)(lds + LDSCTL_OFF) + LW_LCNT;
            pg8::MoeDenseOrder S{{(const char*)(ws + WS_ACT), (const char*)((bf16*)(ws + WS_WD) + (size_t)l * NE * D * DFF), D / 256, toff[NE], G, bx, DFF, (size_t)D * DFF * 2, toff, lcnt, (const int*)(ws + WS_PERM)}};
            pg8::EpiDown E{(bf16*)(ws + WS_CONTRIB), ka->in[17] + (size_t)l * NE * D, (const int*)(ws + WS_PERM), (const float*)(ws + WS_SLOTW), lcnt};
            pg8::gemm_phase<pg8::EpiDown, pg8::MoeDenseOrder, false, true>(lds + RING_OFF, DFF, S, E);
            if (BOTH(pb + 6)) GRID_BAR();
        }
        if (PH_EN(8) && IN(pb + 7)) {
            PH_LOCALS();
            const float* X1 = (const float*)(ws + WS_X1); bf16* XN = (bf16*)(ws + WS_XN); const bf16* CONTRIB = (const bf16*)(ws + WS_CONTRIB); float* outp = ka->out;
            const float* g2 = ka->in[18] + (size_t)l * D; const float* b2 = ka->in[19] + (size_t)l * D;
            f32x4 gv[4], bv[4];
#pragma unroll
            for (int j = 0; j < 4; ++j) { gv[j] = *(const f32x4*)(g2 + 256 * j + 4 * lane); bv[j] = *(const f32x4*)(b2 + 256 * j + 4 * lane); }
#pragma unroll 1
            for (int m = gw; m < T; m += NGW) {
                const GAS f32x4* xr = (const GAS f32x4*)(X1 + (size_t)m * D) + lane;
                f32x4 v[4]; float s = 0.f;
#pragma unroll
                for (int j = 0; j < 4; ++j) v[j] = xr[64 * j] * DN_ALPHA;
#pragma unroll
                for (int k = 0; k < TOPK; ++k) { const GAS v2u* cr = (const GAS v2u*)(CONTRIB + ((size_t)m * 4 + k) * D) + lane;
#pragma unroll
                    for (int j = 0; j < 4; ++j) { const v2u c = cr[64 * j]; v[j].x += bflo(c.x); v[j].y += bfhi(c.x); v[j].z += bflo(c.y); v[j].w += bfhi(c.y); } }
#pragma unroll
                for (int j = 0; j < 4; ++j) s += (v[j].x + v[j].y) + (v[j].z + v[j].w);
                const float mean = wave_sum(s) * (1.f / D); float s2 = 0.f;
#pragma unroll
                for (int j = 0; j < 4; ++j) { v[j] = v[j] - mean; s2 += (v[j].x * v[j].x + v[j].y * v[j].y) + (v[j].z * v[j].z + v[j].w * v[j].w); }
                const float rstd = 1.f / sqrtf(wave_sum(s2) * (1.f / D) + LN_EPS);
                GAS f32x4* orow = (GAS f32x4*)(outp + (size_t)m * D) + lane;
                GAS unsigned long long* o8 = (GAS unsigned long long*)(XN + (size_t)m * D) + lane;
#pragma unroll
                for (int j = 0; j < 4; ++j) { v[j] = v[j] * rstd * gv[j] + bv[j]; orow[64 * j] = v[j];
                    o8[64 * j] = (unsigned long long)pk2(v[j].x, v[j].y) | ((unsigned long long)pk2(v[j].z, v[j].w) << 32); }
            }
            if (BOTH(pb + 7)) GRID_BAR();
        }
    }
#undef IN
#undef BOTH
}

extern "C" void kernel_launch(void* const* d_in, const int* in_sizes, int n_in, void* d_out, int out_size, void* d_ws, size_t ws_size, hipStream_t stream) {
    static int grid = 0;
    if (grid == 0) {
        if (n_in != 20 || in_sizes[0] != T * D || out_size != T * D || ws_size < WS_END) { fprintf(stderr, "kernel_launch: unexpected shapes / workspace (n_in %d, ws %zu, need %zu)\n", n_in, ws_size, (size_t)WS_END); grid = -1; return; }
        int dev = 0, cus = 0, per_cu = 0;
        if (hipGetDevice(&dev) != hipSuccess || hipDeviceGetAttribute(&cus, hipDeviceAttributeMultiprocessorCount, dev) != hipSuccess) { grid = -1; return; }
        if (hipFuncSetAttribute((const void*)mk_fwd, hipFuncAttributeMaxDynamicSharedMemorySize, LDS_BYTES) != hipSuccess) { fprintf(stderr, "kernel_launch: hipFuncSetAttribute failed\n"); grid = -1; return; }
        if (hipOccupancyMaxActiveBlocksPerMultiprocessor(&per_cu, (const void*)mk_fwd, NWAVES * 64, LDS_BYTES) != hipSuccess || per_cu < 1) fprintf(stderr, "kernel_launch: occupancy query reports %d\n", per_cu);
        (void)hipGetLastError();
        grid = cus;
    }
    if (grid < 0) return;
    (void)hipMemsetAsync((char*)d_ws + WS_CTL, 0, CTL_ZERO_BYTES, stream);
    Args a{};
    for (int i = 0; i < 20; ++i) a.in[i] = (const float*)d_in[i];
    a.out = (float*)d_out; a.ws = (unsigned char*)d_ws;
#if MK_ONE_LAUNCH
    a.ph_lo = 0; a.ph_hi = 1 + 8 * DEPTH;
    hipLaunchKernelGGL(mk_fwd, dim3(grid), dim3(NWAVES * 64), LDS_BYTES, stream, a);
#else
    for (int ph = 0; ph < 1 + 8 * DEPTH; ++ph) {
        a.ph_lo = ph; a.ph_hi = ph + 1;
        hipLaunchKernelGGL(mk_fwd, dim3(grid), dim3(NWAVES * 64), LDS_BYTES, stream, a);
    }
#endif
}
```

```cpp
#include <hip/hip_runtime.h>
#include <cstdio>
#include <cstdint>

#ifndef DIS_MASK
#define DIS_MASK 0
#endif
#define PH_EN(k) (((DIS_MASK) >> (k) & 1) == 0)
#ifndef EPI_TWICE_SEL
#define EPI_TWICE_SEL 0
#endif
#if EPI_TWICE_SEL
#define EPI_TWICE 1
#endif
#ifndef REPEAT_MASK
#define REPEAT_MASK 0
#endif
#define REP(k) for (int rep_ = 0; rep_ < (((REPEAT_MASK) >> (k)) & 1) + 1; ++rep_)
#ifndef ATT_MASK
#define ATT_MASK 0
#endif
#define ATT_EN(k) (((ATT_MASK) >> (k) & 1) == 0)
#ifndef MK_ONE_LAUNCH
#define MK_ONE_LAUNCH 1
#endif

constexpr int BATCH = 16, SEQ = 4096, D = 1024, T = BATCH * SEQ, W = 512, INW = 6656, NE = 32, TOPK = 4, DFF = 1024, MEML = 256, MEMT = BATCH * MEML, DEPTH = 2;
constexpr int GATE0 = 7 * W;
constexpr float LN_EPS = 1e-5f, RMS_EPS = 1e-5f;
constexpr float DN_ALPHA = 1.4142135623730951f;
constexpr int NWAVES = 8;

constexpr size_t MiB = 1u << 20;
constexpr size_t WS_CTL = 0, CTL_ZERO_BYTES = 1 * MiB;
constexpr size_t WS_PERM = 2 * MiB;
constexpr size_t WS_SLOTW = 10 * MiB;
constexpr size_t WS_STATS = 12 * MiB;
constexpr size_t WS_SLOTPOS = 11 * MiB;
constexpr size_t WS_WIN = 16 * MiB;
constexpr size_t WS_WMEMKV = 42 * MiB;
constexpr size_t WS_WBR = 46 * MiB;
constexpr size_t WS_WOUT = 52 * MiB;
constexpr size_t WS_WGU = 56 * MiB;
constexpr size_t WS_WD = 312 * MiB;
constexpr size_t WS_MEMB = 440 * MiB;
constexpr size_t WS_MEMKV = 448 * MiB;
constexpr size_t WS_XN = 456 * MiB;
constexpr size_t WS_X1 = 584 * MiB;
constexpr size_t WS_BIG = 840 * MiB;
constexpr size_t WS_PROJ = WS_BIG;
constexpr size_t WS_Y = WS_BIG + 832 * MiB;
constexpr size_t WS_MERGED = WS_BIG + 1024 * MiB;
constexpr size_t WS_ACT = WS_BIG;
constexpr size_t WS_CONTRIB = WS_BIG + 528 * MiB;
constexpr size_t WS_MEMKV2 = WS_BIG + 1152 * MiB;
constexpr size_t WS_END = WS_MEMKV2 + 16 * MiB;
static_assert(WS_CONTRIB + (size_t)528 * MiB <= WS_END && WS_MERGED + (size_t)T * D * 2 <= WS_END, "ws map");

constexpr int CW_TMO = 0, CW_CODE = 1;
constexpr int CW_BAR = 4096;
constexpr int CW_CNT = 32768;

constexpr int RING_OFF = 0, RING_BYTES = 132096;
constexpr int LDSCTL_OFF = RING_BYTES;
constexpr int LDS_BYTES = 147456;
constexpr int LW_BAR = 8;
constexpr int LW_TOFF = 64;
constexpr int LW_LCNT = 128;
constexpr int LW_RCNT = 192;
constexpr int LW_RBASE = 256;
constexpr int LW_RSLOT = 320, RSLOT_STRIDE = 256;

#define GAS __attribute__((address_space(1)))
#define LAS __attribute__((address_space(3)))
typedef unsigned short bf16;
typedef unsigned v4u __attribute__((ext_vector_type(4)));
typedef unsigned v2u __attribute__((ext_vector_type(2)));
typedef float f32x4 __attribute__((ext_vector_type(4)));
typedef float f32x2 __attribute__((ext_vector_type(2)));
typedef short bf16x8 __attribute__((ext_vector_type(8)));
typedef GAS unsigned gu32;
#define RLX_AGENT __ATOMIC_RELAXED, __HIP_MEMORY_SCOPE_AGENT
#define LDS_WAIT() asm volatile("s_waitcnt lgkmcnt(0)" ::: "memory")
#define VM_WAIT() asm volatile("s_waitcnt vmcnt(0)" ::: "memory")

__device__ __forceinline__ unsigned f2bf(float f) { unsigned u = __builtin_bit_cast(unsigned, f); return (u + 0x7fffu + ((u >> 16) & 1u)) >> 16; }
__device__ __forceinline__ unsigned pk2(float lo, float hi) { return f2bf(lo) | (f2bf(hi) << 16); }
__device__ __forceinline__ float bflo(unsigned w) { return __uint_as_float(w << 16); }
__device__ __forceinline__ float bfhi(unsigned w) { return __uint_as_float(w & 0xffff0000u); }
__device__ __forceinline__ float bf2f(bf16 b) { return __uint_as_float((unsigned)b << 16); }
__device__ __forceinline__ float fast_exp(float x) { return __builtin_amdgcn_exp2f(x * 1.4426950408889634f); }
__device__ __forceinline__ float fast_sigmoid(float x) { return __builtin_amdgcn_rcpf(1.0f + fast_exp(-x)); }

namespace pg8 {
#define PG8_LAS __attribute__((address_space(3)))
typedef unsigned short bf16_t;
typedef unsigned u32x4 __attribute__((ext_vector_type(4)));
constexpr int BM = 256, BK = 64, HALF = 128, HTB = HALF * BK * 2, STAGE_BYTES = 8 * HTB, NXCD = 8, WGM = 8;

__host__ __device__ __forceinline__ int lds_byte(int r, int c) { const int st = (r >> 4) * 2 + (c >> 5), rr = r & 15, cc = c & 31, ob = rr * 64 + cc * 2; return st * 1024 + (ob ^ (((ob >> 9) & 1) << 5)); }
__host__ __device__ __forceinline__ void stage_rc(int b, int& R, int& C) { const int st = b / 1024, sb = b % 1024, swz = sb ^ (((sb >> 9) & 1) << 5); R = (st >> 1) * 16 + swz / 64; C = (st & 1) * 32 + (swz % 64) / 2; }
__host__ __device__ __forceinline__ int perm32(int rho) { const int n = rho >> 4, i = rho & 15; return 8 * (i >> 2) + 4 * n + (i & 3); }

struct Unit { int pm, pn, e, rt; };

__device__ __forceinline__ bool tile_order(long L, int nM, int nN, int& pm, int& pn) {
    const int nwg = nM * nN; if (L >= nwg) return false;
    int wgid = (int)L; { const int q = nwg / NXCD, r = nwg % NXCD, xcd = wgid % NXCD, off = wgid / NXCD; wgid = (xcd < r ? xcd * (q + 1) : r * (q + 1) + (xcd - r) * q) + off; }
    const int nig = WGM * nN, gid = wgid / nig, fm = gid * WGM, gsz = (nM - fm) < WGM ? (nM - fm) : WGM;
    pm = fm + ((wgid % nig) % gsz); pn = (wgid % nig) / gsz; return true;
}

__device__ __forceinline__ unsigned cvt_pk_bf16(float lo, float hi) { unsigned r; asm volatile("v_cvt_pk_bf16_f32 %0, %1, %2" : "=v"(r) : "v"(lo), "v"(hi)); return r; }

template <class Epi, class Sched, bool GATHER, bool ALIGN_EPI>
__device__ __forceinline__ void gemm_phase(PG8_LAS unsigned char* lds, const int K, const Sched& S, const Epi& E) {
    int tid = threadIdx.x; asm volatile("" : "+v"(tid));
    const int wid = __builtin_amdgcn_readfirstlane(tid >> 6), lane = tid & 63, wr = wid >> 2, wc = wid & 3, fr = lane & 15, fq = lane >> 4;
    const int nt = K / BK;
    unsigned voffA[2], voffB[2]; int gR[2], gC[2];
#pragma unroll
    for (int i = 0; i < 2; ++i) { int R, C; stage_rc(tid * 16 + i * 8192, R, C); const int Rb = Epi::PERM ? ((R & ~31) + perm32(R & 31)) : R;
        voffA[i] = (unsigned)(R * K + C) * 2u; voffB[i] = (unsigned)(Rb * K + C) * 2u; gR[i] = R; gC[i] = C * 2; }
    const size_t kstep = (size_t)(BK * 2);
    const size_t hstep = (size_t)HALF * K * 2;
    const unsigned ldsw = (unsigned)wid * 1024u;
    const int aoff = lds_byte(wr * 64 + fr, fq * 8), boff = lds_byte(wc * 32 + fr, fq * 8);
#define PG8_SA(b, h) (((b) * 2 + (h)) * HTB)
#define PG8_SB(b, h) ((4 + (b) * 2 + (h)) * HTB)
#define PG8_STAGE(bufoff, gbase, voff) do { _Pragma("unroll") for (int _i = 0; _i < 2; ++_i) \
        __builtin_amdgcn_global_load_lds((const unsigned*)((const char*)(gbase) + (voff)[_i]), (PG8_LAS unsigned*)(lds + (bufoff) + ldsw + _i * 8192), 16, 0, 0); } while (0)
#define PG8_STAGE_A(bufoff, kptr, h, G) do { if constexpr (GATHER) { PG8_STAGE(bufoff, kptr, (G)[h]); } else { PG8_STAGE(bufoff, (kptr) + (h) * hstep, voffA); } } while (0)
#define PG8_LDA(dst, b, h) do { _Pragma("unroll") for (int m = 0; m < 4; ++m) _Pragma("unroll") for (int k = 0; k < 2; ++k) dst[m][k] = *(const PG8_LAS bf16x8*)(lds + PG8_SA(b, h) + aoff + m * 2048 + k * 1024); } while (0)
#define PG8_LDB(dst, b, h) do { _Pragma("unroll") for (int n = 0; n < 2; ++n) _Pragma("unroll") for (int k = 0; k < 2; ++k) dst[n][k] = *(const PG8_LAS bf16x8*)(lds + PG8_SB(b, h) + boff + n * 2048 + k * 1024); } while (0)
#define PG8_MMA(ai, bj, At, Bt) do { __builtin_amdgcn_s_setprio(1); _Pragma("unroll") for (int m = 0; m < 4; ++m) _Pragma("unroll") for (int n = 0; n < 2; ++n) _Pragma("unroll") for (int k = 0; k < 2; ++k) \
        acc[ai][bj][m][n] = __builtin_amdgcn_mfma_f32_16x16x32_bf16(Bt[n][k], At[m][k], acc[ai][bj][m][n], 0, 0, 0); __builtin_amdgcn_s_setprio(0); } while (0)
#define PG8_WAIT_V(n) asm volatile("s_waitcnt vmcnt(" #n ")" ::: "memory")
#define PG8_WAIT_L(n) asm volatile("s_waitcnt lgkmcnt(" #n ")" ::: "memory")
#define PG8_BAR __builtin_amdgcn_s_barrier()
#define PG8_SCHED __builtin_amdgcn_sched_barrier(0)
    Unit cur, nxt; int ui = 0;
    if (!S.next(0, cur)) return;
    f32x4 acc[2][2][4][2];
#pragma unroll
    for (int a = 0; a < 2; ++a)
#pragma unroll
        for (int b = 0; b < 2; ++b)
#pragma unroll
            for (int m = 0; m < 4; ++m)
#pragma unroll
                for (int n = 0; n < 2; ++n) acc[a][b][m][n] = (f32x4){0.f, 0.f, 0.f, 0.f};
    bf16x8 At[4][2], B0[2][2], B1[2][2];
    unsigned cG[2][2] = {{0u, 0u}, {0u, 0u}}, nG[2][2] = {{0u, 0u}, {0u, 0u}}, sG[2][2] = {{0u, 0u}, {0u, 0u}};
    if constexpr (GATHER) S.gather(cur, gR, gC, K, cG);
    if constexpr (GATHER) asm volatile("" : "+v"(cG[0][0]), "+v"(cG[0][1]), "+v"(cG[1][0]), "+v"(cG[1][1]));
    const char* cA = S.a_base(cur); const char* cB = S.b_base(cur);
    PG8_STAGE(PG8_SB(0, 0), cB, voffB); PG8_STAGE(PG8_SB(0, 1), cB + hstep, voffB); PG8_STAGE_A(PG8_SA(0, 0), cA, 0, cG); PG8_STAGE_A(PG8_SA(0, 1), cA, 1, cG);
    if (wr == 1) PG8_BAR;
    PG8_WAIT_V(2); PG8_BAR;
    PG8_STAGE(PG8_SB(1, 0), cB + kstep, voffB); PG8_STAGE_A(PG8_SA(1, 0), cA + kstep, 0, cG); PG8_STAGE(PG8_SB(1, 1), cB + hstep + kstep, voffB);
    PG8_WAIT_V(6); PG8_BAR;
    for (;;) {
        const bool has_next = S.next(ui + 1, nxt);
        const char* nA = has_next ? S.a_base(nxt) : cA; const char* nB = has_next ? S.b_base(nxt) : cB;
        if constexpr (GATHER) { if (has_next) S.gather(nxt, gR, gC, K, nG); else { nG[0][0] = cG[0][0]; nG[0][1] = cG[0][1]; nG[1][0] = cG[1][0]; nG[1][1] = cG[1][1]; } }
        if constexpr (GATHER) asm volatile("" : "+v"(nG[0][0]), "+v"(nG[0][1]), "+v"(nG[1][0]), "+v"(nG[1][1]));
        for (int t = 0; t < nt; t += 2) {
            const bool last = (t == nt - 2);
            const char* a1 = cA + (size_t)(t + 1) * kstep;
            const char* a2 = last ? nA : cA + (size_t)(t + 2) * kstep; const char* b2 = last ? nB : cB + (size_t)(t + 2) * kstep;
            const char* a3 = a2 + kstep; const char* b3 = b2 + kstep;
            if constexpr (GATHER) { sG[0][0] = last ? nG[0][0] : cG[0][0]; sG[0][1] = last ? nG[0][1] : cG[0][1]; sG[1][0] = last ? nG[1][0] : cG[1][0]; sG[1][1] = last ? nG[1][1] : cG[1][1]; }
            PG8_LDB(B0, 0, 0); PG8_LDB(B1, 0, 1); PG8_SCHED; PG8_LDA(At, 0, 0); PG8_STAGE_A(PG8_SA(1, 1), a1, 1, cG);
            PG8_WAIT_V(8); PG8_WAIT_L(0); PG8_BAR; PG8_MMA(0, 0, At, B0); PG8_MMA(0, 1, At, B1); PG8_BAR; PG8_SCHED;
            PG8_LDA(At, 0, 1); PG8_STAGE(PG8_SB(0, 0), b2, voffB); PG8_STAGE(PG8_SB(0, 1), b2 + hstep, voffB); PG8_STAGE_A(PG8_SA(0, 0), a2, 0, sG);
            PG8_WAIT_V(8); PG8_WAIT_L(0); PG8_BAR; PG8_MMA(1, 0, At, B0); PG8_MMA(1, 1, At, B1); PG8_BAR; PG8_SCHED;
            PG8_LDB(B0, 1, 0); PG8_LDB(B1, 1, 1); PG8_SCHED; PG8_LDA(At, 1, 0); PG8_STAGE_A(PG8_SA(0, 1), a2, 1, sG);
            PG8_WAIT_V(8); PG8_WAIT_L(0); PG8_BAR; PG8_MMA(0, 0, At, B0); PG8_MMA(0, 1, At, B1); PG8_BAR; PG8_SCHED;
            PG8_LDA(At, 1, 1); PG8_STAGE(PG8_SB(1, 0), b3, voffB); PG8_STAGE(PG8_SB(1, 1), b3 + hstep, voffB); PG8_STAGE_A(PG8_SA(1, 0), a3, 0, sG);
            PG8_WAIT_V(8); PG8_WAIT_L(0); PG8_BAR; PG8_MMA(1, 0, At, B0); PG8_MMA(1, 1, At, B1); PG8_BAR; PG8_SCHED;
            if constexpr (Epi::HAS_MID) { if (t == 6 || t == 14) E.mid(acc, cur, wr, wc, fr, fq, (t + 2) >> 3); }
        }
        if constexpr (ALIGN_EPI) { if (wr == 0) PG8_BAR; }
        E(acc, cur, wr, wc, fr, fq);
#if defined(EPI_TWICE)
        if constexpr (Epi::TWICE) { asm volatile("" ::: "memory"); E(acc, cur, wr, wc, fr, fq); }
#endif
        if constexpr (Epi::DRAIN_AFTER) __builtin_amdgcn_s_waitcnt(0x0F70);
        if (!has_next) break;
#pragma unroll
        for (int a = 0; a < 2; ++a)
#pragma unroll
            for (int b = 0; b < 2; ++b)
#pragma unroll
                for (int m = 0; m < 4; ++m)
#pragma unroll
                    for (int n = 0; n < 2; ++n) acc[a][b][m][n] = (f32x4){0.f, 0.f, 0.f, 0.f};
        cur = nxt; cA = nA; cB = nB; ++ui;
        if constexpr (GATHER) { cG[0][0] = nG[0][0]; cG[0][1] = nG[0][1]; cG[1][0] = nG[1][0]; cG[1][1] = nG[1][1]; }
        if constexpr (ALIGN_EPI) { if (wr == 1) PG8_BAR; }
    }
    PG8_WAIT_V(0);
    if constexpr (!ALIGN_EPI) { if (wr == 0) PG8_BAR; }
    PG8_BAR;
#undef PG8_SA
#undef PG8_SB
#undef PG8_STAGE
#undef PG8_STAGE_A
#undef PG8_LDA
#undef PG8_LDB
#undef PG8_MMA
#undef PG8_WAIT_V
#undef PG8_WAIT_L
#undef PG8_BAR
#undef PG8_SCHED
}

struct DenseOrder {
    const char* A; const char* Bt; int nM, nN, G, c, K;
    __device__ __forceinline__ bool next(int i, Unit& u) const { u.e = 0; u.rt = 0; return tile_order((long)i * G + c, nM, nN, u.pm, u.pn); }
    __device__ __forceinline__ const char* a_base(const Unit& u) const { return A + (size_t)u.pm * BM * K * 2; }
    __device__ __forceinline__ const char* b_base(const Unit& u) const { return Bt + (size_t)u.pn * BM * K * 2; }
};
struct MoeOrder {
    const char* A; const char* Wt; int nN, NT, G, c, K; size_t wstride;
    const PG8_LAS int* toff; const PG8_LAS int* lcnt; const int* perm;
    __device__ __forceinline__ bool next(int i, Unit& u) const {
        if (!tile_order((long)i * G + c, NT, nN, u.pm, u.pn)) return false;
        int e = 0;
#pragma unroll 1
        for (int j = 1; j < NE; ++j) e += (toff[j] <= u.pm) ? 1 : 0;
        u.e = e; u.rt = u.pm - toff[e]; return true;
    }
    __device__ __forceinline__ const char* a_base(const Unit& u) const { return A; }
    __device__ __forceinline__ const char* a_dense(const Unit& u) const { return A + (size_t)u.pm * BM * K * 2; }
    __device__ __forceinline__ const char* b_base(const Unit& u) const { return Wt + (size_t)u.e * wstride + (size_t)u.pn * BM * K * 2; }
    __device__ __forceinline__ void gather(const Unit& u, const int (&gR)[2], const int (&gC)[2], int K_, unsigned (&Gv)[2][2]) const {
        const int n = lcnt[u.e] - u.rt * BM; const int* p = perm + (size_t)u.e * T + u.rt * BM;
#pragma unroll
        for (int h = 0; h < 2; ++h)
#pragma unroll
            for (int i = 0; i < 2; ++i) { const int r = h * HALF + gR[i]; const int tok = (r < n) ? (p[r] >> 2) : 0; Gv[h][i] = (unsigned)tok * (unsigned)(K_ * 2) + (unsigned)gC[i]; }
    }
};
struct MoeDenseOrder : MoeOrder {
    __device__ __forceinline__ const char* a_base(const Unit& u) const { return a_dense(u); }
};

struct EpiProj {
    static constexpr bool PERM = true, DRAIN_AFTER = false, TWICE = (EPI_TWICE_SEL == 1), HAS_MID = false;
    bf16_t* O; int ldc; const float* bias; int act_from; int qscale_upto;
    __device__ __forceinline__ void operator()(const f32x4 (&acc)[2][2][4][2], const Unit& u, int wr, int wc, int fr, int fq) const {
        const int row0 = u.pm * BM + wr * 64 + fr, colt = u.pn * BM, col0 = colt + wc * 32 + 8 * fq;
        const bool gate = colt >= act_from;
        float qs = 1.0f;
        if (colt < qscale_upto) { const int seg = colt / W; qs = (seg == 0 || seg == 3) ? 0.125f * 1.4426950408889634f : (seg == 6 ? 0.08838834764831845f * 1.4426950408889634f : 1.0f); }
        f32x4 bv[2][2];
#pragma unroll
        for (int bj = 0; bj < 2; ++bj)
#pragma unroll
            for (int n = 0; n < 2; ++n) bv[bj][n] = gate ? *(const f32x4*)(bias + (col0 - act_from) + bj * HALF + 4 * n) : (f32x4){0.f, 0.f, 0.f, 0.f};
#pragma unroll
        for (int ai = 0; ai < 2; ++ai)
#pragma unroll
            for (int m = 0; m < 4; ++m) { bf16_t* rowp = O + (size_t)(row0 + ai * HALF + m * 16) * ldc + col0;
#pragma unroll
                for (int bj = 0; bj < 2; ++bj) { f32x4 v0 = acc[ai][bj][m][0] + bv[bj][0], v1 = acc[ai][bj][m][1] + bv[bj][1];
                    if (gate) {
#pragma unroll
                        for (int j = 0; j < 4; ++j) { v0[j] = fast_sigmoid(v0[j]); v1[j] = fast_sigmoid(v1[j]); } }
                    v0 = v0 * qs; v1 = v1 * qs;
                    u32x4 w; w.x = cvt_pk_bf16(v0[0], v0[1]); w.y = cvt_pk_bf16(v0[2], v0[3]); w.z = cvt_pk_bf16(v1[0], v1[1]); w.w = cvt_pk_bf16(v1[2], v1[3]);
                    *(u32x4*)(rowp + bj * HALF) = w; } }
    }
};
struct EpiBranch {
    static constexpr bool PERM = true, DRAIN_AFTER = false, TWICE = false, HAS_MID = true;
    const bf16_t* P; bf16_t* Mg;
    __device__ __forceinline__ void mid(f32x4 (&acc)[2][2][4][2], const Unit& u, int wr, int wc, int fr, int fq, int seg  ) const {
        asm volatile("" : "+v"(fr), "+v"(fq));
        const int row0 = u.pm * BM + wr * 64 + fr, col0 = u.pn * BM + wc * 32 + 8 * fq;
#pragma unroll
        for (int ai = 0; ai < 2; ++ai) {
            u32x4 gn[4][2], gd[4][2];
#pragma unroll
            for (int m = 0; m < 4; ++m) { const bf16_t* gp = P + (size_t)(row0 + ai * HALF + m * 16) * INW + GATE0 + (seg - 1) * D + col0;
#pragma unroll
                for (int bj = 0; bj < 2; ++bj) { gn[m][bj] = *(const u32x4*)(gp + bj * HALF); gd[m][bj] = *(const u32x4*)(gp + D + bj * HALF); } }
            asm volatile("" :: "v"(gn[0][0]), "v"(gn[0][1]), "v"(gn[1][0]), "v"(gn[1][1]), "v"(gn[2][0]), "v"(gn[2][1]), "v"(gn[3][0]), "v"(gn[3][1]),
                               "v"(gd[0][0]), "v"(gd[0][1]), "v"(gd[1][0]), "v"(gd[1][1]), "v"(gd[2][0]), "v"(gd[2][1]), "v"(gd[3][0]), "v"(gd[3][1]));
#pragma unroll
            for (int m = 0; m < 4; ++m)
#pragma unroll
                for (int bj = 0; bj < 2; ++bj) { const u32x4 n_ = gn[m][bj], d_ = gd[m][bj];
                    f32x4& a0 = acc[ai][bj][m][0]; f32x4& a1 = acc[ai][bj][m][1];
#define BR_RATIO(n__, d__, hi_) ((hi_ ? bfhi(n__) : bflo(n__)) * __builtin_amdgcn_rcpf(__builtin_fmaxf(hi_ ? bfhi(d__) : bflo(d__), 1e-30f)))
                    a0[0] *= BR_RATIO(n_.x, d_.x, 0); a0[1] *= BR_RATIO(n_.x, d_.x, 1); a0[2] *= BR_RATIO(n_.y, d_.y, 0); a0[3] *= BR_RATIO(n_.y, d_.y, 1);
                    a1[0] *= BR_RATIO(n_.z, d_.z, 0); a1[1] *= BR_RATIO(n_.z, d_.z, 1); a1[2] *= BR_RATIO(n_.w, d_.w, 0); a1[3] *= BR_RATIO(n_.w, d_.w, 1);
#undef BR_RATIO
                }
        }
    }
    __device__ __forceinline__ void operator()(const f32x4 (&acc)[2][2][4][2], const Unit& u, int wr, int wc, int fr, int fq) const {
        const int row0 = u.pm * BM + wr * 64 + fr, col0 = u.pn * BM + wc * 32 + 8 * fq;
#pragma unroll
        for (int ai = 0; ai < 2; ++ai)
#pragma unroll
            for (int m = 0; m < 4; ++m) { const size_t row = (size_t)(row0 + ai * HALF + m * 16);
                const bf16_t* gp = P + row * INW + GATE0 + 2 * D + col0; bf16_t* mp = Mg + row * D + col0;
#pragma unroll
                for (int bj = 0; bj < 2; ++bj) {
                    const u32x4 g = *(const u32x4*)(gp + bj * HALF); const f32x4 a0 = acc[ai][bj][m][0], a1 = acc[ai][bj][m][1];
                    u32x4 w;
                    w.x = cvt_pk_bf16(__builtin_fmaxf(bflo(g.x), 1e-30f) * a0[0], __builtin_fmaxf(bfhi(g.x), 1e-30f) * a0[1]);
                    w.y = cvt_pk_bf16(__builtin_fmaxf(bflo(g.y), 1e-30f) * a0[2], __builtin_fmaxf(bfhi(g.y), 1e-30f) * a0[3]);
                    w.z = cvt_pk_bf16(__builtin_fmaxf(bflo(g.z), 1e-30f) * a1[0], __builtin_fmaxf(bfhi(g.z), 1e-30f) * a1[1]);
                    w.w = cvt_pk_bf16(__builtin_fmaxf(bflo(g.w), 1e-30f) * a1[2], __builtin_fmaxf(bfhi(g.w), 1e-30f) * a1[3]);
                    *(u32x4*)(mp + bj * HALF) = w; } }
    }
};
struct EpiOut {
    static constexpr bool PERM = false, DRAIN_AFTER = false, TWICE = (EPI_TWICE_SEL == 4), HAS_MID = false;
    const float* X; float* V1;
    __device__ __forceinline__ void operator()(const f32x4 (&acc)[2][2][4][2], const Unit& u, int wr, int wc, int fr, int fq) const {
        const int row0 = u.pm * BM + wr * 64 + fr, col0 = u.pn * BM + wc * 32 + 4 * fq;
#pragma unroll
        for (int ai = 0; ai < 2; ++ai)
#pragma unroll
            for (int m = 0; m < 4; ++m) { const size_t off = (size_t)(row0 + ai * HALF + m * 16) * D + col0;
#pragma unroll
                for (int bj = 0; bj < 2; ++bj)
#pragma unroll
                    for (int n = 0; n < 2; ++n) { const f32x4 xv = *(const f32x4*)(X + off + bj * HALF + n * 16); *(f32x4*)(V1 + off + bj * HALF + n * 16) = xv * DN_ALPHA + acc[ai][bj][m][n]; } }
    }
};
struct EpiGateUp {
    static constexpr bool PERM = true, DRAIN_AFTER = false, TWICE = (EPI_TWICE_SEL == 6), HAS_MID = false;
    bf16_t* Act; const float* bgu;
    __device__ __forceinline__ void operator()(const f32x4 (&acc)[2][2][4][2], const Unit& u, int wr, int wc, int fr, int fq) const {
        const int row0 = u.pm * BM + wr * 64 + fr, c0 = u.pn * HALF + wc * 32 + 8 * fq;
        const float* bg = bgu + (size_t)u.e * 2 * DFF + c0;
        const f32x4 bg0 = *(const f32x4*)(bg), bg1 = *(const f32x4*)(bg + 4), bu0 = *(const f32x4*)(bg + DFF), bu1 = *(const f32x4*)(bg + DFF + 4);
#pragma unroll
        for (int ai = 0; ai < 2; ++ai)
#pragma unroll
            for (int m = 0; m < 4; ++m) {
                f32x4 g0 = acc[ai][0][m][0] + bg0, g1 = acc[ai][0][m][1] + bg1, u0 = acc[ai][1][m][0] + bu0, u1 = acc[ai][1][m][1] + bu1;
                float o[8];
#pragma unroll
                for (int j = 0; j < 4; ++j) {
                    const float ga = __builtin_fminf(g0[j], 7.0f), gb = __builtin_fminf(g1[j], 7.0f);
                    const float ua = __builtin_fminf(__builtin_fmaxf(u0[j], -7.0f), 7.0f), ub = __builtin_fminf(__builtin_fmaxf(u1[j], -7.0f), 7.0f);
                    o[j] = (ua + 1.0f) * (ga * fast_sigmoid(1.702f * ga)); o[4 + j] = (ub + 1.0f) * (gb * fast_sigmoid(1.702f * gb)); }
                u32x4 w; w.x = cvt_pk_bf16(o[0], o[1]); w.y = cvt_pk_bf16(o[2], o[3]); w.z = cvt_pk_bf16(o[4], o[5]); w.w = cvt_pk_bf16(o[6], o[7]);
                *(u32x4*)(Act + (size_t)(row0 + ai * HALF + m * 16) * DFF + c0) = w; }
    }
};
struct EpiDown {
    static constexpr bool PERM = true, DRAIN_AFTER = false, TWICE = (EPI_TWICE_SEL == 7), HAS_MID = false;
    bf16_t* C; const float* bd;
    __device__ __forceinline__ void operator()(const f32x4 (&acc)[2][2][4][2], const Unit& u, int wr, int wc, int fr, int fq) const {
        const int row0 = u.pm * BM + wr * 64 + fr, col0 = u.pn * BM + wc * 32 + 8 * fq;
        f32x4 bv[2][2];
#pragma unroll
        for (int bj = 0; bj < 2; ++bj)
#pragma unroll
            for (int nn = 0; nn < 2; ++nn) bv[bj][nn] = *(const f32x4*)(bd + (size_t)u.e * D + col0 + bj * HALF + 4 * nn);
#pragma unroll
        for (int ai = 0; ai < 2; ++ai)
#pragma unroll
            for (int m = 0; m < 4; ++m) { bf16_t* rowp = C + (size_t)(row0 + ai * HALF + m * 16) * D + col0;
#pragma unroll
                for (int bj = 0; bj < 2; ++bj) { const f32x4 v0 = acc[ai][bj][m][0] + bv[bj][0], v1 = acc[ai][bj][m][1] + bv[bj][1];
                    u32x4 w; w.x = cvt_pk_bf16(v0[0], v0[1]); w.y = cvt_pk_bf16(v0[2], v0[3]); w.z = cvt_pk_bf16(v1[0], v1[1]); w.w = cvt_pk_bf16(v1[2], v1[3]);
                    *(u32x4*)(rowp + bj * HALF) = w; } }
    }
};
}

#define XB_TMO      128
#define XB_XCNT(j)  (256  + 64 * (j))
#define XB_XSUB(j)  (1280 + 64 * (j))
#define XB_XGEN(j)  (2304 + 64 * (j))
#define XB_TOP      3328
#define XB_TOPGEN   3392
#define XCD_BAR_WORDS 3456
#define XB_SPIN_CAP (1u << 18)
__device__ __forceinline__ unsigned xb_ld(unsigned* p)              { return __hip_atomic_load(p, __ATOMIC_RELAXED, __HIP_MEMORY_SCOPE_AGENT); }
__device__ __forceinline__ unsigned xb_add(unsigned* p, unsigned v) { return __hip_atomic_fetch_add(p, v, __ATOMIC_RELAXED, __HIP_MEMORY_SCOPE_AGENT); }
__device__ __forceinline__ unsigned xb_xcc_id() { return (unsigned)__builtin_amdgcn_s_getreg((3 << 11) | 20) & 0xFu; }
#define XB_SPIN(cond, bar) do { unsigned _sp = 0; while (cond) { __builtin_amdgcn_s_sleep(1); \
    if ((++_sp & 255u) == 0u) { if (xb_ld(&(bar)[XB_TMO])) break; if (_sp > XB_SPIN_CAP) { atomicAdd(&(bar)[XB_TMO], 1u); break; } } } } while (0)
struct XcdBarrier { unsigned* bar; unsigned x; volatile LAS unsigned* st; };
__device__ __forceinline__ XcdBarrier xcd_barrier_post(unsigned* bar, volatile LAS unsigned* st) {
    XcdBarrier b; b.bar = bar; b.x = xb_xcc_id(); b.st = st;
    if (threadIdx.x == 0) (void)xb_add(&bar[XB_XCNT(b.x)], 1u);
    return b;
}
__device__ __forceinline__ void xcd_barrier_complete(unsigned* bar, unsigned x, unsigned& nloc, unsigned& nx) {
    const unsigned G = gridDim.x * gridDim.y * gridDim.z;
    unsigned sum, cnt, mine, sp = 0u;
    for (;;) {
        sum = 0u; cnt = 0u; mine = 0u;
#pragma unroll
        for (unsigned j = 0; j < 16; ++j) { const unsigned c = xb_ld(&bar[XB_XCNT(j)]); sum += c; cnt += (c > 0u) ? 1u : 0u; mine = (j == x) ? c : mine; }
        if (sum == G) break;
        __builtin_amdgcn_s_sleep(1);
        if ((++sp & 255u) == 0u) { if (xb_ld(&bar[XB_TMO])) break; if (sp > XB_SPIN_CAP) { atomicAdd(&bar[XB_TMO], 1u); break; } }
    }
    nloc = mine > 0u ? mine : 1u; nx = cnt > 0u ? cnt : 1u;
}
__device__ __forceinline__ void xcd_barrier(const XcdBarrier& b) {
    asm volatile("s_waitcnt vmcnt(0)" ::: "memory");
    __syncthreads();
    if (threadIdx.x == 0) {
        unsigned* bar = b.bar;
        __builtin_amdgcn_s_waitcnt(0);
        unsigned nloc = b.st[0], nx = b.st[1];
        if (nloc == 0u) { xcd_barrier_complete(bar, b.x, nloc, nx); b.st[0] = nloc; b.st[1] = nx; }
        const unsigned old = xb_add(&bar[XB_XSUB(b.x)], 1u);
        const unsigned gen = old / nloc;
        if (old + 1u == (gen + 1u) * nloc) {
            __builtin_amdgcn_fence(__ATOMIC_RELEASE, "agent");
            asm volatile("s_waitcnt vmcnt(0)" ::: "memory");
            const unsigned og = xb_add(&bar[XB_TOP], 1u);
            const unsigned tg = og / nx;
            if (og + 1u == (tg + 1u) * nx) xb_add(&bar[XB_TOPGEN], 1u);
            else XB_SPIN(xb_ld(&bar[XB_TOPGEN]) == tg, bar);
            __builtin_amdgcn_fence(__ATOMIC_ACQUIRE, "agent");
            xb_add(&bar[XB_XGEN(b.x)], 1u);
            asm volatile("s_waitcnt vmcnt(0)" ::: "memory");
        } else {
            XB_SPIN(xb_ld(&bar[XB_XGEN(b.x)]) == gen, bar);
            __builtin_amdgcn_fence(__ATOMIC_ACQUIRE, "agent");
            asm volatile("s_waitcnt vmcnt(0)" ::: "memory");
        }
    }
    __syncthreads();
}

template <int CTRL> __device__ __forceinline__ float dppf(float v) { return __int_as_float(__builtin_amdgcn_update_dpp(0, __float_as_int(v), CTRL, 0xf, 0xf, true)); }
__device__ __forceinline__ float wave_sum(float v) {
    v += dppf<0xB1>(v); v += dppf<0x4E>(v); v += dppf<0x141>(v); v += dppf<0x140>(v);
    { auto rr = __builtin_amdgcn_permlane16_swap(__float_as_uint(v), __float_as_uint(v), false, false); v = __uint_as_float(rr[0]) + __uint_as_float(rr[1]); }
    { auto rr = __builtin_amdgcn_permlane32_swap(__float_as_uint(v), __float_as_uint(v), false, false); v = __uint_as_float(rr[0]) + __uint_as_float(rr[1]); }
    return v;
}
constexpr int WT_STRIDE = D + 4;

struct Args { const float* in[20]; float* out; unsigned char* ws; int ph_lo, ph_hi; };
typedef const __attribute__((address_space(4))) Args* KArgs;
__device__ __forceinline__ KArgs ka_opaque() { unsigned long long p = (unsigned long long)__builtin_amdgcn_kernarg_segment_ptr(); asm volatile("" : "+s"(p)); return (KArgs)p; }
__device__ __forceinline__ int tid_opaque() { int t = threadIdx.x; asm volatile("" : "+v"(t)); return t; }

__device__ __forceinline__ void p0_transpose_item(const float* Wsrc, int K, int N, bf16* WT, int drow0, int k0, int n0, int dpitch, int dcol0, LAS float* scr, int lane) {
#pragma unroll 8
    for (int i = 0; i < 32; ++i) { const int kk = 2 * i + (lane >> 5); scr[kk * 33 + (lane & 31)] = Wsrc[(size_t)(k0 + kk) * N + n0 + (lane & 31)]; }
    LDS_WAIT(); asm volatile("" ::: "memory");
    const int c = lane & 7;
#pragma unroll
    for (int j = 0; j < 4; ++j) { const int n = (lane >> 3) + 8 * j; const LAS float* s = scr + (8 * c) * 33 + n;
        v4u o; o.x = pk2(s[0 * 33], s[1 * 33]); o.y = pk2(s[2 * 33], s[3 * 33]); o.z = pk2(s[4 * 33], s[5 * 33]); o.w = pk2(s[6 * 33], s[7 * 33]);
        *(GAS v4u*)(WT + (size_t)(drow0 + n) * dpitch + dcol0 + k0 + 8 * c) = o; }
    LDS_WAIT(); asm volatile("" ::: "memory");
}
__device__ __forceinline__ bool p0_matrix(int& r, const float* src, int K, int N, bf16* dst, bool gu_rows, LAS float* scr, int lane, int dpitch = 0, int dcol0 = 0) {
    const int nblk = N / 32, items = (K / 64) * nblk;
    if (r >= items) { r -= items; return false; }
    const int kb = r / nblk, nb = r % nblk, n0 = 32 * nb;
    int drow0 = n0;
    if (gu_rows) { const int cc = (n0 >= DFF) ? n0 - DFF : n0; drow0 = (cc >> 7) * 256 + (n0 >= DFF ? 128 : 0) + (cc & 127); }
    p0_transpose_item(src, K, N, dst, drow0, 64 * kb, n0, dpitch ? dpitch : K, dcol0, scr, lane);
    return true;
}
__device__ __forceinline__ void row_to_bf16(const float* xrow, bf16* orow, int lane) {
    const GAS f32x4* xr = (const GAS f32x4*)xrow + lane; GAS unsigned long long* o8 = (GAS unsigned long long*)orow + lane;
#pragma unroll
    for (int j = 0; j < 4; ++j) { const f32x4 v = xr[64 * j]; o8[64 * j] = (unsigned long long)pk2(v.x, v.y) | ((unsigned long long)pk2(v.z, v.w) << 32); }
}

__device__ __forceinline__ int t5_bucket(int rel) {
    const int n = rel < 0 ? -rel : rel;
    int b;
    if (n < 8) b = n; else b = 8 + (n >= 12) + (n >= 16) + (n >= 23) + (n >= 32) + (n >= 46) + (n >= 64) + (n >= 91);
    return (rel > 0 ? 16 : 0) + b;
}
namespace att {
typedef float f32x16 __attribute__((ext_vector_type(16)));
typedef short s16x4 __attribute__((ext_vector_type(4)));
typedef short v4i16_t __attribute__((ext_vector_type(4)));
typedef __bf16 bf16x2_t __attribute__((ext_vector_type(2)));
constexpr float LOG2E = 1.4426950408889634f;
constexpr int YP = 3 * W;
constexpr int SLOT = 16384, LDS_K = 0, LDS_V = 2 * SLOT, LDS_STG = 4 * SLOT, STG_W = 8192;
constexpr int LW_WSF = 320, LW_FLAG = 832, LW_TAB = 896;
__device__ __forceinline__ int crow(int r, int hi) { return (r & 3) + 8 * (r >> 2) + 4 * hi; }
__device__ __forceinline__ void glds16(const void* gsrc, unsigned lds_dst) { unsigned keep;
    asm volatile("s_mov_b32 %0, m0\n\ts_mov_b32 m0, %2\n\ts_nop 0\n\tglobal_load_lds_dwordx4 %1, off\n\ts_mov_b32 m0, %0" : "=&s"(keep) : "v"(gsrc), "s"(lds_dst) : "memory"); }
__device__ __forceinline__ unsigned cvtpk(float lo, float hi) { f32x2 v = {lo, hi}; bf16x2_t b = __builtin_convertvector(v, bf16x2_t); return __builtin_bit_cast(unsigned, b); }
template <int N> __device__ __forceinline__ void wait_bar() {
    if constexpr (N == 0) asm volatile("s_waitcnt vmcnt(0) lgkmcnt(0)\n\ts_barrier" ::: "memory");
    else if constexpr (N == 2) asm volatile("s_waitcnt vmcnt(2) lgkmcnt(0)\n\ts_barrier" ::: "memory");
    else if constexpr (N == 3) asm volatile("s_waitcnt vmcnt(3) lgkmcnt(0)\n\ts_barrier" ::: "memory");
    else asm volatile("s_waitcnt vmcnt(4) lgkmcnt(0)\n\ts_barrier" ::: "memory");
}
__device__ __forceinline__ void lds_bar() { asm volatile("s_waitcnt lgkmcnt(0)\n\ts_barrier" ::: "memory"); }
typedef LAS const char* lptr;
template <int ND0> __device__ __forceinline__ void qkt(f32x16& p0, f32x16& p1, lptr kslot, const bf16x8* qr, int r32, int hi) {
    lptr kb = kslot + hi * 1024 + r32 * 16;
    p0 = (f32x16){}; p1 = (f32x16){};
#pragma unroll
    for (int d0 = 0; d0 < ND0; ++d0) {
        const bf16x8 b0 = *(const LAS bf16x8*)(kb + d0 * 2048), b1 = *(const LAS bf16x8*)(kb + d0 * 2048 + 512);
        p0 = __builtin_amdgcn_mfma_f32_32x32x16_bf16(b0, qr[d0], p0, 0, 0, 0); p1 = __builtin_amdgcn_mfma_f32_32x32x16_bf16(b1, qr[d0], p1, 0, 0, 0); }
}
__device__ __forceinline__ s16x4 vtr(lptr p) { return __builtin_bit_cast(s16x4, __builtin_amdgcn_ds_read_tr16_b64_v4i16((LAS v4i16_t*)p)); }
template <int NDB> __device__ __forceinline__ void pv(f32x16* o, lptr vb, v4u pw0, v4u pw1, v4u pw2, v4u pw3) {
#pragma unroll
    for (int db = 0; db < NDB; ++db) {
#pragma unroll
        for (int ks = 0; ks < 4; ++ks) {
            const s16x4 lo = vtr(vb + db * 4096 + ks * 1024), hh = vtr(vb + db * 4096 + ks * 1024 + 512);
            const bf16x8 vf = (bf16x8){lo[0], lo[1], lo[2], lo[3], hh[0], hh[1], hh[2], hh[3]};
            const v4u pw = ks == 0 ? pw0 : ks == 1 ? pw1 : ks == 2 ? pw2 : pw3;
            o[db] = __builtin_amdgcn_mfma_f32_32x32x16_bf16(__builtin_bit_cast(bf16x8, pw), vf, o[db], 0, 0, 0); }
    }
}
__device__ __forceinline__ void pack_p(const f32x16& p0, const f32x16& p1, v4u& pw0, v4u& pw1, v4u& pw2, v4u& pw3) {
    pw0 = (v4u){cvtpk(p0[0], p0[1]), cvtpk(p0[2], p0[3]), cvtpk(p0[4], p0[5]), cvtpk(p0[6], p0[7])};
    pw1 = (v4u){cvtpk(p0[8], p0[9]), cvtpk(p0[10], p0[11]), cvtpk(p0[12], p0[13]), cvtpk(p0[14], p0[15])};
    pw2 = (v4u){cvtpk(p1[0], p1[1]), cvtpk(p1[2], p1[3]), cvtpk(p1[4], p1[5]), cvtpk(p1[6], p1[7])};
    pw3 = (v4u){cvtpk(p1[8], p1[9]), cvtpk(p1[10], p1[11]), cvtpk(p1[12], p1[13]), cvtpk(p1[14], p1[15])};
}
__device__ __forceinline__ float half_swap(float x, int hi) {
    auto rr = __builtin_amdgcn_permlane32_swap(__float_as_uint(x), __float_as_uint(x), false, false);
    return __uint_as_float(hi ? rr[0] : rr[1]);
}
__device__ __forceinline__ float rowmax32(const f32x16& p0, const f32x16& p1, int hi) {
    float a = __builtin_fmaxf(p0[0], p1[0]);
#pragma unroll
    for (int r = 1; r < 16; ++r) a = __builtin_fmaxf(a, __builtin_fmaxf(p0[r], p1[r]));
    return __builtin_fmaxf(a, half_swap(a, hi));
}
template <int NKC  , int NVP  >
__device__ __forceinline__ void dma_tile(const bf16* Kt, const bf16* Vt, int pitch, unsigned kdst, unsigned vdst, int wid, int lane) {
#pragma unroll
    for (int i = 0; i < NKC; ++i) { const int c = wid + 8 * i; glds16(Kt + (size_t)lane * pitch + c * 8, (unsigned)__builtin_amdgcn_readfirstlane(kdst + c * 1024)); }
#pragma unroll
    for (int i = 0; i < NVP; ++i) { const int pc = wid + 8 * i, dh = pc >> 2, rg = pc & 3;
        glds16(Vt + (size_t)(16 * rg + (lane >> 2)) * pitch + dh * 32 + (lane & 3) * 8, (unsigned)__builtin_amdgcn_readfirstlane(vdst + pc * 1024)); }
}
template <int NDB> __device__ __forceinline__ void store_o(const f32x16* o, const float* rsc  , LAS unsigned char* stg, bf16* Yw  , int lane, int r32, int hi) {
    LAS bf16* st = (LAS bf16*)stg;
#pragma unroll
    for (int r = 0; r < 16; ++r) { const int orow = crow(r, hi);
#pragma unroll
        for (int db = 0; db < NDB; ++db) st[orow * (NDB * 32) + db * 32 + r32] = (bf16)f2bf(o[db][r] * rsc[r]); }
    LDS_WAIT();
    constexpr int CPR = NDB * 4;
#pragma unroll
    for (int i = 0; i < (32 * CPR) / 64; ++i) { const int idx = i * 64 + lane, row = idx / CPR, ch = idx % CPR;
        const v4u v = *(const LAS v4u*)(stg + row * (NDB * 64) + ch * 16); *(v4u*)(Yw + (size_t)row * YP + ch * 8) = v; }
    LDS_WAIT();
}

__device__ __forceinline__ void sb_unit(LAS unsigned char* lds, volatile LAS unsigned* LWv, const bf16* proj, bf16* ysb, int b, int h, int qt, int, int) {
    const int tid_ = tid_opaque(), lane = tid_ & 63, wid = __builtin_amdgcn_readfirstlane(tid_ >> 6);
    const int r32 = lane & 31, hi = lane >> 5, q0 = qt * 256, qw0 = q0 + 32 * wid;
    const size_t rowb = (size_t)b * SEQ;
    const bf16* Qw = proj + (rowb + qw0) * INW + h * 64; const bf16* Kh = proj + rowb * INW + W + h * 64; const bf16* Vh = proj + rowb * INW + 2 * W + h * 64;
    const unsigned lds0 = (unsigned)(uintptr_t)lds;
    bf16x8 qr[4];
#pragma unroll
    for (int d0 = 0; d0 < 4; ++d0) qr[d0] = *(const bf16x8*)(Qw + (size_t)r32 * INW + d0 * 16 + hi * 8);
    f32x16 o[2]; o[0] = (f32x16){}; o[1] = (f32x16){};
    float R = 0.f;
    const float RTH = 104.0f * LOG2E;
    bool done = false;
    const int jmax = q0 / 64 + 3;
    lptr vb = (lptr)lds + LDS_V + ((lane >> 4) & 1) * 32 + (lane & 3) * 8 + (4 * hi + ((lane & 15) >> 2)) * 64;
    dma_tile<1, 1>(Kh + (size_t)jmax * 64 * INW, Vh + (size_t)jmax * 64 * INW, INW, lds0 + LDS_K, lds0 + LDS_V, wid, lane);
    int slot = 0;
#pragma unroll 1
    for (int j = jmax; j >= 0; --j) {
        if (j > 0) { dma_tile<1, 1>(Kh + (size_t)(j - 1) * 64 * INW, Vh + (size_t)(j - 1) * 64 * INW, INW, lds0 + LDS_K + (slot ^ 1) * SLOT, lds0 + LDS_V + (slot ^ 1) * SLOT, wid, lane); wait_bar<2>(); }
        else wait_bar<0>();
        const int delta = qw0 - 64 * j;
        if (!done && delta > -31) {
            f32x16 p0, p1;
            qkt<4>((f32x16&)p0, (f32x16&)p1, (lptr)lds + LDS_K + slot * SLOT, qr, r32, hi);
            if (delta < 64 + 31) {
#pragma unroll
                for (int r = 0; r < 16; ++r) { const int kv = crow(r, hi) - r32; if (!(kv < delta)) p0[r] = -INFINITY; if (!(kv + 32 < delta)) p1[r] = -INFINITY; }
            }
            f32x16 s0, s1;
#pragma unroll
            for (int r = 0; r < 16; ++r) {
                s0[r] = __builtin_fmaxf(p0[r], 0.f) + __builtin_amdgcn_logf(1.0f + __builtin_amdgcn_exp2f(-__builtin_fabsf(p0[r])));
                s1[r] = __builtin_fmaxf(p1[r], 0.f) + __builtin_amdgcn_logf(1.0f + __builtin_amdgcn_exp2f(-__builtin_fabsf(p1[r]))); }
#pragma unroll
            for (int g = 0; g < 4; ++g) { s0[4 * g + 2] += s0[4 * g + 3]; s0[4 * g + 1] += s0[4 * g + 2]; s0[4 * g] += s0[4 * g + 1]; s1[4 * g + 2] += s1[4 * g + 3]; s1[4 * g + 1] += s1[4 * g + 2]; s1[4 * g] += s1[4 * g + 1]; }
            float To[8], Tp[8], F[8];
#pragma unroll
            for (int g = 0; g < 4; ++g) { To[g] = s0[4 * g]; To[4 + g] = s1[4 * g]; }
#pragma unroll
            for (int g = 0; g < 8; ++g) Tp[g] = half_swap(To[g], hi);
            F[7] = 0.f;
#pragma unroll
            for (int g = 6; g >= 0; --g) F[g] = F[g + 1] + (To[g + 1] + Tp[g + 1]);
            const float total = F[0] + (To[0] + Tp[0]);
#pragma unroll
            for (int g = 0; g < 8; ++g) { const float E = R + F[g] + (hi == 0 ? Tp[g] : 0.f);
#pragma unroll
                for (int i = 0; i < 4; ++i) { if (g < 4) p0[4 * g + i] = __builtin_amdgcn_exp2f(p0[4 * g + i] - (E + s0[4 * g + i])); else p1[4 * (g - 4) + i] = __builtin_amdgcn_exp2f(p1[4 * (g - 4) + i] - (E + s1[4 * (g - 4) + i])); } }
            R += total;
            v4u pw0, pw1, pw2, pw3; pack_p(p0, p1, pw0, pw1, pw2, pw3);
            pv<2>(o, vb + slot * SLOT, pw0, pw1, pw2, pw3);
            done = __all(R > RTH);
        }
        if (lane == 0) LWv[LW_FLAG + wid] = (done || j == 0) ? 1u : 0u;
        lds_bar();
        unsigned alld = 1u;
#pragma unroll
        for (int w = 0; w < 8; ++w) alld &= LWv[LW_FLAG + w];
        slot ^= 1;
        if (alld) break;
    }
    wait_bar<0>();
    float ones[16];
#pragma unroll
    for (int r = 0; r < 16; ++r) ones[r] = 1.0f;
    store_o<2>(o, ones, lds + LDS_STG + wid * STG_W, ysb + (rowb + qw0) * YP + h * 64, lane, r32, hi);
}

template <int NDB> __device__ __forceinline__ void softmax_tile(f32x16& p0, f32x16& p1, f32x16* o, float& m, float& l, float cb, const LAS float* tabp, volatile LAS float* wsf, int r32, int hi) {
    if (tabp) {
#pragma unroll
        for (int r = 0; r < 16; ++r) { p0[r] += tabp[crow(r, 0)] - cb; p1[r] += tabp[32 + crow(r, 0)] - cb; }
    }
    float a = __builtin_fmaxf(__builtin_fmaxf(p0[0], p0[1]), p1[0]), b = __builtin_fmaxf(__builtin_fmaxf(p0[2], p0[3]), p1[1]); a = __builtin_fmaxf(__builtin_fmaxf(a, p1[2]), p1[3]);
#pragma unroll
    for (int r = 4; r < 16; r += 4) { a = __builtin_fmaxf(__builtin_fmaxf(a, p0[r]), p0[r + 1]); b = __builtin_fmaxf(__builtin_fmaxf(b, p0[r + 2]), p0[r + 3]); a = __builtin_fmaxf(__builtin_fmaxf(a, p1[r]), p1[r + 1]); b = __builtin_fmaxf(__builtin_fmaxf(b, p1[r + 2]), p1[r + 3]); }
    float rm = __builtin_fmaxf(a, b); rm = __builtin_fmaxf(rm, half_swap(rm, hi));
    if (__any(rm > m + 8.0f)) {
        const float mn = __builtin_fmaxf(m, rm), f = __builtin_amdgcn_exp2f(m - mn);
        l *= f; m = mn;
        if (hi == 0) wsf[r32] = f;
        LDS_WAIT();
#pragma unroll
        for (int r = 0; r < 16; ++r) { const float fr_ = wsf[crow(r, hi)];
#pragma unroll
            for (int db = 0; db < NDB; ++db) o[db][r] *= fr_; }
        LDS_WAIT();
    }
    float s = 0.f;
#pragma unroll
    for (int r = 0; r < 16; ++r) { p0[r] = __builtin_amdgcn_exp2f(p0[r] - m); p1[r] = __builtin_amdgcn_exp2f(p1[r] - m); s += p0[r] + p1[r]; }
    l += s;
}
__device__ __forceinline__ void row_inv_l(float l, float* rli, volatile LAS float* wsf, int r32, int hi) {
    l += half_swap(l, hi);
    if (hi == 0) wsf[r32] = l;
    LDS_WAIT();
#pragma unroll
    for (int r = 0; r < 16; ++r) rli[r] = __builtin_amdgcn_rcpf(wsf[crow(r, hi)]);
    LDS_WAIT();
}

__device__ __forceinline__ void df_unit(LAS unsigned char* lds, volatile LAS unsigned* LWv, const bf16* proj, bf16* ydf, const float* subg, float lam, float outscale, int b, int H, int qt, int, int) {
    const int tid_ = tid_opaque(), lane = tid_ & 63, wid = __builtin_amdgcn_readfirstlane(tid_ >> 6);
    const int r32 = lane & 31, hi = lane >> 5, q0 = qt * 256, qw0 = q0 + 32 * wid;
    const size_t rowb = (size_t)b * SEQ;
    const bf16* Vh = proj + rowb * INW + 5 * W + H * 128;
    const unsigned lds0 = (unsigned)(uintptr_t)lds;
    volatile LAS float* wsf = (volatile LAS float*)(LWv + LW_WSF + wid * 64);
    LAS unsigned char* stg = lds + LDS_STG + wid * STG_W;
    lptr vb = (lptr)lds + LDS_V + ((lane >> 4) & 1) * 32 + (lane & 3) * 8 + (4 * hi + ((lane & 15) >> 2)) * 64;
    const int jmax = q0 / 64 + 3, jw = qw0 / 64;
    f32x16 o[4];
#pragma unroll 1
    for (int mp = 0; mp < 2; ++mp) {
        const int h2 = 2 * H + mp;
        const bf16* Qw = proj + (rowb + qw0) * INW + 3 * W + h2 * 64; const bf16* Kh = proj + rowb * INW + 4 * W + h2 * 64;
        const LAS float* tab = (const LAS float*)(LWv + LW_TAB) + h2 * 256;
        const float cfar = tab[0];
        bf16x8 qr[4];
#pragma unroll
        for (int d0 = 0; d0 < 4; ++d0) qr[d0] = *(const bf16x8*)(Qw + (size_t)r32 * INW + d0 * 16 + hi * 8);
#pragma unroll
        for (int db = 0; db < 4; ++db) o[db] = (f32x16){};
        float m = -INFINITY, l = 0.f;
        dma_tile<1, 2>(Kh, Vh, INW, lds0 + LDS_K, lds0 + LDS_V, wid, lane);
        int slot = 0;
#pragma unroll 1
        for (int j = 0; j <= jmax; ++j) {
            if (j < jmax) { dma_tile<1, 2>(Kh + (size_t)(j + 1) * 64 * INW, Vh + (size_t)(j + 1) * 64 * INW, INW, lds0 + LDS_K + (slot ^ 1) * SLOT, lds0 + LDS_V + (slot ^ 1) * SLOT, wid, lane); wait_bar<3>(); }
            else wait_bar<0>();
            if (j <= jw) {
                f32x16 p0, p1;
                qkt<4>(p0, p1, (lptr)lds + LDS_K + slot * SLOT, qr, r32, hi);
                const int relmax = 64 * j + 63 - qw0;
                const LAS float* tabp = (relmax > -91) ? tab + (64 * j - qw0 + 192 + 4 * hi - r32) : nullptr;
                softmax_tile<4>(p0, p1, o, m, l, cfar, tabp, wsf, r32, hi);
                v4u pw0, pw1, pw2, pw3; pack_p(p0, p1, pw0, pw1, pw2, pw3);
                pv<4>(o, vb + slot * SLOT, pw0, pw1, pw2, pw3);
            }
            lds_bar();
            slot ^= 1;
        }
        float rli[16]; row_inv_l(l, rli, wsf, r32, hi);
        LAS bf16* st = (LAS bf16*)stg;
        if (mp == 0) {
#pragma unroll
            for (int r = 0; r < 16; ++r) { const int orow = crow(r, hi);
#pragma unroll
                for (int db = 0; db < 4; ++db) st[orow * 128 + db * 32 + r32] = (bf16)f2bf(o[db][r] * rli[r]); }
            LDS_WAIT();
        } else {
            float ss[16];
#pragma unroll
            for (int r = 0; r < 16; ++r) { const int orow = crow(r, hi); float q = 0.f;
#pragma unroll
                for (int db = 0; db < 4; ++db) { const float a = bf2f(st[orow * 128 + db * 32 + r32]) - lam * (o[db][r] * rli[r]); o[db][r] = a; q += a * a; }
                ss[r] = q; }
#pragma unroll
            for (int r = 0; r < 16; ++r) { float q = ss[r];
#pragma unroll
                for (int x = 1; x < 32; x <<= 1) q += __shfl_xor(q, x);
                ss[r] = __builtin_amdgcn_rsqf(q * (1.0f / 128.0f) + RMS_EPS) * outscale; }
#pragma unroll
            for (int db = 0; db < 4; ++db) { const float g = subg[db * 32 + r32];
#pragma unroll
                for (int r = 0; r < 16; ++r) o[db][r] *= g; }
            LDS_WAIT();
            store_o<4>(o, ss, stg, ydf + (rowb + qw0) * YP + H * 128, lane, r32, hi);
        }
    }
}

__device__ __forceinline__ void mem_unit(LAS unsigned char* lds, volatile LAS unsigned* LWv, const bf16* proj, const bf16* memkv, bf16* ymem, int b, int h, int qt, int, int) {
    const int tid_ = tid_opaque(), lane = tid_ & 63, wid = __builtin_amdgcn_readfirstlane(tid_ >> 6);
    const int r32 = lane & 31, hi = lane >> 5, q0 = qt * 256, qw0 = q0 + 32 * wid;
    const size_t rowb = (size_t)b * SEQ;
    const bf16* Qw = proj + (rowb + qw0) * INW + 6 * W + h * 128; const bf16* Kh = memkv + (size_t)b * MEML * 2048 + h * 128; const bf16* Vh = Kh + W;
    const unsigned lds0 = (unsigned)(uintptr_t)lds;
    volatile LAS float* wsf = (volatile LAS float*)(LWv + LW_WSF + wid * 64);
    lptr vb = (lptr)lds + LDS_V + ((lane >> 4) & 1) * 32 + (lane & 3) * 8 + (4 * hi + ((lane & 15) >> 2)) * 64;
    bf16x8 qr[8];
#pragma unroll
    for (int d0 = 0; d0 < 8; ++d0) qr[d0] = *(const bf16x8*)(Qw + (size_t)r32 * INW + d0 * 16 + hi * 8);
    f32x16 o[4];
#pragma unroll
    for (int db = 0; db < 4; ++db) o[db] = (f32x16){};
    float m = -INFINITY, l = 0.f;
    dma_tile<2, 2>(Kh, Vh, 2048, lds0 + LDS_K, lds0 + LDS_V, wid, lane);
    int slot = 0;
#pragma unroll 1
    for (int j = 0; j < MEML / 64; ++j) {
        if (j + 1 < MEML / 64) { dma_tile<2, 2>(Kh + (size_t)(j + 1) * 64 * 2048, Vh + (size_t)(j + 1) * 64 * 2048, 2048, lds0 + LDS_K + (slot ^ 1) * SLOT, lds0 + LDS_V + (slot ^ 1) * SLOT, wid, lane); wait_bar<4>(); }
        else wait_bar<0>();
        f32x16 p0, p1;
        qkt<8>(p0, p1, (lptr)lds + LDS_K + slot * SLOT, qr, r32, hi);
        softmax_tile<4>(p0, p1, o, m, l, 0.f, nullptr, wsf, r32, hi);
        v4u pw0, pw1, pw2, pw3; pack_p(p0, p1, pw0, pw1, pw2, pw3);
        pv<4>(o, vb + slot * SLOT, pw0, pw1, pw2, pw3);
        lds_bar();
        slot ^= 1;
    }
    float rli[16]; row_inv_l(l, rli, wsf, r32, hi);
    store_o<4>(o, rli, lds + LDS_STG + wid * STG_W, ymem + (rowb + qw0) * YP + h * 128, lane, r32, hi);
}
}

#define PH_LOCALS() KArgs ka = ka_opaque(); unsigned char* ws = ka->ws; const int tid = tid_opaque(), lane = tid & 63, wave = __builtin_amdgcn_readfirstlane(tid >> 6); \
    const int G = gridDim.x, bx = blockIdx.x, vcu = (G % 8 == 0) ? (bx % 8) * (G / 8) + bx / 8 : bx, gw = vcu * NWAVES + wave, NGW = G * NWAVES; \
    (void)ws; (void)lane; (void)wave; (void)gw; (void)NGW; (void)vcu; (void)bx
__global__ void __launch_bounds__(NWAVES * 64, 2) mk_fwd(Args args) {
    extern __shared__ __attribute__((aligned(16))) unsigned char lds_raw[];
    LAS unsigned char* lds = (LAS unsigned char*)lds_raw;
    volatile LAS unsigned* LW = (volatile LAS unsigned*)(lds + LDSCTL_OFF);
    for (int u = threadIdx.x; u < (LDS_BYTES - LDSCTL_OFF) / 4; u += NWAVES * 64) ((LAS unsigned*)(lds + LDSCTL_OFF))[u] = 0u;
    __syncthreads();
#if MK_ONE_LAUNCH
    XcdBarrier bar = xcd_barrier_post((unsigned*)((gu32*)(args.ws + WS_CTL) + CW_BAR), LW + LW_BAR);
#define GRID_BAR() xcd_barrier(bar)
#else
#define GRID_BAR() do {} while (0)
#endif
    const int lo = args.ph_lo, hi = args.ph_hi;
#define IN(k) (lo <= (k) && (k) < hi)
#define BOTH(k) (IN(k) && IN((k) + 1))

    if (PH_EN(0) && IN(0)) REP(0) {
        PH_LOCALS();
        LAS float* scr = (LAS float*)(lds + RING_OFF + wave * 16384);
        constexpr int I_IN = 16 * (INW / 32), I_SQ = 16 * 32, I_BR = 8 * 32, I_GU = 16 * 64, I_D = 16 * 32;
        constexpr int PER_LAYER = I_IN + I_SQ + 3 * I_BR + I_SQ + NE * I_GU + NE * I_D;
#pragma unroll 1
        for (int it = gw; it < DEPTH * PER_LAYER; it += NGW) {
            const int l = it / PER_LAYER; int r = it % PER_LAYER;
            if (p0_matrix(r, ka->in[2] + (size_t)l * D * INW, D, INW, (bf16*)(ws + WS_WIN) + (size_t)l * INW * D, false, scr, lane)) continue;
            if (p0_matrix(r, ka->in[7] + (size_t)l * D * 1024, D, 1024, (bf16*)(ws + WS_WMEMKV) + (size_t)l * 1024 * D, false, scr, lane)) continue;
            if (r < 3 * I_BR) { const int b = r / I_BR; int rr = r % I_BR;
                p0_matrix(rr, ka->in[8] + ((size_t)l * 3 + b) * W * D, W, D, (bf16*)(ws + WS_WBR) + (size_t)l * D * 3 * W, false, scr, lane, 3 * W, b * W); continue; }
            r -= 3 * I_BR;
            if (p0_matrix(r, ka->in[9] + (size_t)l * D * D, D, D, (bf16*)(ws + WS_WOUT) + (size_t)l * D * D, false, scr, lane)) continue;
            if (r < NE * I_GU) { const int e = r / I_GU; int rr = r % I_GU;
                p0_matrix(rr, ka->in[14] + ((size_t)l * NE + e) * D * 2 * DFF, D, 2 * DFF, (bf16*)(ws + WS_WGU) + ((size_t)l * NE + e) * 2 * DFF * D, true, scr, lane); continue; }
            r -= NE * I_GU;
            { const int e = r / I_D; int rr = r % I_D;
                p0_matrix(rr, ka->in[16] + ((size_t)l * NE + e) * DFF * D, DFF, D, (bf16*)(ws + WS_WD) + ((size_t)l * NE + e) * D * DFF, false, scr, lane); }
        }
        { const float* x_in = ka->in[0]; bf16* XN = (bf16*)(ws + WS_XN);
#pragma unroll 1
          for (int m = gw; m < T; m += NGW) row_to_bf16(x_in + (size_t)m * D, XN + (size_t)m * D, lane); }
        { const float* mem_in = ka->in[1]; bf16* MEMB = (bf16*)(ws + WS_MEMB);
#pragma unroll 1
          for (int m = gw; m < MEMT; m += NGW) row_to_bf16(mem_in + (size_t)m * D, MEMB + (size_t)m * D, lane); }
        if (BOTH(0)) GRID_BAR();
    }

#pragma unroll 1
    for (int l = 0; l < DEPTH; ++l) {
        const int pb = 1 + 8 * l;
        if (PH_EN(1) && IN(pb + 0)) REP(1) {
            { PH_LOCALS();
              pg8::DenseOrder S{(const char*)(ws + WS_XN), (const char*)((bf16*)(ws + WS_WIN) + (size_t)l * INW * D), T / 256, INW / 256, G, bx, D};
              pg8::EpiProj E{(bf16*)(ws + WS_PROJ), INW, ka->in[3] + (size_t)l * 3 * D, GATE0, GATE0};
              pg8::gemm_phase<pg8::EpiProj, pg8::DenseOrder, false, true>(lds + RING_OFF, D, S, E); }
            if (l == 0) { PH_LOCALS();
              pg8::DenseOrder S{(const char*)(ws + WS_MEMB), (const char*)(ws + WS_WMEMKV), MEMT / 256, 2048 / 256, G, bx, D};
              pg8::EpiProj E{(bf16*)(ws + WS_MEMKV2), 2048, nullptr, 1 << 30, 0};
              pg8::gemm_phase<pg8::EpiProj, pg8::DenseOrder, false, true>(lds + RING_OFF, D, S, E); }
            if (BOTH(pb + 0)) GRID_BAR();
        }
        if (PH_EN(2) && IN(pb + 1)) REP(2) {
            PH_LOCALS();
            const bf16* PROJ = (const bf16*)(ws + WS_PROJ); bf16* YB = (bf16*)(ws + WS_Y);
            { LAS float* tab = (LAS float*)(lds + LDSCTL_OFF) + att::LW_TAB; const float* rel_bias = ka->in[6];
              for (int i = tid; i < 8 * 256; i += NWAVES * 64) tab[i] = rel_bias[t5_bucket((i & 255) - 192) * 8 + (i >> 8)] * att::LOG2E; }
            float lam, outscale;
            { const float* dl = ka->in[4] + (size_t)l * 256; float s1 = 0.f, s2 = 0.f;
              for (int i = 0; i < 64; ++i) { s1 += dl[i] * dl[64 + i]; s2 += dl[128 + i] * dl[192 + i]; }
              const float lam_init = 0.8f - 0.6f * expf(-0.3f * (float)l); lam = expf(s1) - expf(s2) + lam_init; outscale = 1.0f - lam_init; }
            __syncthreads();
            const float* subg = ka->in[5] + (size_t)l * 128;
#pragma unroll 1
            REP(9) for (int it = vcu; ATT_EN(0) && it < BATCH * 4 * 8; it += G) { const int bH = it >> 3, s8 = it & 7;
#pragma unroll 1
                for (int z = 0; z < 2; ++z) att::df_unit(lds, LW, PROJ, YB + W, subg, lam, outscale, bH >> 2, bH & 3, z ? s8 : 15 - s8, wave, lane); }
#pragma unroll 1
            REP(10) for (int u = vcu; ATT_EN(1) && u < BATCH * 8 * 16; u += G) { const int bh = u >> 4; att::sb_unit(lds, LW, PROJ, YB, bh >> 3, bh & 7, u & 15, wave, lane); }
#pragma unroll 1
            REP(11) for (int u = vcu; ATT_EN(2) && u < BATCH * 4 * 16; u += G) { const int bh = u >> 4; att::mem_unit(lds, LW, PROJ, (const bf16*)(ws + WS_MEMKV2) + l * 1024, YB + 2 * W, bh >> 2, bh & 3, u & 15, wave, lane); }
            if (BOTH(pb + 1)) GRID_BAR();
        }
        if (PH_EN(3) && IN(pb + 2)) REP(3) {
            PH_LOCALS();
            pg8::DenseOrder S{(const char*)(ws + WS_Y), (const char*)((bf16*)(ws + WS_WBR) + (size_t)l * D * 3 * W), T / 256, D / 256, G, bx, 3 * W};
            pg8::EpiBranch E{(const bf16*)(ws + WS_PROJ), (bf16*)(ws + WS_MERGED)};
            pg8::gemm_phase<pg8::EpiBranch, pg8::DenseOrder, false, true>(lds + RING_OFF, 3 * W, S, E);
            if (BOTH(pb + 2)) GRID_BAR();
        }
        if (PH_EN(4) && IN(pb + 3)) REP(4) {
            PH_LOCALS();
            const float* xprev = (l == 0) ? ka->in[0] : ka->out;
            pg8::DenseOrder S{(const char*)(ws + WS_MERGED), (const char*)((bf16*)(ws + WS_WOUT) + (size_t)l * D * D), T / 256, D / 256, G, bx, D};
            pg8::EpiOut E{xprev, (float*)(ws + WS_X1)};
            pg8::gemm_phase<pg8::EpiOut, pg8::DenseOrder, false, true>(lds + RING_OFF, D, S, E);
            if (BOTH(pb + 3)) GRID_BAR();
        }
        if (PH_EN(5) && IN(pb + 4)) {
            PH_LOCALS();
            gu32* ctl = (gu32*)(ws + WS_CTL); float* X1 = (float*)(ws + WS_X1); bf16* XN = (bf16*)(ws + WS_XN); int* PERM = (int*)(ws + WS_PERM); float* SLOTW = (float*)(ws + WS_SLOTW); unsigned* SLOTPOS = (unsigned*)(ws + WS_SLOTPOS); float* STATS = (float*)(ws + WS_STATS);
            LAS float* WT = (LAS float*)(lds + RING_OFF);
            const float* rw = ka->in[12] + (size_t)l * D * NE; const float* rb = ka->in[13] + (size_t)l * NE;
            for (int i = tid; i < D * NE; i += NWAVES * 64) { const int k = i >> 5, e = i & 31; WT[e * WT_STRIDE + k] = rw[i]; }
            if (tid < NE) LW[LW_RCNT + tid] = 0u;
            __syncthreads();
            const float* g1 = ka->in[10] + (size_t)l * D; const float* b1 = ka->in[11] + (size_t)l * D;
            f32x4 gv[4], bv[4];
#pragma unroll
            for (int j = 0; j < 4; ++j) { gv[j] = *(const f32x4*)(g1 + 256 * j + 4 * lane); bv[j] = *(const f32x4*)(b1 + 256 * j + 4 * lane); }
            const int rows_per_wg = (T + G - 1) / G, rows_per_wave = (((rows_per_wg + NWAVES - 1) / NWAVES) + 1) & ~1;
            const int rbase = vcu * rows_per_wg + wave * rows_per_wave;
            const int myexp = (lane >> 1) & 31;
            const float myrb = rb[myexp];
#pragma unroll 1
            for (int ri = 0; ri < rows_per_wave; ri += 2) {
                const int m0 = rbase + ri;
                const bool ok0 = (m0 < T) && (wave * rows_per_wave + ri) < rows_per_wg, ok1 = (m0 + 1 < T) && (wave * rows_per_wave + ri + 1) < rows_per_wg;
                if (!ok0) break;
                const int m1 = ok1 ? m0 + 1 : m0;
                GAS f32x4* xr0 = (GAS f32x4*)(X1 + (size_t)m0 * D) + lane; GAS f32x4* xr1 = (GAS f32x4*)(X1 + (size_t)m1 * D) + lane;
                f32x4 v0[4], v1[4]; float s0 = 0.f, s1 = 0.f;
#pragma unroll
                for (int j = 0; j < 4; ++j) { v0[j] = xr0[64 * j]; v1[j] = xr1[64 * j]; }
#pragma unroll
                for (int j = 0; j < 4; ++j) { s0 += (v0[j].x + v0[j].y) + (v0[j].z + v0[j].w); s1 += (v1[j].x + v1[j].y) + (v1[j].z + v1[j].w); }
                const float mean0 = wave_sum(s0) * (1.f / D), mean1 = wave_sum(s1) * (1.f / D); float q0 = 0.f, q1 = 0.f;
#pragma unroll
                for (int j = 0; j < 4; ++j) { v0[j] = v0[j] - mean0; v1[j] = v1[j] - mean1;
                    q0 += (v0[j].x * v0[j].x + v0[j].y * v0[j].y) + (v0[j].z * v0[j].z + v0[j].w * v0[j].w); q1 += (v1[j].x * v1[j].x + v1[j].y * v1[j].y) + (v1[j].z * v1[j].z + v1[j].w * v1[j].w); }
                const float rstd0 = 1.f / sqrtf(wave_sum(q0) * (1.f / D) + LN_EPS), rstd1 = 1.f / sqrtf(wave_sum(q1) * (1.f / D) + LN_EPS);
                GAS unsigned long long* o80 = (GAS unsigned long long*)(XN + (size_t)m0 * D) + lane; GAS unsigned long long* o81 = (GAS unsigned long long*)(XN + (size_t)m1 * D) + lane;
#pragma unroll
                for (int j = 0; j < 4; ++j) { v0[j] = v0[j] * rstd0 * gv[j] + bv[j]; v1[j] = v1[j] * rstd1 * gv[j] + bv[j];
                    o80[64 * j] = (unsigned long long)pk2(v0[j].x, v0[j].y) | ((unsigned long long)pk2(v0[j].z, v0[j].w) << 32);
                    if (ok1) o81[64 * j] = (unsigned long long)pk2(v1[j].x, v1[j].y) | ((unsigned long long)pk2(v1[j].z, v1[j].w) << 32); }
                if (lane == 0) { STATS[2 * (size_t)m0] = mean0; STATS[2 * (size_t)m0 + 1] = rstd0; if (ok1) { STATS[2 * (size_t)m1] = mean1; STATS[2 * (size_t)m1 + 1] = rstd1; } }
                float pa[NE], pb[NE];
#pragma unroll
                for (int e = 0; e < NE; ++e) { float a = 0.f, b = 0.f;
#pragma unroll
                    for (int j = 0; j < 4; ++j) { const f32x4 w = *(const LAS f32x4*)(WT + e * WT_STRIDE + 256 * j + 4 * lane);
                        a += (v0[j].x * w.x + v0[j].y * w.y) + (v0[j].z * w.z + v0[j].w * w.w); b += (v1[j].x * w.x + v1[j].y * w.y) + (v1[j].z * w.z + v1[j].w * w.w); }
                    pa[e] = a; pb[e] = b; }
#define RT_SWAP(P, n, SW) _Pragma("unroll") for (int e = 0; e < n; ++e) { auto rr = SW(__float_as_uint(P[e]), __float_as_uint(P[e + n]), false, false); P[e] = __uint_as_float(rr[0]) + __uint_as_float(rr[1]); }
                RT_SWAP(pa, 16, __builtin_amdgcn_permlane32_swap) RT_SWAP(pb, 16, __builtin_amdgcn_permlane32_swap)
                RT_SWAP(pa, 8, __builtin_amdgcn_permlane16_swap) RT_SWAP(pb, 8, __builtin_amdgcn_permlane16_swap)
#undef RT_SWAP
#pragma unroll
                for (int e = 0; e < 4; ++e) { const bool up = (lane & 8) != 0; const float ka_ = up ? pa[e + 4] : pa[e], sa_ = up ? pa[e] : pa[e + 4], kb_ = up ? pb[e + 4] : pb[e], sb_ = up ? pb[e] : pb[e + 4];
                    pa[e] = ka_ + dppf<0x128>(sa_); pb[e] = kb_ + dppf<0x128>(sb_); }
#pragma unroll
                for (int e = 0; e < 2; ++e) { const bool up = (lane & 4) != 0; const float ka_ = up ? pa[e + 2] : pa[e], sa_ = up ? pa[e] : pa[e + 2], kb_ = up ? pb[e + 2] : pb[e], sb_ = up ? pb[e] : pb[e + 2];
                    pa[e] = ka_ + __shfl_xor(sa_, 4); pb[e] = kb_ + __shfl_xor(sb_, 4); }
                { const bool up = (lane & 2) != 0; const float ka_ = up ? pa[1] : pa[0], sa_ = up ? pa[0] : pa[1], kb_ = up ? pb[1] : pb[0], sb_ = up ? pb[0] : pb[1];
                    pa[0] = ka_ + dppf<0x4E>(sa_); pb[0] = kb_ + dppf<0x4E>(sb_); }
                const float la = pa[0] + dppf<0xB1>(pa[0]) + myrb, lb = pb[0] + dppf<0xB1>(pb[0]) + myrb;
                int ra = 0, rbk = 0;
#pragma unroll
                for (int e = 0; e < NE; ++e) { const float xa = __int_as_float(__builtin_amdgcn_readlane(__float_as_int(la), 2 * e)), xb = __int_as_float(__builtin_amdgcn_readlane(__float_as_int(lb), 2 * e));
                    ra += (xa > la || (xa == la && e < myexp)) ? 1 : 0; rbk += (xb > lb || (xb == lb && e < myexp)) ? 1 : 0; }
                float tva[TOPK], tvb[TOPK]; int tea[TOPK], teb[TOPK];
#pragma unroll
                for (int k = 0; k < TOPK; ++k) {
                    const unsigned long long ma = __ballot(ra == k), mb = __ballot(rbk == k);
                    const int lna = ma ? (int)__builtin_ctzll(ma) : 0, lnb = mb ? (int)__builtin_ctzll(mb) : 0;
                    tea[k] = lna >> 1; teb[k] = lnb >> 1;
                    tva[k] = __int_as_float(__builtin_amdgcn_readlane(__float_as_int(la), lna)); tvb[k] = __int_as_float(__builtin_amdgcn_readlane(__float_as_int(lb), lnb)); }
                float ewa[TOPK], ewb[TOPK], esa = 0.f, esb = 0.f;
#pragma unroll
                for (int k = 0; k < TOPK; ++k) { ewa[k] = fast_exp(tva[k] - tva[0]); esa += ewa[k]; ewb[k] = fast_exp(tvb[k] - tvb[0]); esb += ewb[k]; }
                const float inva = 1.0f / esa, invb = 1.0f / esb;
                if (lane < 2 * TOPK && (lane < TOPK || ok1)) {
                    const int kk = lane & 3; const bool second = lane >= TOPK;
                    const int ek = second ? (kk == 0 ? teb[0] : kk == 1 ? teb[1] : kk == 2 ? teb[2] : teb[3]) : (kk == 0 ? tea[0] : kk == 1 ? tea[1] : kk == 2 ? tea[2] : tea[3]);
                    const float wk = second ? (kk == 0 ? ewb[0] : kk == 1 ? ewb[1] : kk == 2 ? ewb[2] : ewb[3]) * invb : (kk == 0 ? ewa[0] : kk == 1 ? ewa[1] : kk == 2 ? ewa[2] : ewa[3]) * inva;
                    const unsigned lr = __hip_atomic_fetch_add((LAS unsigned*)(LW + LW_RCNT + ek), 1u, __ATOMIC_RELAXED, __HIP_MEMORY_SCOPE_WORKGROUP);
                    LW[LW_RSLOT + wave * RSLOT_STRIDE + ri * 4 + lane] = ((unsigned)ek << 16) | lr;
                    SLOTW[(size_t)m0 * 4 + lane] = wk;
                }
            }
            __syncthreads();
            if (tid < NE) { const unsigned c = LW[LW_RCNT + tid]; LW[LW_RBASE + tid] = c ? __hip_atomic_fetch_add(ctl + CW_CNT + (l * NE + tid) * 64, c, RLX_AGENT) : 0u; }
            __syncthreads();
            for (int q = lane; q < rows_per_wave * 4; q += 64) { const int ri = q >> 2, m = rbase + ri;
                if (m < T && (wave * rows_per_wave + ri) < rows_per_wg) { const unsigned ent = LW[LW_RSLOT + wave * RSLOT_STRIDE + q]; const unsigned e = ent >> 16, lr = ent & 0xffffu;
                    const unsigned rk = LW[LW_RBASE + e] + lr; PERM[(size_t)e * T + rk] = m * 4 + (q & 3); SLOTPOS[(size_t)m * 4 + (q & 3)] = (e << 16) | rk; } }
            if (BOTH(pb + 4)) GRID_BAR();
        }
        if ((PH_EN(6) && IN(pb + 5)) || (PH_EN(7) && IN(pb + 6)) || (PH_EN(8) && IN(pb + 7))) {
            PH_LOCALS();
            gu32* ctl = (gu32*)(ws + WS_CTL);
            __syncthreads();
            if (tid == 0) { int acc_t = 0;
                for (int e = 0; e < NE; ++e) { const int c = (int)__hip_atomic_load(ctl + CW_CNT + (l * NE + e) * 64, RLX_AGENT); LW[LW_LCNT + e] = (unsigned)c; LW[LW_TOFF + e] = (unsigned)acc_t; acc_t += (c + 255) >> 8; }
                LW[LW_TOFF + NE] = (unsigned)acc_t; }
            __syncthreads();
        }
        if (PH_EN(6) && IN(pb + 5)) REP(6) {
            PH_LOCALS();
            const LAS int* toff = (const LAS int*)(lds + LDSCTL_OFF) + LW_TOFF; const LAS int* lcnt = (const LAS int*)(lds + LDSCTL_OFF) + LW_LCNT;
            pg8::MoeOrder S{(const char*)(ws + WS_XN), (const char*)((bf16*)(ws + WS_WGU) + (size_t)l * NE * 2 * DFF * D), 2 * DFF / 256, toff[NE], G, bx, D, (size_t)2 * DFF * D * 2, toff, lcnt, (const int*)(ws + WS_PERM)};
            pg8::EpiGateUp E{(bf16*)(ws + WS_ACT), ka->in[15] + (size_t)l * NE * 2 * DFF};
            pg8::gemm_phase<pg8::EpiGateUp, pg8::MoeOrder, true, true>(lds + RING_OFF, D, S, E);
            if (BOTH(pb + 5)) GRID_BAR();
        }
        if (PH_EN(7) && IN(pb + 6)) REP(7) {
            PH_LOCALS();
            const LAS int* toff = (const LAS int*)(lds + LDSCTL_OFF) + LW_TOFF; const LAS int* lcnt = (const LAS int*)(lds + LDSCTL_OFF) + LW_LCNT;
            pg8::MoeDenseOrder S{{(const char*)(ws + WS_ACT), (const char*)((bf16*)(ws + WS_WD) + (size_t)l * NE * D * DFF), D / 256, toff[NE], G, bx, DFF, (size_t)D * DFF * 2, toff, lcnt, (const int*)(ws + WS_PERM)}};
            pg8::EpiDown E{(bf16*)(ws + WS_CONTRIB), ka->in[17] + (size_t)l * NE * D};
            pg8::gemm_phase<pg8::EpiDown, pg8::MoeDenseOrder, false, true>(lds + RING_OFF, DFF, S, E);
            if (BOTH(pb + 6)) GRID_BAR();
        }
        if (PH_EN(8) && IN(pb + 7)) REP(8) {
            PH_LOCALS();
            const float* X1 = (const float*)(ws + WS_X1); bf16* XN = (bf16*)(ws + WS_XN); const bf16* CONTRIB = (const bf16*)(ws + WS_CONTRIB); float* outp = ka->out; const unsigned* SLOTPOS = (const unsigned*)(ws + WS_SLOTPOS); const float* SLOTW = (const float*)(ws + WS_SLOTW);
            const float* g2 = ka->in[18] + (size_t)l * D; const float* b2 = ka->in[19] + (size_t)l * D; const float* g1 = ka->in[10] + (size_t)l * D; const float* b1 = ka->in[11] + (size_t)l * D;
            const float* STATS = (const float*)(ws + WS_STATS);
            f32x4 gv[4], bv[4], g1v[4], b1v[4];
#pragma unroll
            for (int j = 0; j < 4; ++j) { gv[j] = *(const f32x4*)(g2 + 256 * j + 4 * lane); bv[j] = *(const f32x4*)(b2 + 256 * j + 4 * lane); g1v[j] = *(const f32x4*)(g1 + 256 * j + 4 * lane); b1v[j] = *(const f32x4*)(b1 + 256 * j + 4 * lane); }
#pragma unroll 1
            for (int m = gw; m < T; m += NGW) {
                const GAS f32x4* xr = (const GAS f32x4*)(X1 + (size_t)m * D) + lane;
                f32x4 v[4]; float s = 0.f;
#pragma unroll
                for (int j = 0; j < 4; ++j) v[j] = xr[64 * j];
                { const float mean1 = STATS[2 * (size_t)m], rstd1 = STATS[2 * (size_t)m + 1];
#pragma unroll
                  for (int j = 0; j < 4; ++j) v[j] = (((v[j] - mean1) * rstd1) * g1v[j] + b1v[j]) * DN_ALPHA; }
#pragma unroll
                for (int k = 0; k < TOPK; ++k) { const unsigned sp = SLOTPOS[(size_t)m * 4 + k]; const float cw = SLOTW[(size_t)m * 4 + k];
                    const size_t srow = (size_t)LW[LW_TOFF + (sp >> 16)] * 256 + (sp & 0xffffu);
                    const GAS v2u* cr = (const GAS v2u*)(CONTRIB + srow * D) + lane;
#pragma unroll
                    for (int j = 0; j < 4; ++j) { const v2u c = cr[64 * j]; v[j].x += cw * bflo(c.x); v[j].y += cw * bfhi(c.x); v[j].z += cw * bflo(c.y); v[j].w += cw * bfhi(c.y); } }
#pragma unroll
                for (int j = 0; j < 4; ++j) s += (v[j].x + v[j].y) + (v[j].z + v[j].w);
                const float mean = wave_sum(s) * (1.f / D); float s2 = 0.f;
#pragma unroll
                for (int j = 0; j < 4; ++j) { v[j] = v[j] - mean; s2 += (v[j].x * v[j].x + v[j].y * v[j].y) + (v[j].z * v[j].z + v[j].w * v[j].w); }
                const float rstd = 1.f / sqrtf(wave_sum(s2) * (1.f / D) + LN_EPS);
                GAS f32x4* orow = (GAS f32x4*)(outp + (size_t)m * D) + lane;
                GAS unsigned long long* o8 = (GAS unsigned long long*)(XN + (size_t)m * D) + lane;
#pragma unroll
                for (int j = 0; j < 4; ++j) { v[j] = v[j] * rstd * gv[j] + bv[j]; orow[64 * j] = v[j];
                    if (l + 1 < DEPTH) o8[64 * j] = (unsigned long long)pk2(v[j].x, v[j].y) | ((unsigned long long)pk2(v[j].z, v[j].w) << 32); }
            }
            if (BOTH(pb + 7)) GRID_BAR();
        }
    }
#undef IN
#undef BOTH
}

extern "C" void kernel_launch(void* const* d_in, const int* in_sizes, int n_in, void* d_out, int out_size, void* d_ws, size_t ws_size, hipStream_t stream) {
    static int grid = 0;
    if (grid == 0) {
        if (n_in != 20 || in_sizes[0] != T * D || out_size != T * D || ws_size < WS_END) { fprintf(stderr, "kernel_launch: unexpected shapes / workspace (n_in %d, ws %zu, need %zu)\n", n_in, ws_size, (size_t)WS_END); grid = -1; return; }
        int dev = 0, cus = 0, per_cu = 0;
        if (hipGetDevice(&dev) != hipSuccess || hipDeviceGetAttribute(&cus, hipDeviceAttributeMultiprocessorCount, dev) != hipSuccess) { grid = -1; return; }
        if (hipFuncSetAttribute((const void*)mk_fwd, hipFuncAttributeMaxDynamicSharedMemorySize, LDS_BYTES) != hipSuccess) { fprintf(stderr, "kernel_launch: hipFuncSetAttribute failed\n"); grid = -1; return; }
        if (hipOccupancyMaxActiveBlocksPerMultiprocessor(&per_cu, (const void*)mk_fwd, NWAVES * 64, LDS_BYTES) != hipSuccess || per_cu < 1) fprintf(stderr, "kernel_launch: occupancy query reports %d\n", per_cu);
        (void)hipGetLastError();
        grid = cus;
    }
    if (grid < 0) return;
    (void)hipMemsetAsync((char*)d_ws + WS_CTL, 0, CTL_ZERO_BYTES, stream);
    Args a{};
    for (int i = 0; i < 20; ++i) a.in[i] = (const float*)d_in[i];
    a.out = (float*)d_out; a.ws = (unsigned char*)d_ws;
#if MK_ONE_LAUNCH
    a.ph_lo = 0; a.ph_hi = 1 + 8 * DEPTH;
    hipLaunchKernelGGL(mk_fwd, dim3(grid), dim3(NWAVES * 64), LDS_BYTES, stream, a);
#else
    for (int ph = 0; ph < 1 + 8 * DEPTH; ++ph) {
        a.ph_lo = ph; a.ph_hi = ph + 1;
        hipLaunchKernelGGL(mk_fwd, dim3(grid), dim3(NWAVES * 64), LDS_BYTES, stream, a);
    }
#endif
}
```

```cpp
#include <hip/hip_runtime.h>
#include <cstdio>
#include <cstdint>

#ifndef DIS_MASK
#define DIS_MASK 0
#endif
#define PH_EN(k) (((DIS_MASK) >> (k) & 1) == 0)
#ifndef EPI_TWICE_SEL
#define EPI_TWICE_SEL 0
#endif
#if EPI_TWICE_SEL
#define EPI_TWICE 1
#endif
#ifndef GEMM_SKEW_TICKS
#define GEMM_SKEW_TICKS 0
#endif
#ifndef I8_P1
#define I8_P1 1
#endif
#ifndef I8_P6
#define I8_P6 1
#endif
#ifndef REPEAT_MASK
#define REPEAT_MASK 0
#endif
#define REP(k) for (int rep_ = 0; rep_ < (((REPEAT_MASK) >> (k)) & 1) + 1; ++rep_)
#ifndef ATT_MASK
#define ATT_MASK 0
#endif
#define ATT_EN(k) (((ATT_MASK) >> (k) & 1) == 0)
#ifndef MK_ONE_LAUNCH
#define MK_ONE_LAUNCH 1
#endif

constexpr int BATCH = 16, SEQ = 4096, D = 1024, T = BATCH * SEQ, W = 512, INW = 6656, NE = 32, TOPK = 4, DFF = 1024, MEML = 256, MEMT = BATCH * MEML, DEPTH = 2;
constexpr int GATE0 = 7 * W;
constexpr int PP = GATE0;
constexpr float LN_EPS = 1e-5f, RMS_EPS = 1e-5f;
constexpr float DN_ALPHA = 1.4142135623730951f;
constexpr int NWAVES = 8;

constexpr size_t MiB = 1u << 20;
constexpr size_t WS_CTL = 0, CTL_ZERO_BYTES = 1 * MiB;
constexpr size_t WS_DUMP = 1 * MiB;
constexpr size_t WS_PERM = 2 * MiB;
constexpr size_t WS_SLOTW = 10 * MiB;
constexpr size_t WS_SX = 12 * MiB + 512 * 1024;
constexpr size_t WS_SWIN = 13 * MiB;
constexpr size_t WS_SWGU = 13 * MiB + 256 * 1024;
constexpr size_t WS_STATS = 12 * MiB;
constexpr size_t WS_SLOTPOS = 11 * MiB;
constexpr size_t WS_WIN = 16 * MiB;
constexpr size_t WS_WMEMKV = 42 * MiB;
constexpr size_t WS_WBR = 46 * MiB;
constexpr size_t WS_WOUT = 52 * MiB;
constexpr size_t WS_WGU = 56 * MiB;
constexpr size_t WS_WD = 312 * MiB;
constexpr size_t WS_MEMB = 440 * MiB;
constexpr size_t WS_MEMKV = 448 * MiB;
constexpr size_t WS_XN = 456 * MiB;
constexpr size_t WS_X1 = 584 * MiB;
constexpr size_t WS_BIG = 840 * MiB;
constexpr size_t WS_PROJ = WS_BIG;
constexpr size_t WS_G8 = WS_BIG + 448 * MiB;
constexpr size_t WS_Y = WS_BIG + 832 * MiB;
constexpr size_t WS_MERGED = WS_BIG + 1024 * MiB;
constexpr size_t WS_ACT = WS_BIG;
constexpr size_t WS_CONTRIB = WS_BIG + 528 * MiB;
constexpr size_t WS_MEMKV2 = WS_BIG + 1152 * MiB;
constexpr size_t WS_SXP = WS_MEMKV2 + 16 * MiB;
constexpr size_t WS_XQ = WS_BIG + 1088 * MiB;
constexpr size_t WS_END = WS_SXP + 8 * MiB;
static_assert(WS_CONTRIB + (size_t)528 * MiB <= WS_END && WS_MERGED + (size_t)T * D * 2 <= WS_END, "ws map");

constexpr int CW_TMO = 0, CW_CODE = 1;
constexpr int CW_BAR = 4096;
constexpr int CW_CNT = 32768;

constexpr int RING_OFF = 0, RING_BYTES = 132096;
constexpr int LDSCTL_OFF = RING_BYTES;
constexpr int LDS_BYTES = 163840;
constexpr int LW_BAR = 8;
constexpr int LW_TOFF = 64;
constexpr int LW_LCNT = 128;
constexpr int LW_RCNT = 192;
constexpr int LW_RBASE = 256;
constexpr int LW_RSLOT = 320, RSLOT_STRIDE = 256;

#define GAS __attribute__((address_space(1)))
#define LAS __attribute__((address_space(3)))
typedef unsigned short bf16;
typedef unsigned v4u __attribute__((ext_vector_type(4)));
typedef unsigned v2u __attribute__((ext_vector_type(2)));
typedef float f32x4 __attribute__((ext_vector_type(4)));
typedef float f32x2 __attribute__((ext_vector_type(2)));
typedef short bf16x8 __attribute__((ext_vector_type(8)));
typedef GAS unsigned gu32;
#define RLX_AGENT __ATOMIC_RELAXED, __HIP_MEMORY_SCOPE_AGENT
#define LDS_WAIT() asm volatile("s_waitcnt lgkmcnt(0)" ::: "memory")
#define VM_WAIT() asm volatile("s_waitcnt vmcnt(0)" ::: "memory")

__device__ __forceinline__ unsigned f2bf(float f) { unsigned u = __builtin_bit_cast(unsigned, f); return (u + 0x7fffu + ((u >> 16) & 1u)) >> 16; }
__device__ __forceinline__ unsigned pk2(float lo, float hi) { return f2bf(lo) | (f2bf(hi) << 16); }
__device__ __forceinline__ float bflo(unsigned w) { return __uint_as_float(w << 16); }
__device__ __forceinline__ float bfhi(unsigned w) { return __uint_as_float(w & 0xffff0000u); }
__device__ __forceinline__ float bf2f(bf16 b) { return __uint_as_float((unsigned)b << 16); }
__device__ __forceinline__ float fast_exp(float x) { return __builtin_amdgcn_exp2f(x * 1.4426950408889634f); }
__device__ __forceinline__ float fast_sigmoid(float x) { return __builtin_amdgcn_rcpf(1.0f + fast_exp(-x)); }

__device__ __forceinline__ int lane_opaque() { int l = (int)__builtin_amdgcn_mbcnt_hi(~0u, __builtin_amdgcn_mbcnt_lo(~0u, 0u)); asm volatile("" : "+v"(l)); return l; }
__device__ __forceinline__ int tid_opaque() { int t = threadIdx.x; asm volatile("" : "+v"(t)); return t; }
namespace pg8 {
#define PG8_LAS __attribute__((address_space(3)))
typedef unsigned short bf16_t;
typedef unsigned u32x4 __attribute__((ext_vector_type(4)));
typedef int i32x4 __attribute__((ext_vector_type(4)));
constexpr int BM = 256, BK = 64, HALF = 128, HTB = HALF * BK * 2, STAGE_BYTES = 8 * HTB, NXCD = 8, WGM = 8;
constexpr int EPI_BUF_OFF = 132096 + 4096, EPI_BUF_BYTES = 3072;

__host__ __device__ __forceinline__ int lds_byte(int r, int c) { const int st = (r >> 4) * 2 + (c >> 5), rr = r & 15, cc = c & 31, ob = rr * 64 + cc * 2; return st * 1024 + (ob ^ (((ob >> 9) & 1) << 5)); }
__host__ __device__ __forceinline__ void stage_rc(int b, int& R, int& C) { const int st = b / 1024, sb = b % 1024, swz = sb ^ (((sb >> 9) & 1) << 5); R = (st >> 1) * 16 + swz / 64; C = (st & 1) * 32 + (swz % 64) / 2; }
__host__ __device__ __forceinline__ int perm32(int rho) { const int n = rho >> 4, i = rho & 15; return 8 * (i >> 2) + 4 * n + (i & 3); }

struct Unit { int pm, pn, e, rt; };

__device__ __forceinline__ bool tile_order(long L, int nM, int nN, int& pm, int& pn) {
    const int nwg = nM * nN; if (L >= nwg) return false;
    int wgid = (int)L; { const int q = nwg / NXCD, r = nwg % NXCD, xcd = wgid % NXCD, off = wgid / NXCD; wgid = (xcd < r ? xcd * (q + 1) : r * (q + 1) + (xcd - r) * q) + off; }
    const int nig = WGM * nN, gid = wgid / nig, fm = gid * WGM, gsz = (nM - fm) < WGM ? (nM - fm) : WGM;
    const int w = wgid % nig;
    if (gsz == WGM) { pm = fm + (w % WGM); pn = w / WGM; } else { pm = fm + (w % gsz); pn = w / gsz; }
    return true;
}

__device__ __forceinline__ unsigned cvt_pk_bf16(float lo, float hi) { unsigned r; asm volatile("v_cvt_pk_bf16_f32 %0, %1, %2" : "=v"(r) : "v"(lo), "v"(hi)); return r; }

template <class Epi, class Sched, bool GATHER, bool ALIGN_EPI, bool I8 = false>
__device__ __forceinline__ void gemm_phase(PG8_LAS unsigned char* lds, const int K, const Sched& S, const Epi& E, unsigned* dump  ) {
    const int tid = tid_opaque();
    const int wid = __builtin_amdgcn_readfirstlane(tid >> 6), lane = tid & 63, wr = wid >> 2, wc = wid & 3, fr = lane & 15, fq = lane >> 4;
    int nt = K / BK; asm volatile("" : "+s"(nt));
    unsigned voffA[2], voffB[2]; int gR[2], gC[2];
#pragma unroll
    for (int i = 0; i < 2; ++i) { int R, C; stage_rc(tid * 16 + i * 8192, R, C); const int Rb = Epi::PERM ? ((R & ~31) + perm32(R & 31)) : R;
        voffA[i] = (unsigned)(R * K + C) * 2u; voffB[i] = (unsigned)(Rb * K + C) * 2u; gR[i] = R; gC[i] = C * 2; }
    const size_t kstep = (size_t)(BK * 2);
    const size_t hstep = (size_t)HALF * K * 2;
    const unsigned ldsw = (unsigned)wid * 1024u;
    const int aoff = lds_byte(wr * 64 + fr, fq * 8), boff = lds_byte(wc * 32 + fr, fq * 8);
#define PG8_SA(b, h) (((b) * 2 + (h)) * HTB)
#define PG8_SB(b, h) ((4 + (b) * 2 + (h)) * HTB)
#define PG8_STAGE(bufoff, gbase, voff) do { _Pragma("unroll") for (int _i = 0; _i < 2; ++_i) \
        __builtin_amdgcn_global_load_lds((const unsigned*)((const char*)(gbase) + (voff)[_i]), (PG8_LAS unsigned*)(lds + (bufoff) + ldsw + _i * 8192), 16, 0, 0); } while (0)
#define PG8_STAGE_A(bufoff, kptr, h, G) do { if constexpr (GATHER) { PG8_STAGE(bufoff, kptr, (G)[h]); } else { PG8_STAGE(bufoff, (kptr) + (h) * hstep, voffA); } } while (0)
#define PG8_LDA(dst, b, h) do { _Pragma("unroll") for (int m = 0; m < 4; ++m) _Pragma("unroll") for (int k = 0; k < 2; ++k) dst[m][k] = *(const PG8_LAS bf16x8*)(lds + PG8_SA(b, h) + aoff + m * 2048 + k * 1024); } while (0)
#define PG8_LDB(dst, b, h) do { _Pragma("unroll") for (int n = 0; n < 2; ++n) _Pragma("unroll") for (int k = 0; k < 2; ++k) dst[n][k] = *(const PG8_LAS bf16x8*)(lds + PG8_SB(b, h) + boff + n * 2048 + k * 1024); } while (0)
#define PG8_MMA(ai, bj, At, Bt) do { __builtin_amdgcn_s_setprio(1); _Pragma("unroll") for (int m = 0; m < 4; ++m) _Pragma("unroll") for (int n = 0; n < 2; ++n) _Pragma("unroll") for (int k = 0; k < 2; ++k) { \
        if constexpr (I8) acc[ai][bj][m][n] = __builtin_bit_cast(f32x4, __builtin_amdgcn_mfma_i32_16x16x64_i8(__builtin_bit_cast(i32x4, Bt[n][k]), __builtin_bit_cast(i32x4, At[m][k]), __builtin_bit_cast(i32x4, acc[ai][bj][m][n]), 0, 0, 0)); \
        else acc[ai][bj][m][n] = __builtin_amdgcn_mfma_f32_16x16x32_bf16(Bt[n][k], At[m][k], acc[ai][bj][m][n], 0, 0, 0); } __builtin_amdgcn_s_setprio(0); } while (0)
#define PG8_WAIT_V(n) asm volatile("s_waitcnt vmcnt(" #n ")" ::: "memory")
#define PG8_WAIT_V8R(t) asm volatile("s_cmp_lg_u32 %0, 0\n\ts_cbranch_scc1 1f\n\ts_waitcnt vmcnt(%1)\n\ts_branch 2f\n1:\n\ts_waitcnt vmcnt(8)\n2:" :: "s"(t), "n"(8 + Epi::NSTORES) : "memory", "scc")
#define PG8_WAIT_L(n) asm volatile("s_waitcnt lgkmcnt(" #n ")" ::: "memory")
#define PG8_BAR __builtin_amdgcn_s_barrier()
#define PG8_SCHED __builtin_amdgcn_sched_barrier(0)
    Unit cur, nxt; int ui = 0;
    if (!S.next(0, cur)) return;
#if GEMM_SKEW_TICKS
    { const unsigned long long t0_ = __builtin_amdgcn_s_memrealtime(); const unsigned long long want_ = (unsigned long long)((blockIdx.x >> 3) & 7) * GEMM_SKEW_TICKS;
      while (__builtin_amdgcn_s_memrealtime() - t0_ < want_) __builtin_amdgcn_s_sleep(8); }
#endif
    f32x4 acc[2][2][4][2];
#pragma unroll
    for (int a = 0; a < 2; ++a)
#pragma unroll
        for (int b = 0; b < 2; ++b)
#pragma unroll
            for (int m = 0; m < 4; ++m)
#pragma unroll
                for (int n = 0; n < 2; ++n) acc[a][b][m][n] = (f32x4){0.f, 0.f, 0.f, 0.f};
    bf16x8 At[4][2], B0[2][2], B1[2][2];
    unsigned cG[2][2] = {{0u, 0u}, {0u, 0u}}, nG[2][2] = {{0u, 0u}, {0u, 0u}}, sG[2][2] = {{0u, 0u}, {0u, 0u}};
    if constexpr (GATHER) S.gather(cur, gR, gC, K, cG);
    if constexpr (GATHER) asm volatile("" : "+v"(cG[0][0]), "+v"(cG[0][1]), "+v"(cG[1][0]), "+v"(cG[1][1]));
    const char* cA = S.a_base(cur); const char* cB = S.b_base(cur);
    PG8_STAGE(PG8_SB(0, 0), cB, voffB); PG8_STAGE(PG8_SB(0, 1), cB + hstep, voffB); PG8_STAGE_A(PG8_SA(0, 0), cA, 0, cG); PG8_STAGE_A(PG8_SA(0, 1), cA, 1, cG);
    if (wr == 1) PG8_BAR;
    PG8_WAIT_V(2); PG8_BAR;
    PG8_STAGE(PG8_SB(1, 0), cB + kstep, voffB); PG8_STAGE_A(PG8_SA(1, 0), cA + kstep, 0, cG); PG8_STAGE(PG8_SB(1, 1), cB + hstep + kstep, voffB);
    PG8_WAIT_V(6); PG8_BAR;
    if constexpr (Epi::NSTORES > 0) {
        unsigned* dp = dump + (size_t)blockIdx.x * 512 + tid;
#pragma unroll
        for (int i = 0; i < Epi::NSTORES; ++i) asm volatile("global_store_dword %0, %1, off" :: "v"(dp), "v"(i) : "memory"); }
    for (;;) {
        const bool has_next = S.next(ui + 1, nxt);
        const char* nA = has_next ? S.a_base(nxt) : cA; const char* nB = has_next ? S.b_base(nxt) : cB;
        const PG8_LAS float* eb = (const PG8_LAS float*)(lds + EPI_BUF_OFF + (ui & 1) * EPI_BUF_BYTES);
        if constexpr (Epi::PREF) E.prefetch(cur, (PG8_LAS unsigned char*)eb, wid);
        if constexpr (GATHER) { if (has_next && wid == 3) S.stage_idx(nxt, lds + 2 * STAGE_BYTES / 2, lane); }
#pragma unroll 1
        for (int t = 0; t < nt; t += 2) {
            const bool last = (t == nt - 2);
            const char* a1 = cA + (size_t)(t + 1) * kstep;
            const char* a2 = last ? nA : cA + (size_t)(t + 2) * kstep; const char* b2 = last ? nB : cB + (size_t)(t + 2) * kstep;
            const char* a3 = a2 + kstep; const char* b3 = b2 + kstep;
            if constexpr (GATHER) {
                if (last) { if (has_next) S.gather_lds(nxt, gR, gC, K, nG, (const PG8_LAS int*)(lds + 2 * STAGE_BYTES / 2)); else { nG[0][0] = cG[0][0]; nG[0][1] = cG[0][1]; nG[1][0] = cG[1][0]; nG[1][1] = cG[1][1]; }
                    asm volatile("" : "+v"(nG[0][0]), "+v"(nG[0][1]), "+v"(nG[1][0]), "+v"(nG[1][1])); }
                sG[0][0] = last ? nG[0][0] : cG[0][0]; sG[0][1] = last ? nG[0][1] : cG[0][1]; sG[1][0] = last ? nG[1][0] : cG[1][0]; sG[1][1] = last ? nG[1][1] : cG[1][1]; }
            PG8_LDB(B0, 0, 0); PG8_LDB(B1, 0, 1); PG8_SCHED; PG8_LDA(At, 0, 0); PG8_STAGE_A(PG8_SA(1, 1), a1, 1, cG);
            PG8_WAIT_V8R(t); PG8_WAIT_L(0); PG8_BAR; PG8_MMA(0, 0, At, B0); PG8_MMA(0, 1, At, B1); PG8_BAR; PG8_SCHED;
            PG8_LDA(At, 0, 1); PG8_STAGE(PG8_SB(0, 0), b2, voffB); PG8_STAGE(PG8_SB(0, 1), b2 + hstep, voffB); PG8_STAGE_A(PG8_SA(0, 0), a2, 0, sG);
            PG8_WAIT_V8R(t); PG8_WAIT_L(0); PG8_BAR; PG8_MMA(1, 0, At, B0); PG8_MMA(1, 1, At, B1); PG8_BAR; PG8_SCHED;
            PG8_LDB(B0, 1, 0); PG8_LDB(B1, 1, 1); PG8_SCHED; PG8_LDA(At, 1, 0); PG8_STAGE_A(PG8_SA(0, 1), a2, 1, sG);
            PG8_WAIT_V(8); PG8_WAIT_L(0); PG8_BAR; PG8_MMA(0, 0, At, B0); PG8_MMA(0, 1, At, B1); PG8_BAR; PG8_SCHED;
            PG8_LDA(At, 1, 1); PG8_STAGE(PG8_SB(1, 0), b3, voffB); PG8_STAGE(PG8_SB(1, 1), b3 + hstep, voffB); PG8_STAGE_A(PG8_SA(1, 0), a3, 0, sG);
            PG8_WAIT_V(8); PG8_WAIT_L(0); PG8_BAR; PG8_MMA(1, 0, At, B0); PG8_MMA(1, 1, At, B1); PG8_BAR; PG8_SCHED;
            if constexpr (Epi::HAS_MID) { if (t == 6 || t == 14) E.mid(acc, cur, wr, wc, fr, fq, (t + 2) >> 3); }
        }
        if constexpr (ALIGN_EPI) { if (wr == 0) PG8_BAR; }
        E(acc, cur, wr, wc, fr, fq, eb);
#if defined(EPI_TWICE)
        if constexpr (Epi::TWICE) { asm volatile("" ::: "memory"); E(acc, cur, wr, wc, fr, fq, eb); }
#endif
        if constexpr (Epi::DRAIN_AFTER) __builtin_amdgcn_s_waitcnt(0x0F70);
        if (!has_next) break;
#pragma unroll
        for (int a = 0; a < 2; ++a)
#pragma unroll
            for (int b = 0; b < 2; ++b)
#pragma unroll
                for (int m = 0; m < 4; ++m)
#pragma unroll
                    for (int n = 0; n < 2; ++n) acc[a][b][m][n] = (f32x4){0.f, 0.f, 0.f, 0.f};
        cur = nxt; cA = nA; cB = nB; ++ui;
        if constexpr (GATHER) { cG[0][0] = nG[0][0]; cG[0][1] = nG[0][1]; cG[1][0] = nG[1][0]; cG[1][1] = nG[1][1]; }
        if constexpr (ALIGN_EPI) { if (wr == 1) PG8_BAR; }
    }
    PG8_WAIT_V(0);
    if constexpr (!ALIGN_EPI) { if (wr == 0) PG8_BAR; }
    PG8_BAR;
#undef PG8_SA
#undef PG8_SB
#undef PG8_STAGE
#undef PG8_STAGE_A
#undef PG8_LDA
#undef PG8_LDB
#undef PG8_MMA
#undef PG8_WAIT_V
#undef PG8_WAIT_V8R
#undef PG8_WAIT_L
#undef PG8_BAR
#undef PG8_SCHED
}

struct DenseOrder {
    const char* A; const char* Bt; int nM, nN, G, c, K;
    __device__ __forceinline__ bool next(int i, Unit& u) const { u.e = 0; u.rt = 0; return tile_order((long)i * G + c, nM, nN, u.pm, u.pn); }
    __device__ __forceinline__ const char* a_base(const Unit& u) const { return A + (size_t)u.pm * BM * K * 2; }
    __device__ __forceinline__ const char* b_base(const Unit& u) const { return Bt + (size_t)u.pn * BM * K * 2; }
};
struct PanelOrder {
    const char* A; const char* Bt; int nM, nN, G, c, v, K; bool own;
    __device__ __forceinline__ bool next(int i, Unit& u) const { u.e = 0; u.rt = 0; if (own) { u.pm = v; u.pn = i; return i < nN; } return tile_order((long)i * G + c, nM, nN, u.pm, u.pn); }
    __device__ __forceinline__ const char* a_base(const Unit& u) const { return A + (size_t)u.pm * BM * K * 2; }
    __device__ __forceinline__ const char* b_base(const Unit& u) const { return Bt + (size_t)u.pn * BM * K * 2; }
};
struct MoeOrder {
    const char* A; const char* Wt; int nN, NT, G, c, K; size_t wstride;
    const PG8_LAS int* toff; const PG8_LAS int* lcnt; const int* perm;
    __device__ __forceinline__ bool next(int i, Unit& u) const {
        if (!tile_order((long)i * G + c, NT, nN, u.pm, u.pn)) return false;
        const int j = (int)__builtin_amdgcn_mbcnt_lo(~0u, 0u);
        const int e = __builtin_popcountll(__builtin_amdgcn_ballot_w64(j >= 1 && j < NE && toff[j] <= u.pm));
        u.e = e; u.rt = u.pm - toff[e]; return true;
    }
    __device__ __forceinline__ const char* a_base(const Unit& u) const { return A; }
    __device__ __forceinline__ const char* a_dense(const Unit& u) const { return A + (size_t)u.pm * BM * K * 2; }
    __device__ __forceinline__ const char* b_base(const Unit& u) const { return Wt + (size_t)u.e * wstride + (size_t)u.pn * BM * K * 2; }
    __device__ __forceinline__ void stage_idx(const Unit& u, PG8_LAS unsigned char* dst, int lane) const {
        const unsigned off = ((unsigned)(u.e * T + u.rt * BM) + (unsigned)lane_opaque() * 4u) * 4u;
        __builtin_amdgcn_global_load_lds((const unsigned*)((const char*)perm + off), (PG8_LAS unsigned*)dst, 16, 0, 0); }
    __device__ __forceinline__ void gather_lds(const Unit& u, const int (&gR)[2], const int (&gC)[2], int K_, unsigned (&Gv)[2][2], const PG8_LAS int* idx) const {
        const int n = lcnt[u.e] - u.rt * BM;
#pragma unroll
        for (int h = 0; h < 2; ++h)
#pragma unroll
            for (int i = 0; i < 2; ++i) { const int r = h * HALF + gR[i]; const int tok = (r < n) ? (idx[r] >> 2) : 0; Gv[h][i] = (unsigned)tok * (unsigned)(K_ * 2) + (unsigned)gC[i]; }
    }
    __device__ __forceinline__ void gather(const Unit& u, const int (&gR)[2], const int (&gC)[2], int K_, unsigned (&Gv)[2][2]) const {
        const int n = lcnt[u.e] - u.rt * BM; const int* p = perm + (size_t)u.e * T + u.rt * BM;
#pragma unroll
        for (int h = 0; h < 2; ++h)
#pragma unroll
            for (int i = 0; i < 2; ++i) { const int r = h * HALF + gR[i]; const int tok = (r < n) ? (p[r] >> 2) : 0; Gv[h][i] = (unsigned)tok * (unsigned)(K_ * 2) + (unsigned)gC[i]; }
    }
};
struct MoeDenseOrder : MoeOrder {
    __device__ __forceinline__ const char* a_base(const Unit& u) const { return a_dense(u); }
};

template <bool Q8> struct EpiProjT {
    static constexpr bool PERM = true, DRAIN_AFTER = false, TWICE = (EPI_TWICE_SEL == 1), HAS_MID = false; static constexpr int NSTORES = TWICE ? 0 : 16;
    static constexpr bool PREF = Q8;
    bf16_t* O; int ldc; const float* bias; int act_from; int qscale_upto;
    unsigned char* G8;
    const float* sxr; const float* swc;
    __device__ __forceinline__ void prefetch(const Unit& u, PG8_LAS unsigned char* buf, int wid) const {
        const int colt = u.pn * BM, ln4 = lane_opaque() * 4;
        if (wid == 0) { if (colt >= act_from) __builtin_amdgcn_global_load_lds((const unsigned*)(bias + (colt - act_from) + ln4), (PG8_LAS unsigned*)buf, 16, 0, 0); }
        else if (wid == 1) __builtin_amdgcn_global_load_lds((const unsigned*)(swc + colt + ln4), (PG8_LAS unsigned*)(buf + 1024), 16, 0, 0);
        else if (wid == 2) __builtin_amdgcn_global_load_lds((const unsigned*)(sxr + u.pm * BM + ln4), (PG8_LAS unsigned*)(buf + 2048), 16, 0, 0); }
    __device__ __forceinline__ void operator()(const f32x4 (&acc)[2][2][4][2], const Unit& u, int wr, int wc, int fr, int fq, const PG8_LAS float* eb) const {
        const int row0 = u.pm * BM + wr * 64 + fr, colt = u.pn * BM, col0 = colt + wc * 32 + 8 * fq;
        const bool gate = colt >= act_from;
        float qs = 1.0f;
        if (colt < qscale_upto) { const int seg = colt / W; qs = (seg == 0 || seg == 3) ? 0.125f * 1.4426950408889634f : (seg == 6 ? 0.08838834764831845f * 1.4426950408889634f : 1.0f); }
        f32x4 bv[2][2], sw[2][2]; float rsc[2][4];
#pragma unroll
        for (int bj = 0; bj < 2; ++bj)
#pragma unroll
            for (int n = 0; n < 2; ++n) { const int cl = wc * 32 + 8 * fq + bj * HALF + 4 * n;
                if constexpr (Q8) { bv[bj][n] = gate ? *(const PG8_LAS f32x4*)(eb + cl) : (f32x4){0.f, 0.f, 0.f, 0.f}; sw[bj][n] = *(const PG8_LAS f32x4*)(eb + 256 + cl); }
                else { bv[bj][n] = gate ? *(const f32x4*)(bias + (col0 - act_from) + bj * HALF + 4 * n) : (f32x4){0.f, 0.f, 0.f, 0.f}; sw[bj][n] = (f32x4){1.f, 1.f, 1.f, 1.f}; } }
#pragma unroll
        for (int ai = 0; ai < 2; ++ai)
#pragma unroll
            for (int m = 0; m < 4; ++m) rsc[ai][m] = Q8 ? eb[512 + wr * 64 + fr + ai * HALF + m * 16] * qs : qs;
        if (gate) {
#pragma unroll
            for (int bj = 0; bj < 2; ++bj)
#pragma unroll
                for (int n = 0; n < 2; ++n) { bv[bj][n] = bv[bj][n] * -1.4426950408889634f; sw[bj][n] = sw[bj][n] * -1.4426950408889634f; } }
#pragma unroll
        for (int ai = 0; ai < 2; ++ai)
#pragma unroll
            for (int m = 0; m < 4; ++m) { bf16_t* rowp = O + (size_t)(row0 + ai * HALF + m * 16) * ldc + col0;
                const float rs = rsc[ai][m]; const f32x2 rs2 = (f32x2){rs, rs};
#pragma unroll
                for (int bj = 0; bj < 2; ++bj) {
                    f32x2 t[2][2];
#pragma unroll
                    for (int n = 0; n < 2; ++n) { const f32x4 a = acc[ai][bj][m][n];
                        if constexpr (Q8) { const i32x4 ia = __builtin_bit_cast(i32x4, a); t[n][0] = (f32x2){(float)ia[0], (float)ia[1]} * rs2; t[n][1] = (f32x2){(float)ia[2], (float)ia[3]} * rs2; }
                        else { t[n][0] = (f32x2){a[0], a[1]} * rs2; t[n][1] = (f32x2){a[2], a[3]} * rs2; } }
                    if (gate) {
                        unsigned g[2] = {0u, 0u};
#pragma unroll
                        for (int n = 0; n < 2; ++n)
#pragma unroll
                            for (int p = 0; p < 2; ++p) {
                                f32x2 e = t[n][p] * (f32x2){sw[bj][n][2 * p], sw[bj][n][2 * p + 1]} + (f32x2){bv[bj][n][2 * p], bv[bj][n][2 * p + 1]};
                                e.x = __builtin_amdgcn_exp2f(e.x); e.y = __builtin_amdgcn_exp2f(e.y);
                                e = e * (f32x2){1.0f / 255.0f, 1.0f / 255.0f} + (f32x2){1.0f / 255.0f, 1.0f / 255.0f};
                                g[n] = __builtin_amdgcn_cvt_pk_u8_f32(__builtin_rintf(__builtin_amdgcn_rcpf(e.x)), 2 * p, g[n]);
                                g[n] = __builtin_amdgcn_cvt_pk_u8_f32(__builtin_rintf(__builtin_amdgcn_rcpf(e.y)), 2 * p + 1, g[n]); }
                        *(v2u*)(G8 + (size_t)(row0 + ai * HALF + m * 16) * (3 * D) + (col0 - act_from) + bj * HALF) = (v2u){g[0], g[1]};
                        continue; }
                    u32x4 w;
                    { const f32x2 o0 = t[0][0] * (f32x2){sw[bj][0][0], sw[bj][0][1]}, o1 = t[0][1] * (f32x2){sw[bj][0][2], sw[bj][0][3]}, o2 = t[1][0] * (f32x2){sw[bj][1][0], sw[bj][1][1]}, o3 = t[1][1] * (f32x2){sw[bj][1][2], sw[bj][1][3]};
                      w.x = cvt_pk_bf16(o0.x, o0.y); w.y = cvt_pk_bf16(o1.x, o1.y); w.z = cvt_pk_bf16(o2.x, o2.y); w.w = cvt_pk_bf16(o3.x, o3.y); }
                    __builtin_nontemporal_store(w, (u32x4*)(rowp + bj * HALF)); } }
    }
};
typedef EpiProjT<false> EpiProj; typedef EpiProjT<true> EpiProjQ;
struct EpiBranch {
    static constexpr bool PERM = true, DRAIN_AFTER = false, TWICE = false, HAS_MID = true, PREF = false; static constexpr int NSTORES = 16;
    const unsigned char* G8; bf16_t* Mg;
    static __device__ __forceinline__ float ub(unsigned w, int i) { return (float)((w >> (8 * i)) & 0xffu); }
    __device__ __forceinline__ void mid(f32x4 (&acc)[2][2][4][2], const Unit& u, int wr, int wc, int fr, int fq, int seg  ) const {
        asm volatile("" : "+v"(fr), "+v"(fq));
        const int row0 = u.pm * BM + wr * 64 + fr, col0 = u.pn * BM + wc * 32 + 8 * fq;
        v2u gn[2][4][2], gd[2][4][2];
#pragma unroll
        for (int ai = 0; ai < 2; ++ai)
#pragma unroll
            for (int m = 0; m < 4; ++m) { const unsigned char* gp = G8 + (size_t)(row0 + ai * HALF + m * 16) * (3 * D) + (seg - 1) * D + col0;
#pragma unroll
                for (int bj = 0; bj < 2; ++bj) { gn[ai][m][bj] = *(const v2u*)(gp + bj * HALF); gd[ai][m][bj] = *(const v2u*)(gp + D + bj * HALF); } }
        asm volatile("" :: "v"(gn[0][0][0]), "v"(gn[0][0][1]), "v"(gn[0][1][0]), "v"(gn[0][1][1]), "v"(gn[0][2][0]), "v"(gn[0][2][1]), "v"(gn[0][3][0]), "v"(gn[0][3][1]),
                           "v"(gn[1][0][0]), "v"(gn[1][0][1]), "v"(gn[1][1][0]), "v"(gn[1][1][1]), "v"(gn[1][2][0]), "v"(gn[1][2][1]), "v"(gn[1][3][0]), "v"(gn[1][3][1]));
        asm volatile("" :: "v"(gd[0][0][0]), "v"(gd[0][0][1]), "v"(gd[0][1][0]), "v"(gd[0][1][1]), "v"(gd[0][2][0]), "v"(gd[0][2][1]), "v"(gd[0][3][0]), "v"(gd[0][3][1]),
                           "v"(gd[1][0][0]), "v"(gd[1][0][1]), "v"(gd[1][1][0]), "v"(gd[1][1][1]), "v"(gd[1][2][0]), "v"(gd[1][2][1]), "v"(gd[1][3][0]), "v"(gd[1][3][1]));
#pragma unroll
        for (int ai = 0; ai < 2; ++ai)
#pragma unroll
            for (int m = 0; m < 4; ++m)
#pragma unroll
                for (int bj = 0; bj < 2; ++bj) { const v2u n_ = gn[ai][m][bj], d_ = gd[ai][m][bj];
                    f32x4& a0 = acc[ai][bj][m][0]; f32x4& a1 = acc[ai][bj][m][1];
#pragma unroll
                    for (int j = 0; j < 4; ++j) { a0[j] *= ub(n_.x, j) * __builtin_amdgcn_rcpf(__builtin_fmaxf(ub(d_.x, j), 1.0f)); a1[j] *= ub(n_.y, j) * __builtin_amdgcn_rcpf(__builtin_fmaxf(ub(d_.y, j), 1.0f)); } }
    }
    __device__ __forceinline__ void operator()(const f32x4 (&acc)[2][2][4][2], const Unit& u, int wr, int wc, int fr, int fq, const PG8_LAS float* eb) const {
        const int row0 = u.pm * BM + wr * 64 + fr, col0 = u.pn * BM + wc * 32 + 8 * fq;
        v2u gl[2][4][2];
#pragma unroll
        for (int ai = 0; ai < 2; ++ai)
#pragma unroll
            for (int m = 0; m < 4; ++m) { const unsigned char* gp = G8 + (size_t)(row0 + ai * HALF + m * 16) * (3 * D) + 2 * D + col0;
#pragma unroll
                for (int bj = 0; bj < 2; ++bj) gl[ai][m][bj] = *(const v2u*)(gp + bj * HALF); }
        asm volatile("" :: "v"(gl[0][0][0]), "v"(gl[0][0][1]), "v"(gl[0][1][0]), "v"(gl[0][1][1]), "v"(gl[0][2][0]), "v"(gl[0][2][1]), "v"(gl[0][3][0]), "v"(gl[0][3][1]),
                           "v"(gl[1][0][0]), "v"(gl[1][0][1]), "v"(gl[1][1][0]), "v"(gl[1][1][1]), "v"(gl[1][2][0]), "v"(gl[1][2][1]), "v"(gl[1][3][0]), "v"(gl[1][3][1]));
#pragma unroll
        for (int ai = 0; ai < 2; ++ai)
#pragma unroll
            for (int m = 0; m < 4; ++m) { const size_t row = (size_t)(row0 + ai * HALF + m * 16);
                bf16_t* mp = Mg + row * D + col0;
#pragma unroll
                for (int bj = 0; bj < 2; ++bj) {
                    const v2u g = gl[ai][m][bj]; const f32x4 a0 = acc[ai][bj][m][0], a1 = acc[ai][bj][m][1];
                    float r0[4], r1[4];
#pragma unroll
                    for (int j = 0; j < 4; ++j) { r0[j] = __builtin_fmaxf(ub(g.x, j), 1.0f) * (1.0f / 255.0f) * a0[j]; r1[j] = __builtin_fmaxf(ub(g.y, j), 1.0f) * (1.0f / 255.0f) * a1[j]; }
                    u32x4 w; w.x = cvt_pk_bf16(r0[0], r0[1]); w.y = cvt_pk_bf16(r0[2], r0[3]); w.z = cvt_pk_bf16(r1[0], r1[1]); w.w = cvt_pk_bf16(r1[2], r1[3]);
                    *(u32x4*)(mp + bj * HALF) = w; } }
    }
};
struct EpiOut {
    static constexpr bool PERM = false, DRAIN_AFTER = false, TWICE = (EPI_TWICE_SEL == 4), HAS_MID = false, PREF = false; static constexpr int NSTORES = TWICE ? 0 : 32;
    const float* X; float* V1;
    __device__ __forceinline__ void operator()(const f32x4 (&acc)[2][2][4][2], const Unit& u, int wr, int wc, int fr, int fq, const PG8_LAS float* eb) const {
        const int row0 = u.pm * BM + wr * 64 + fr, col0 = u.pn * BM + wc * 32 + 4 * fq;
#pragma unroll
        for (int ai = 0; ai < 2; ++ai)
#pragma unroll
            for (int m = 0; m < 4; ++m) { const size_t off = (size_t)(row0 + ai * HALF + m * 16) * D + col0;
#pragma unroll
                for (int bj = 0; bj < 2; ++bj)
#pragma unroll
                    for (int n = 0; n < 2; ++n) { const f32x4 xv = *(const f32x4*)(X + off + bj * HALF + n * 16); *(f32x4*)(V1 + off + bj * HALF + n * 16) = xv * DN_ALPHA + acc[ai][bj][m][n]; } }
    }
};
template <bool Q8> struct EpiGateUpT {
    static constexpr bool PERM = true, DRAIN_AFTER = false, TWICE = (EPI_TWICE_SEL == 6), HAS_MID = false, PREF = Q8; static constexpr int NSTORES = TWICE ? 0 : 8;
    bf16_t* Act; const float* bgu;
    const float* sxp; const float* swr;
    __device__ __forceinline__ void prefetch(const Unit& u, PG8_LAS unsigned char* buf, int wid) const {
        const int ln = lane_opaque();
        if (wid == 0) __builtin_amdgcn_global_load_lds((const unsigned*)(bgu + (size_t)u.e * 2 * DFF + (ln >> 5) * DFF + u.pn * HALF + (ln & 31) * 4), (PG8_LAS unsigned*)buf, 16, 0, 0);
        else if (wid == 1) __builtin_amdgcn_global_load_lds((const unsigned*)(swr + (size_t)u.e * 2 * DFF + u.pn * BM + ln * 4), (PG8_LAS unsigned*)(buf + 1024), 16, 0, 0);
        else if (wid == 2) __builtin_amdgcn_global_load_lds((const unsigned*)(sxp + (size_t)u.e * T + u.rt * BM + ln * 4), (PG8_LAS unsigned*)(buf + 2048), 16, 0, 0); }
    __device__ __forceinline__ void operator()(const f32x4 (&acc)[2][2][4][2], const Unit& u, int wr, int wc, int fr, int fq, const PG8_LAS float* eb) const {
        const int row0 = u.pm * BM + wr * 64 + fr, c0 = u.pn * HALF + wc * 32 + 8 * fq;
        f32x4 bg0, bg1, bu0, bu1, sg0 = (f32x4){1.f, 1.f, 1.f, 1.f}, sg1 = sg0, su0 = sg0, su1 = sg0;
        float rsc[2][4];
        if constexpr (Q8) { const PG8_LAS float* lp = eb + wc * 32 + 8 * fq;
            bg0 = *(const PG8_LAS f32x4*)(lp); bg1 = *(const PG8_LAS f32x4*)(lp + 4); bu0 = *(const PG8_LAS f32x4*)(lp + HALF); bu1 = *(const PG8_LAS f32x4*)(lp + HALF + 4);
            sg0 = *(const PG8_LAS f32x4*)(lp + 256); sg1 = *(const PG8_LAS f32x4*)(lp + 260); su0 = *(const PG8_LAS f32x4*)(lp + 256 + HALF); su1 = *(const PG8_LAS f32x4*)(lp + 260 + HALF); }
        else { const float* bg = bgu + (size_t)u.e * 2 * DFF + c0; bg0 = *(const f32x4*)(bg); bg1 = *(const f32x4*)(bg + 4); bu0 = *(const f32x4*)(bg + DFF); bu1 = *(const f32x4*)(bg + DFF + 4); }
#pragma unroll
        for (int ai = 0; ai < 2; ++ai)
#pragma unroll
            for (int m = 0; m < 4; ++m) rsc[ai][m] = Q8 ? eb[512 + wr * 64 + fr + ai * HALF + m * 16] : 1.0f;
        const f32x4 bgv[2] = {bg0, bg1}, buv[2] = {bu0, bu1}, sgv[2] = {sg0, sg1}, suv[2] = {su0, su1};
#pragma unroll
        for (int ai = 0; ai < 2; ++ai)
#pragma unroll
            for (int m = 0; m < 4; ++m) {
                const float rs = rsc[ai][m]; const f32x2 rs2 = (f32x2){rs, rs};
                unsigned wv[4];
#pragma unroll
                for (int h = 0; h < 2; ++h) { const f32x4 ga4 = acc[ai][0][m][h], ua4 = acc[ai][1][m][h];
#pragma unroll
                    for (int p = 0; p < 2; ++p) {
                        f32x2 g, uu;
                        if constexpr (Q8) { const i32x4 gi = __builtin_bit_cast(i32x4, ga4), ui = __builtin_bit_cast(i32x4, ua4);
                            g = (f32x2){(float)gi[2 * p], (float)gi[2 * p + 1]} * rs2; uu = (f32x2){(float)ui[2 * p], (float)ui[2 * p + 1]} * rs2; }
                        else { g = (f32x2){ga4[2 * p], ga4[2 * p + 1]}; uu = (f32x2){ua4[2 * p], ua4[2 * p + 1]}; }
                        g = g * (f32x2){sgv[h][2 * p], sgv[h][2 * p + 1]} + (f32x2){bgv[h][2 * p], bgv[h][2 * p + 1]};
                        uu = uu * (f32x2){suv[h][2 * p], suv[h][2 * p + 1]} + (f32x2){buv[h][2 * p], buv[h][2 * p + 1]};
                        g.x = __builtin_fminf(g.x, 7.0f); g.y = __builtin_fminf(g.y, 7.0f);
                        uu.x = __builtin_fminf(__builtin_fmaxf(uu.x, -7.0f), 7.0f); uu.y = __builtin_fminf(__builtin_fmaxf(uu.y, -7.0f), 7.0f);
                        f32x2 e = g * (f32x2){-1.702f * 1.4426950408889634f, -1.702f * 1.4426950408889634f};
                        e.x = __builtin_amdgcn_exp2f(e.x); e.y = __builtin_amdgcn_exp2f(e.y);
                        e = e + (f32x2){1.0f, 1.0f};
                        e.x = __builtin_amdgcn_rcpf(e.x); e.y = __builtin_amdgcn_rcpf(e.y);
                        const f32x2 o = (uu + (f32x2){1.0f, 1.0f}) * (g * e);
                        wv[2 * h + p] = cvt_pk_bf16(o.x, o.y); } }
                *(u32x4*)(Act + (size_t)(row0 + ai * HALF + m * 16) * DFF + c0) = (u32x4){wv[0], wv[1], wv[2], wv[3]}; }
    }
};
typedef EpiGateUpT<false> EpiGateUp; typedef EpiGateUpT<true> EpiGateUpQ;
struct EpiDown {
    static constexpr bool PERM = true, DRAIN_AFTER = false, TWICE = (EPI_TWICE_SEL == 7), HAS_MID = false, PREF = true; static constexpr int NSTORES = TWICE ? 0 : 16;
    bf16_t* C; const float* bd;
    __device__ __forceinline__ void prefetch(const Unit& u, PG8_LAS unsigned char* buf, int wid) const {
        if (wid == 0) __builtin_amdgcn_global_load_lds((const unsigned*)(bd + (size_t)u.e * D + u.pn * BM + lane_opaque() * 4), (PG8_LAS unsigned*)buf, 16, 0, 0); }
    __device__ __forceinline__ void operator()(const f32x4 (&acc)[2][2][4][2], const Unit& u, int wr, int wc, int fr, int fq, const PG8_LAS float* eb) const {
        const int row0 = u.pm * BM + wr * 64 + fr, col0 = u.pn * BM + wc * 32 + 8 * fq;
        f32x4 bv[2][2];
#pragma unroll
        for (int bj = 0; bj < 2; ++bj)
#pragma unroll
            for (int nn = 0; nn < 2; ++nn) bv[bj][nn] = *(const PG8_LAS f32x4*)(eb + wc * 32 + 8 * fq + bj * HALF + 4 * nn);
#pragma unroll
        for (int ai = 0; ai < 2; ++ai)
#pragma unroll
            for (int m = 0; m < 4; ++m) { bf16_t* rowp = C + (size_t)(row0 + ai * HALF + m * 16) * D + col0;
#pragma unroll
                for (int bj = 0; bj < 2; ++bj) { const f32x4 v0 = acc[ai][bj][m][0] + bv[bj][0], v1 = acc[ai][bj][m][1] + bv[bj][1];
                    u32x4 w; w.x = cvt_pk_bf16(v0[0], v0[1]); w.y = cvt_pk_bf16(v0[2], v0[3]); w.z = cvt_pk_bf16(v1[0], v1[1]); w.w = cvt_pk_bf16(v1[2], v1[3]);
                    *(u32x4*)(rowp + bj * HALF) = w; } }
    }
};
}

#define XB_TMO      128
#define XB_XCNT(j)  (256  + 64 * (j))
#define XB_XSUB(j)  (1280 + 64 * (j))
#define XB_XGEN(j)  (2304 + 64 * (j))
#define XB_TOP      3328
#define XB_TOPGEN   3392
#define XCD_BAR_WORDS 3456
#define XB_SPIN_CAP (1u << 18)
__device__ __forceinline__ unsigned xb_ld(unsigned* p)              { return __hip_atomic_load(p, __ATOMIC_RELAXED, __HIP_MEMORY_SCOPE_AGENT); }
__device__ __forceinline__ unsigned xb_add(unsigned* p, unsigned v) { return __hip_atomic_fetch_add(p, v, __ATOMIC_RELAXED, __HIP_MEMORY_SCOPE_AGENT); }
__device__ __forceinline__ unsigned xb_xcc_id() { return (unsigned)__builtin_amdgcn_s_getreg((3 << 11) | 20) & 0xFu; }
#define XB_SPIN(cond, bar) do { unsigned _sp = 0; while (cond) { __builtin_amdgcn_s_sleep(1); \
    if ((++_sp & 255u) == 0u) { if (xb_ld(&(bar)[XB_TMO])) break; if (_sp > XB_SPIN_CAP) { atomicAdd(&(bar)[XB_TMO], 1u); break; } } } } while (0)
struct XcdBarrier { unsigned* bar; unsigned x; volatile LAS unsigned* st; };
__device__ __forceinline__ XcdBarrier xcd_barrier_post(unsigned* bar, volatile LAS unsigned* st) {
    XcdBarrier b; b.bar = bar; b.x = xb_xcc_id(); b.st = st;
    if (threadIdx.x == 0) (void)xb_add(&bar[XB_XCNT(b.x)], 1u);
    return b;
}
__device__ __forceinline__ void xcd_barrier_complete(unsigned* bar, unsigned x, unsigned& nloc, unsigned& nx) {
    const unsigned G = gridDim.x * gridDim.y * gridDim.z;
    unsigned sum, cnt, mine, sp = 0u;
    for (;;) {
        sum = 0u; cnt = 0u; mine = 0u;
#pragma unroll
        for (unsigned j = 0; j < 16; ++j) { const unsigned c = xb_ld(&bar[XB_XCNT(j)]); sum += c; cnt += (c > 0u) ? 1u : 0u; mine = (j == x) ? c : mine; }
        if (sum == G) break;
        __builtin_amdgcn_s_sleep(1);
        if ((++sp & 255u) == 0u) { if (xb_ld(&bar[XB_TMO])) break; if (sp > XB_SPIN_CAP) { atomicAdd(&bar[XB_TMO], 1u); break; } }
    }
    nloc = mine > 0u ? mine : 1u; nx = cnt > 0u ? cnt : 1u;
}
__device__ __forceinline__ void xcd_barrier(const XcdBarrier& b) {
    asm volatile("s_waitcnt vmcnt(0)" ::: "memory");
    __syncthreads();
    if (threadIdx.x == 0) {
        unsigned* bar = b.bar;
        __builtin_amdgcn_s_waitcnt(0);
        unsigned nloc = b.st[0], nx = b.st[1];
        if (nloc == 0u) { xcd_barrier_complete(bar, b.x, nloc, nx); b.st[0] = nloc; b.st[1] = nx; }
        const unsigned old = xb_add(&bar[XB_XSUB(b.x)], 1u);
        const unsigned gen = old / nloc;
        if (old + 1u == (gen + 1u) * nloc) {
            __builtin_amdgcn_fence(__ATOMIC_RELEASE, "agent");
            asm volatile("s_waitcnt vmcnt(0)" ::: "memory");
            const unsigned og = xb_add(&bar[XB_TOP], 1u);
            const unsigned tg = og / nx;
            if (og + 1u == (tg + 1u) * nx) xb_add(&bar[XB_TOPGEN], 1u);
            else XB_SPIN(xb_ld(&bar[XB_TOPGEN]) == tg, bar);
            __builtin_amdgcn_fence(__ATOMIC_ACQUIRE, "agent");
            xb_add(&bar[XB_XGEN(b.x)], 1u);
            asm volatile("s_waitcnt vmcnt(0)" ::: "memory");
        } else {
            XB_SPIN(xb_ld(&bar[XB_XGEN(b.x)]) == gen, bar);
            __builtin_amdgcn_fence(__ATOMIC_ACQUIRE, "agent");
            asm volatile("s_waitcnt vmcnt(0)" ::: "memory");
        }
    }
    __syncthreads();
}

template <int CTRL> __device__ __forceinline__ float dppf(float v) { return __int_as_float(__builtin_amdgcn_update_dpp(0, __float_as_int(v), CTRL, 0xf, 0xf, true)); }
__device__ __forceinline__ float wave_sum(float v) {
    v += dppf<0xB1>(v); v += dppf<0x4E>(v); v += dppf<0x141>(v); v += dppf<0x140>(v);
    { auto rr = __builtin_amdgcn_permlane16_swap(__float_as_uint(v), __float_as_uint(v), false, false); v = __uint_as_float(rr[0]) + __uint_as_float(rr[1]); }
    { auto rr = __builtin_amdgcn_permlane32_swap(__float_as_uint(v), __float_as_uint(v), false, false); v = __uint_as_float(rr[0]) + __uint_as_float(rr[1]); }
    return v;
}
__device__ __forceinline__ float wave_max(float v) {
    asm volatile("s_nop 1\n\tv_max_f32_dpp %0, %0, %0 quad_perm:[1,0,3,2] row_mask:0xf bank_mask:0xf\n\ts_nop 1\n\t"
                 "v_max_f32_dpp %0, %0, %0 quad_perm:[2,3,0,1] row_mask:0xf bank_mask:0xf\n\ts_nop 1\n\t"
                 "v_max_f32_dpp %0, %0, %0 row_half_mirror row_mask:0xf bank_mask:0xf\n\ts_nop 1\n\t"
                 "v_max_f32_dpp %0, %0, %0 row_mirror row_mask:0xf bank_mask:0xf" : "+v"(v));
    { auto rr = __builtin_amdgcn_permlane16_swap(__float_as_uint(v), __float_as_uint(v), false, false); float a = __uint_as_float(rr[0]), b = __uint_as_float(rr[1]); asm volatile("v_max_f32 %0, %1, %2" : "=v"(v) : "v"(a), "v"(b)); }
    { auto rr = __builtin_amdgcn_permlane32_swap(__float_as_uint(v), __float_as_uint(v), false, false); float a = __uint_as_float(rr[0]), b = __uint_as_float(rr[1]); asm volatile("v_max_f32 %0, %1, %2" : "=v"(v) : "v"(a), "v"(b)); }
    return v;
}
__device__ __forceinline__ unsigned q4(f32x4 x, float inv) {
    unsigned w = 0u;
    w = __builtin_amdgcn_cvt_pk_u8_f32(__builtin_rintf(__builtin_fmaf(x.x, inv, 128.0f)), 0, w); w = __builtin_amdgcn_cvt_pk_u8_f32(__builtin_rintf(__builtin_fmaf(x.y, inv, 128.0f)), 1, w);
    w = __builtin_amdgcn_cvt_pk_u8_f32(__builtin_rintf(__builtin_fmaf(x.z, inv, 128.0f)), 2, w); w = __builtin_amdgcn_cvt_pk_u8_f32(__builtin_rintf(__builtin_fmaf(x.w, inv, 128.0f)), 3, w);
    return w ^ 0x80808080u;
}
__device__ __forceinline__ void quant_row(const f32x4 (&v)[4], signed char* qrow, float* sc, int lane) {
    float am = 0.f;
#pragma unroll
    for (int j = 0; j < 4; ++j) am = __builtin_fmaxf(am, __builtin_fmaxf(__builtin_fmaxf(__builtin_fabsf(v[j].x), __builtin_fabsf(v[j].y)), __builtin_fmaxf(__builtin_fabsf(v[j].z), __builtin_fabsf(v[j].w))));
    am = wave_max(am);
    const float inv = am > 0.f ? 127.0f / am : 0.f;
    GAS unsigned* o = (GAS unsigned*)qrow + lane;
#pragma unroll
    for (int j = 0; j < 4; ++j) o[64 * j] = q4(v[j], inv);
    if (lane == 0) *sc = am * (1.0f / 127.0f);
}
constexpr int WT_STRIDE = D + 4;

struct Args { const float* in[20]; float* out; unsigned char* ws; int ph_lo, ph_hi; };
typedef const __attribute__((address_space(4))) Args* KArgs;

__device__ __forceinline__ KArgs ka_opaque() { unsigned long long p = (unsigned long long)__builtin_amdgcn_kernarg_segment_ptr(); asm volatile("" : "+s"(p)); return (KArgs)p; }


__device__ __forceinline__ void p0_transpose_item(const float* Wsrc, int K, int N, bf16* WT, int drow0, int k0, int n0, int dpitch, int dcol0, LAS float* scr, int lane) {
#pragma unroll 8
    for (int i = 0; i < 32; ++i) { const int kk = 2 * i + (lane >> 5); scr[kk * 33 + (lane & 31)] = Wsrc[(size_t)(k0 + kk) * N + n0 + (lane & 31)]; }
    LDS_WAIT(); asm volatile("" ::: "memory");
    const int c = lane & 7;
#pragma unroll
    for (int j = 0; j < 4; ++j) { const int n = (lane >> 3) + 8 * j; const LAS float* s = scr + (8 * c) * 33 + n;
        v4u o; o.x = pk2(s[0 * 33], s[1 * 33]); o.y = pk2(s[2 * 33], s[3 * 33]); o.z = pk2(s[4 * 33], s[5 * 33]); o.w = pk2(s[6 * 33], s[7 * 33]);
        *(GAS v4u*)(WT + (size_t)(drow0 + n) * dpitch + dcol0 + k0 + 8 * c) = o; }
    LDS_WAIT(); asm volatile("" ::: "memory");
}
__device__ __forceinline__ void p0_quant_strip_wg(const float* Wsrc, int N, signed char* WQ, float* SC, int drow0, int n0, LAS float* scr  , LAS float* pmax  , int wave, int lane) {
    constexpr int K = 1024;
    LAS float* mine = scr + wave * 128 * 32;
    float am = 0.f;
#pragma unroll 8
    for (int i = 0; i < 64; ++i) { const int kk = 2 * i + (lane >> 5); const float x = Wsrc[(size_t)(128 * wave + kk) * N + n0 + (lane & 31)];
        am = __builtin_fmaxf(am, __builtin_fabsf(x)); mine[kk * 32 + ((lane & 31) ^ (kk & 31))] = x; }
    am = __builtin_fmaxf(am, __shfl_xor(am, 32));
    if (lane < 32) pmax[wave * 32 + lane] = am;
    __syncthreads();
    float cm = 0.f;
#pragma unroll
    for (int w = 0; w < 8; ++w) cm = __builtin_fmaxf(cm, pmax[w * 32 + (lane & 31)]);
    const float inv = cm > 0.f ? 127.0f / cm : 0.f;
    if (wave == 0 && lane < 32) SC[drow0 + lane] = cm * (1.0f / 127.0f);
    const int c = lane & 3;
#pragma unroll
    for (int kb = 0; kb < 2; ++kb)
#pragma unroll
        for (int j = 0; j < 2; ++j) { const int n = (lane >> 2) + 16 * j; const float invn = __shfl(inv, n);
            float x[16];
#pragma unroll
            for (int t = 0; t < 16; ++t) { const int kk = 64 * kb + 16 * c + t; x[t] = mine[kk * 32 + (n ^ (kk & 31))]; }
            v4u o; o.x = q4((f32x4){x[0], x[1], x[2], x[3]}, invn); o.y = q4((f32x4){x[4], x[5], x[6], x[7]}, invn); o.z = q4((f32x4){x[8], x[9], x[10], x[11]}, invn); o.w = q4((f32x4){x[12], x[13], x[14], x[15]}, invn);
            *(GAS v4u*)(WQ + (size_t)(drow0 + n) * K + 128 * wave + 64 * kb + 16 * c) = o; }
    __syncthreads();
}
__device__ __forceinline__ bool p0_matrix(int& r, const float* src, int K, int N, bf16* dst, bool gu_rows, LAS float* scr, int lane, int dpitch = 0, int dcol0 = 0) {
    const int nblk = N / 32, items = (K / 64) * nblk;
    if (r >= items) { r -= items; return false; }
    const int kb = r / nblk, nb = r % nblk, n0 = 32 * nb;
    int drow0 = n0;
    if (gu_rows) { const int cc = (n0 >= DFF) ? n0 - DFF : n0; drow0 = (cc >> 7) * 256 + (n0 >= DFF ? 128 : 0) + (cc & 127); }
    p0_transpose_item(src, K, N, dst, drow0, 64 * kb, n0, dpitch ? dpitch : K, dcol0, scr, lane);
    return true;
}
__device__ __forceinline__ void row_to_bf16(const float* xrow, bf16* orow, int lane) {
    const GAS f32x4* xr = (const GAS f32x4*)xrow + lane; GAS unsigned long long* o8 = (GAS unsigned long long*)orow + lane;
    f32x4 v[4];
#pragma unroll
    for (int j = 0; j < 4; ++j) v[j] = xr[64 * j];
    asm volatile("" :: "v"(v[0]), "v"(v[1]), "v"(v[2]), "v"(v[3]));
#pragma unroll
    for (int j = 0; j < 4; ++j) o8[64 * j] = (unsigned long long)pk2(v[j].x, v[j].y) | ((unsigned long long)pk2(v[j].z, v[j].w) << 32);
}

__device__ __forceinline__ int t5_bucket(int rel) {
    const int n = rel < 0 ? -rel : rel;
    int b;
    if (n < 8) b = n; else b = 8 + (n >= 12) + (n >= 16) + (n >= 23) + (n >= 32) + (n >= 46) + (n >= 64) + (n >= 91);
    return (rel > 0 ? 16 : 0) + b;
}
namespace att {
typedef float f32x16 __attribute__((ext_vector_type(16)));
typedef short s16x4 __attribute__((ext_vector_type(4)));
typedef short v4i16_t __attribute__((ext_vector_type(4)));
typedef __bf16 bf16x2_t __attribute__((ext_vector_type(2)));
constexpr float LOG2E = 1.4426950408889634f;
constexpr int YP = 3 * W;
constexpr int SLOT = 16384, LDS_K = 0, LDS_V = 2 * SLOT, LDS_STG = 4 * SLOT, STG_W = 8192;
constexpr int LW_MSTG = 3072;
constexpr int LW_WSF = 320, LW_FLAG = 832, LW_TAB = 896;
__device__ __forceinline__ int crow(int r, int hi) { return (r & 3) + 8 * (r >> 2) + 4 * hi; }
__device__ __forceinline__ void glds16(const void* gsrc, unsigned lds_dst) { unsigned keep;
    asm volatile("s_mov_b32 %0, m0\n\ts_mov_b32 m0, %2\n\ts_nop 0\n\tglobal_load_lds_dwordx4 %1, off\n\ts_mov_b32 m0, %0" : "=&s"(keep) : "v"(gsrc), "s"(lds_dst) : "memory"); }
__device__ __forceinline__ unsigned cvtpk(float lo, float hi) { f32x2 v = {lo, hi}; bf16x2_t b = __builtin_convertvector(v, bf16x2_t); return __builtin_bit_cast(unsigned, b); }
template <int N> __device__ __forceinline__ void wait_bar() {
    if constexpr (N == 0) asm volatile("s_waitcnt vmcnt(0) lgkmcnt(0)\n\ts_barrier" ::: "memory");
    else if constexpr (N == 2) asm volatile("s_waitcnt vmcnt(2) lgkmcnt(0)\n\ts_barrier" ::: "memory");
    else if constexpr (N == 3) asm volatile("s_waitcnt vmcnt(3) lgkmcnt(0)\n\ts_barrier" ::: "memory");
    else asm volatile("s_waitcnt vmcnt(4) lgkmcnt(0)\n\ts_barrier" ::: "memory");
}
__device__ __forceinline__ void lds_bar() { asm volatile("s_waitcnt lgkmcnt(0)\n\ts_barrier" ::: "memory"); }
typedef LAS const char* lptr;
template <int ND0, int BT = 4> __device__ __forceinline__ void qkt(f32x16& p0, f32x16& p1, lptr kslot, const bf16x8* qr, int r32, int hi) {
    lptr kb = kslot + hi * 1024 + r32 * 16;
    p0 = (f32x16){}; p1 = (f32x16){};
    bf16x8 b0[BT], b1[BT];
#pragma unroll
    for (int g = 0; g < ND0 / BT; ++g) {
#pragma unroll
        for (int d = 0; d < BT; ++d) { b0[d] = *(const LAS bf16x8*)(kb + (BT * g + d) * 2048); b1[d] = *(const LAS bf16x8*)(kb + (BT * g + d) * 2048 + 512); }
        __builtin_amdgcn_sched_barrier(0);
#pragma unroll
        for (int d = 0; d < BT; ++d) { p0 = __builtin_amdgcn_mfma_f32_32x32x16_bf16(b0[d], qr[BT * g + d], p0, 0, 0, 0); p1 = __builtin_amdgcn_mfma_f32_32x32x16_bf16(b1[d], qr[BT * g + d], p1, 0, 0, 0); }
        __builtin_amdgcn_sched_barrier(0);
    }
}
__device__ __forceinline__ s16x4 vtr(lptr p) { return __builtin_bit_cast(s16x4, __builtin_amdgcn_ds_read_tr16_b64_v4i16((LAS v4i16_t*)p)); }
template <int NDB> __device__ __forceinline__ void pv(f32x16* o, lptr vb, v4u pw0, v4u pw1, v4u pw2, v4u pw3) {
    s16x4 lo[2][4], hh[2][4];
#pragma unroll
    for (int ks = 0; ks < 4; ++ks) { lo[0][ks] = vtr(vb + ks * 1024); hh[0][ks] = vtr(vb + ks * 1024 + 512); }
#pragma unroll
    for (int db = 0; db < NDB; ++db) {
        if (db + 1 < NDB) {
#pragma unroll
            for (int ks = 0; ks < 4; ++ks) { lo[(db + 1) & 1][ks] = vtr(vb + (db + 1) * 4096 + ks * 1024); hh[(db + 1) & 1][ks] = vtr(vb + (db + 1) * 4096 + ks * 1024 + 512); }
        }
        __builtin_amdgcn_sched_barrier(0);
#pragma unroll
        for (int ks = 0; ks < 4; ++ks) {
            const s16x4 l_ = lo[db & 1][ks], h_ = hh[db & 1][ks];
            const bf16x8 vf = (bf16x8){l_[0], l_[1], l_[2], l_[3], h_[0], h_[1], h_[2], h_[3]};
            const v4u pw = ks == 0 ? pw0 : ks == 1 ? pw1 : ks == 2 ? pw2 : pw3;
            o[db] = __builtin_amdgcn_mfma_f32_32x32x16_bf16(__builtin_bit_cast(bf16x8, pw), vf, o[db], 0, 0, 0); }
        __builtin_amdgcn_sched_barrier(0);
    }
}
__device__ __forceinline__ void pack_p(const f32x16& p0, const f32x16& p1, v4u& pw0, v4u& pw1, v4u& pw2, v4u& pw3) {
    pw0 = (v4u){cvtpk(p0[0], p0[1]), cvtpk(p0[2], p0[3]), cvtpk(p0[4], p0[5]), cvtpk(p0[6], p0[7])};
    pw1 = (v4u){cvtpk(p0[8], p0[9]), cvtpk(p0[10], p0[11]), cvtpk(p0[12], p0[13]), cvtpk(p0[14], p0[15])};
    pw2 = (v4u){cvtpk(p1[0], p1[1]), cvtpk(p1[2], p1[3]), cvtpk(p1[4], p1[5]), cvtpk(p1[6], p1[7])};
    pw3 = (v4u){cvtpk(p1[8], p1[9]), cvtpk(p1[10], p1[11]), cvtpk(p1[12], p1[13]), cvtpk(p1[14], p1[15])};
}
__device__ __forceinline__ float half_swap(float x, int hi) {
    auto rr = __builtin_amdgcn_permlane32_swap(__float_as_uint(x), __float_as_uint(x), false, false);
    return __uint_as_float(hi ? rr[0] : rr[1]);
}
__device__ __forceinline__ float rowmax32(const f32x16& p0, const f32x16& p1, int hi) {
    float a = __builtin_fmaxf(p0[0], p1[0]);
#pragma unroll
    for (int r = 1; r < 16; ++r) a = __builtin_fmaxf(a, __builtin_fmaxf(p0[r], p1[r]));
    return __builtin_fmaxf(a, half_swap(a, hi));
}
template <int NKC  , int NVP  >
__device__ __forceinline__ void dma_tile(const bf16* Kt, const bf16* Vt, int pitch, unsigned kdst, unsigned vdst, int wid, int lane) {
#pragma unroll
    for (int i = 0; i < NKC; ++i) { const int c = wid + 8 * i; glds16(Kt + (size_t)lane * pitch + c * 8, (unsigned)__builtin_amdgcn_readfirstlane(kdst + c * 1024)); }
#pragma unroll
    for (int i = 0; i < NVP; ++i) { const int pc = wid + 8 * i, dh = pc >> 2, rg = pc & 3;
        glds16(Vt + (size_t)(16 * rg + (lane >> 2)) * pitch + dh * 32 + (lane & 3) * 8, (unsigned)__builtin_amdgcn_readfirstlane(vdst + pc * 1024)); }
}
template <int NDB> __device__ __forceinline__ void store_o(const f32x16* o, const float* rsc  , LAS unsigned char* stg, bf16* Yw  , int lane, int r32, int hi) {
    LAS bf16* st = (LAS bf16*)stg;
#pragma unroll
    for (int r = 0; r < 16; ++r) { const int orow = crow(r, hi);
#pragma unroll
        for (int db = 0; db < NDB; ++db) st[orow * (NDB * 32) + db * 32 + r32] = (bf16)f2bf(o[db][r] * rsc[r]); }
    LDS_WAIT();
    constexpr int CPR = NDB * 4;
#pragma unroll
    for (int i = 0; i < (32 * CPR) / 64; ++i) { const int idx = i * 64 + lane, row = idx / CPR, ch = idx % CPR;
        const v4u v = *(const LAS v4u*)(stg + row * (NDB * 64) + ch * 16); *(v4u*)(Yw + (size_t)row * YP + ch * 8) = v; }
    LDS_WAIT();
}

template <int NKC> __device__ __forceinline__ void dma_k(const bf16* Kt, int pitch, unsigned kdst, int wid, int lane) {
#pragma unroll
    for (int i = 0; i < NKC; ++i) { const int c = wid + 8 * i; glds16(Kt + (size_t)lane * pitch + c * 8, (unsigned)__builtin_amdgcn_readfirstlane(kdst + c * 1024)); }
}
template <int NVP> __device__ __forceinline__ void dma_v(const bf16* Vt, int pitch, unsigned vdst, int wid, int lane) {
#pragma unroll
    for (int i = 0; i < NVP; ++i) { const int pc = wid + 8 * i, dh = pc >> 2, rg = pc & 3;
        glds16(Vt + (size_t)(16 * rg + (lane >> 2)) * pitch + dh * 32 + (lane & 3) * 8, (unsigned)__builtin_amdgcn_readfirstlane(vdst + pc * 1024)); }
}
template <int NDB> __device__ __forceinline__ void store_rows(const f32x16* o, const float* rsc, LAS unsigned char* stg, bf16* Yw, int lane, int r32, int hi) {
    constexpr int RPP = 2048 / (NDB * 64), RH = RPP / 2, NP = 32 / RPP, CPR = NDB * 4, NIT = RPP * CPR / 64;
    LAS bf16* st = (LAS bf16*)stg;
#pragma unroll
    for (int g = 0; g < NP; ++g) {
#pragma unroll
        for (int rp = 0; rp < RH; ++rp)
#pragma unroll
            for (int db = 0; db < NDB; ++db) st[crow(rp, hi) * (NDB * 32) + db * 32 + r32] = (bf16)f2bf(o[db][g * RH + rp] * rsc[g * RH + rp]);
        LDS_WAIT();
#pragma unroll
        for (int i = 0; i < NIT; ++i) { const int idx = i * 64 + lane, row = idx / CPR, ch = idx % CPR;
            const v4u v = *(const LAS v4u*)(stg + row * (NDB * 64) + ch * 16); *(v4u*)(Yw + (size_t)(g * RPP + row) * YP + ch * 8) = v; }
        LDS_WAIT();
    }
}
__device__ __forceinline__ float mul1(float a, float b) { float r; asm("v_mul_f32 %0, %1, %2" : "=v"(r) : "v"(a), "v"(b)); return r; }
__device__ __forceinline__ void sb_tile(f32x16* o, float& R, lptr kslot, lptr vbt, const bf16x8* qr, int delta  , int r32, int hi) {
    f32x16 p0, p1;
    qkt<4>(p0, p1, kslot, qr, r32, hi);
    if (delta < 64 + 31) {
#pragma unroll
        for (int r = 0; r < 16; ++r) { const int kv = crow(r, hi) - r32; if (!(kv < delta)) p0[r] = -INFINITY; if (!(kv + 32 < delta)) p1[r] = -INFINITY; }
    }
#pragma unroll
    for (int r = 0; r < 16; ++r) { p0[r] = __builtin_amdgcn_rcpf(1.0f + __builtin_amdgcn_exp2f(p0[r])); p1[r] = __builtin_amdgcn_rcpf(1.0f + __builtin_amdgcn_exp2f(p1[r])); }
    float To[8], Tp[8], F[8];
#pragma unroll
    for (int g = 0; g < 4; ++g) { To[g] = mul1(mul1(p0[4 * g + 3], p0[4 * g + 2]), mul1(p0[4 * g + 1], p0[4 * g])); To[4 + g] = mul1(mul1(p1[4 * g + 3], p1[4 * g + 2]), mul1(p1[4 * g + 1], p1[4 * g])); }
#pragma unroll
    for (int g = 0; g < 8; ++g) Tp[g] = half_swap(To[g], hi);
    F[7] = 1.0f;
#pragma unroll
    for (int g = 6; g >= 0; --g) F[g] = mul1(F[g + 1], mul1(To[g + 1], Tp[g + 1]));
    const float total = mul1(F[0], mul1(To[0], Tp[0]));
#pragma unroll
    for (int g = 0; g < 8; ++g) { const float E = mul1(mul1(R, F[g]), (hi == 0 ? Tp[g] : 1.0f));
        f32x16& pp = (g < 4) ? p0 : p1; const int q = 4 * (g & 3);
        f32x4 x;
        x[3] = E; x[2] = mul1(E, pp[q + 3]); x[1] = mul1(x[2], pp[q + 2]); x[0] = mul1(x[1], pp[q + 1]);
        const f32x2 w01 = ((f32x2){1.0f, 1.0f} - (f32x2){pp[q], pp[q + 1]}) * (f32x2){x[0], x[1]}, w23 = ((f32x2){1.0f, 1.0f} - (f32x2){pp[q + 2], pp[q + 3]}) * (f32x2){x[2], x[3]};
        pp[q] = w01.x; pp[q + 1] = w01.y; pp[q + 2] = w23.x; pp[q + 3] = w23.y; }
    R *= total;
    v4u pw0, pw1, pw2, pw3; pack_p(p0, p1, pw0, pw1, pw2, pw3);
    pv<2>(o, vbt, pw0, pw1, pw2, pw3);
}
__device__ __forceinline__ void sb_unit(LAS unsigned char* lds, volatile LAS unsigned* LWv, const bf16* proj, bf16* ysb, int b, int h, int qt, int, int) {
    const int tid_ = tid_opaque(), lane = tid_ & 63, wid = __builtin_amdgcn_readfirstlane(tid_ >> 6);
    const int r32 = lane & 31, hi = lane >> 5, q0 = qt * 256, qw0 = q0 + 32 * wid;
    const size_t rowb = (size_t)b * SEQ;
    const bf16* Qw = proj + (rowb + qw0) * PP + h * 64; const bf16* Kh = proj + rowb * PP + W + h * 64; const bf16* Vh = proj + rowb * PP + 2 * W + h * 64;
    const unsigned lds0 = (unsigned)(uintptr_t)lds;
    constexpr int WK = 0, WV = 4 * SLOT, TB = 8192;
    const int jhi = q0 / 64 + 3, jlo = jhi >= 7 ? jhi - 7 : 0;
#pragma unroll 1
    for (int j = jhi; j >= jlo; --j) dma_tile<1, 1>(Kh + (size_t)j * 64 * PP, Vh + (size_t)j * 64 * PP, PP, lds0 + WK + (jhi - j) * TB, lds0 + WV + (jhi - j) * TB, wid, lane);
    bf16x8 qr[4];
#pragma unroll
    for (int d0 = 0; d0 < 4; ++d0) qr[d0] = *(const bf16x8*)(Qw + (size_t)r32 * PP + d0 * 16 + hi * 8);
    asm volatile("" : "+v"(qr[0]), "+v"(qr[1]), "+v"(qr[2]), "+v"(qr[3]));
    f32x16 o[2]; o[0] = (f32x16){}; o[1] = (f32x16){};
    float R = 1.0f;
    const float RTH = 7.5231638e-37f;
    bool done = false;
    lptr vb = (lptr)lds + WV + ((lane >> 4) & 1) * 32 + (lane & 3) * 8 + (4 * hi + ((lane & 15) >> 2)) * 64;
    wait_bar<0>();
#pragma unroll 1
    for (int j = jhi; j >= jlo; --j) {
        const int delta = qw0 - 64 * j;
        if (delta <= -31) continue;
        sb_tile(o, R, (lptr)lds + WK + (jhi - j) * TB, vb + (jhi - j) * TB, qr, delta, r32, hi);
        done = __all(R < RTH);
        if (done) break;
    }
    if (lane == 0) LWv[LW_FLAG + wid] = (!done && jlo > 0) ? 1u : 0u;
    lds_bar();
    unsigned more = 0u;
#pragma unroll
    for (int w = 0; w < 8; ++w) more |= LWv[LW_FLAG + w];
    if (more) {
        lds_bar();
        dma_tile<1, 1>(Kh + (size_t)(jlo - 1) * 64 * PP, Vh + (size_t)(jlo - 1) * 64 * PP, PP, lds0 + WK, lds0 + WV, wid, lane);
        int slot = 0;
#pragma unroll 1
        for (int j = jlo - 1; j >= 0; --j) {
            if (j > 0) { dma_tile<1, 1>(Kh + (size_t)(j - 1) * 64 * PP, Vh + (size_t)(j - 1) * 64 * PP, PP, lds0 + WK + (slot ^ 1) * TB, lds0 + WV + (slot ^ 1) * TB, wid, lane); wait_bar<2>(); }
            else wait_bar<0>();
            if (!done) { sb_tile(o, R, (lptr)lds + WK + slot * TB, vb + slot * TB, qr, qw0 - 64 * j, r32, hi); done = __all(R < RTH); }
            if (lane == 0) LWv[LW_FLAG + wid] = (done || j == 0) ? 1u : 0u;
            lds_bar();
            unsigned alld = 1u;
#pragma unroll
            for (int w = 0; w < 8; ++w) alld &= LWv[LW_FLAG + w];
            slot ^= 1;
            if (alld) break;
        }
        wait_bar<0>();
    }
    float ones[16];
#pragma unroll
    for (int r = 0; r < 16; ++r) ones[r] = 1.0f;
    store_rows<2>(o, ones, (LAS unsigned char*)(LWv + LW_MSTG) + wid * 2048, ysb + (rowb + qw0) * YP + h * 64, lane, r32, hi);
    lds_bar();
}

template <int NDB> __device__ __forceinline__ void softmax_tile(f32x16& p0, f32x16& p1, f32x16* o, float& m, float& l, float cb, const LAS float* tabp, volatile LAS float* wsf, int r32, int hi) {
    if (tabp) {
#pragma unroll
        for (int r = 0; r < 16; ++r) { p0[r] += tabp[crow(r, 0)] - cb; p1[r] += tabp[32 + crow(r, 0)] - cb; }
    }
    float a = __builtin_fmaxf(__builtin_fmaxf(p0[0], p0[1]), p1[0]), b = __builtin_fmaxf(__builtin_fmaxf(p0[2], p0[3]), p1[1]); a = __builtin_fmaxf(__builtin_fmaxf(a, p1[2]), p1[3]);
#pragma unroll
    for (int r = 4; r < 16; r += 4) { a = __builtin_fmaxf(__builtin_fmaxf(a, p0[r]), p0[r + 1]); b = __builtin_fmaxf(__builtin_fmaxf(b, p0[r + 2]), p0[r + 3]); a = __builtin_fmaxf(__builtin_fmaxf(a, p1[r]), p1[r + 1]); b = __builtin_fmaxf(__builtin_fmaxf(b, p1[r + 2]), p1[r + 3]); }
    float rm = __builtin_fmaxf(a, b); rm = __builtin_fmaxf(rm, half_swap(rm, hi));
    if (__any(rm > m + 8.0f)) {
        const float mn = __builtin_fmaxf(m, rm), f = __builtin_amdgcn_exp2f(m - mn);
        l *= f; m = mn;
        if (hi == 0) wsf[r32] = f;
        LDS_WAIT();
#pragma unroll
        for (int r = 0; r < 16; ++r) { const float fr_ = wsf[crow(r, hi)];
#pragma unroll
            for (int db = 0; db < NDB; ++db) o[db][r] *= fr_; }
        LDS_WAIT();
    }
    float s = 0.f;
#pragma unroll
    for (int r = 0; r < 16; ++r) { p0[r] = __builtin_amdgcn_exp2f(p0[r] - m); p1[r] = __builtin_amdgcn_exp2f(p1[r] - m); s += p0[r] + p1[r]; }
    l += s;
}
__device__ __forceinline__ void row_inv_l(float l, float* rli, volatile LAS float* wsf, int r32, int hi) {
    l += half_swap(l, hi);
    if (hi == 0) wsf[r32] = l;
    LDS_WAIT();
#pragma unroll
    for (int r = 0; r < 16; ++r) rli[r] = __builtin_amdgcn_rcpf(wsf[crow(r, hi)]);
    LDS_WAIT();
}

__device__ __forceinline__ bool sm_decide(f32x16& p0, f32x16& p1, float& m, float& f, float cb, const LAS float* tabp, int hi) {
    if (tabp) {
#pragma unroll
        for (int r = 0; r < 16; ++r) { p0[r] += tabp[crow(r, 0)] - cb; p1[r] += tabp[32 + crow(r, 0)] - cb; }
    }
    float a = __builtin_fmaxf(__builtin_fmaxf(p0[0], p0[1]), p1[0]), b = __builtin_fmaxf(__builtin_fmaxf(p0[2], p0[3]), p1[1]); a = __builtin_fmaxf(__builtin_fmaxf(a, p1[2]), p1[3]);
#pragma unroll
    for (int r = 4; r < 16; r += 4) { a = __builtin_fmaxf(__builtin_fmaxf(a, p0[r]), p0[r + 1]); b = __builtin_fmaxf(__builtin_fmaxf(b, p0[r + 2]), p0[r + 3]); a = __builtin_fmaxf(__builtin_fmaxf(a, p1[r]), p1[r + 1]); b = __builtin_fmaxf(__builtin_fmaxf(b, p1[r + 2]), p1[r + 3]); }
    float rm = __builtin_fmaxf(a, b); rm = __builtin_fmaxf(rm, half_swap(rm, hi));
    f = 1.0f;
    if (__any(rm > m + 8.0f)) { const float mn = __builtin_fmaxf(m, rm); f = __builtin_amdgcn_exp2f(m - mn); m = mn; return true; }
    return false;
}
__device__ __forceinline__ void pv_exp(f32x16* o, lptr vbp, v4u pw0, v4u pw1, v4u pw2, v4u pw3, f32x16& p0, f32x16& p1, float m) {
    asm volatile("" : "+v"(p0), "+v"(p1));
    s16x4 lo[3], hh[3];
#pragma unroll
    for (int g = 0; g < 2; ++g) { lo[g] = vtr(vbp + (g >> 2) * 4096 + (g & 3) * 1024); hh[g] = vtr(vbp + (g >> 2) * 4096 + (g & 3) * 1024 + 512); }
    __builtin_amdgcn_sched_barrier(0);
#pragma unroll
    for (int g = 0; g < 16; ++g) {
        const int db = g >> 2, ks = g & 3;
        if (g + 2 < 16) { const int gn = g + 2; lo[gn % 3] = vtr(vbp + (gn >> 2) * 4096 + (gn & 3) * 1024); hh[gn % 3] = vtr(vbp + (gn >> 2) * 4096 + (gn & 3) * 1024 + 512); }
        const s16x4 l_ = lo[g % 3], h_ = hh[g % 3];
        const bf16x8 vf = (bf16x8){l_[0], l_[1], l_[2], l_[3], h_[0], h_[1], h_[2], h_[3]};
        const v4u pw = ks == 0 ? pw0 : ks == 1 ? pw1 : ks == 2 ? pw2 : pw3;
        o[db] = __builtin_amdgcn_mfma_f32_32x32x16_bf16(__builtin_bit_cast(bf16x8, pw), vf, o[db], 0, 0, 0);
        if (g < 8) { float e0_ = __builtin_amdgcn_exp2f(p0[2 * g] - m), e1_ = __builtin_amdgcn_exp2f(p0[2 * g + 1] - m); asm volatile("" : "+v"(e0_), "+v"(e1_)); p0[2 * g] = e0_; p0[2 * g + 1] = e1_; }
        else { float e0_ = __builtin_amdgcn_exp2f(p1[2 * g - 16] - m), e1_ = __builtin_amdgcn_exp2f(p1[2 * g - 15] - m); asm volatile("" : "+v"(e0_), "+v"(e1_)); p1[2 * g - 16] = e0_; p1[2 * g - 15] = e1_; }
        __builtin_amdgcn_sched_barrier(0);
    }
}

__device__ __forceinline__ void df_unit(LAS unsigned char* lds, volatile LAS unsigned* LWv, const bf16* proj, bf16* ydf, const float* subg, float lam, float outscale, int b, int H, int qt, int, int) {
    const int tid_ = tid_opaque(), lane = tid_ & 63, wid = __builtin_amdgcn_readfirstlane(tid_ >> 6);
    const int r32 = lane & 31, hi = lane >> 5, q0 = qt * 256, qw0 = q0 + 32 * wid;
    const size_t rowb = (size_t)b * SEQ;
    const bf16* Vh = proj + rowb * PP + 5 * W + H * 128;
    const unsigned lds0 = (unsigned)(uintptr_t)lds;
    volatile LAS float* wsf = (volatile LAS float*)(LWv + LW_WSF + wid * 64);
    LAS unsigned char* stg = lds + LDS_STG + wid * STG_W;
    constexpr int DK = 0, DV = SLOT, KSL = 8192;
    lptr vb = (lptr)lds + DV + ((lane >> 4) & 1) * 32 + (lane & 3) * 8 + (4 * hi + ((lane & 15) >> 2)) * 64;
    const int jmax = q0 / 64 + 3, jw = qw0 / 64;
    f32x16 o[4];
#pragma unroll 1
    for (int mp = 0; mp < 2; ++mp) {
        const int h2 = 2 * H + mp;
        const bf16* Qw = proj + (rowb + qw0) * PP + 3 * W + h2 * 64; const bf16* Kh = proj + rowb * PP + 4 * W + h2 * 64;
        const LAS float* tab = (const LAS float*)(LWv + LW_TAB) + h2 * 256;
        const float cfar = tab[0];
        bf16x8 qr[4];
#pragma unroll
        for (int d0 = 0; d0 < 4; ++d0) qr[d0] = *(const bf16x8*)(Qw + (size_t)r32 * PP + d0 * 16 + hi * 8);
#pragma unroll
        for (int db = 0; db < 4; ++db) o[db] = (f32x16){};
        float m = -INFINITY, l = 0.f;
        v4u pw0 = (v4u){0u, 0u, 0u, 0u}, pw1 = pw0, pw2 = pw0, pw3 = pw0; bool have = false;
        dma_k<1>(Kh, PP, lds0 + DK, wid, lane); dma_v<2>(Vh, PP, lds0 + DV, wid, lane);
        asm volatile("" : "+v"(qr[0]), "+v"(qr[1]), "+v"(qr[2]), "+v"(qr[3]));
        int vs = 0, vprev = 0;
#pragma unroll 1
        for (int j = 0; j <= jmax + 1; ++j) {
            wait_bar<0>();
            const int vnext = (vs == 2) ? 0 : vs + 1;
            if (j < jmax) { dma_k<1>(Kh + (size_t)(j + 1) * 64 * PP, PP, lds0 + DK + ((j + 1) & 1) * KSL, wid, lane); dma_v<2>(Vh + (size_t)(j + 1) * 64 * PP, PP, lds0 + DV + vnext * SLOT, wid, lane); }
            if (j <= jw) {
                f32x16 p0, p1;
                qkt<4, 4>(p0, p1, (lptr)lds + DK + (j & 1) * KSL, qr, r32, hi);
                const int relmax = 64 * j + 63 - qw0;
                const LAS float* tabp = (relmax > -91) ? tab + (64 * j - qw0 + 192 + 4 * hi - r32) : nullptr;
                float f; const bool resc = sm_decide(p0, p1, m, f, cfar, tabp, hi);
                if (have) pv_exp(o, vb + vprev * SLOT, pw0, pw1, pw2, pw3, p0, p1, m);
                else {
#pragma unroll
                    for (int r = 0; r < 16; ++r) { p0[r] = __builtin_amdgcn_exp2f(p0[r] - m); p1[r] = __builtin_amdgcn_exp2f(p1[r] - m); } }
                if (resc) {
                    if (hi == 0) wsf[r32] = f;
                    LDS_WAIT();
#pragma unroll
                    for (int r = 0; r < 16; ++r) { const float fr_ = wsf[crow(r, hi)];
#pragma unroll
                        for (int db = 0; db < 4; ++db) o[db][r] *= fr_; }
                    LDS_WAIT();
                }
                float sacc = 0.f;
#pragma unroll
                for (int r = 0; r < 16; ++r) sacc += p0[r] + p1[r];
                l = l * f + sacc;
                pack_p(p0, p1, pw0, pw1, pw2, pw3); have = true;
            } else if (have) { pv<4>(o, vb + vprev * SLOT, pw0, pw1, pw2, pw3); have = false; }
            vprev = vs; vs = vnext;
        }
        lds_bar();
        float rli[16]; row_inv_l(l, rli, wsf, r32, hi);
        LAS bf16* st = (LAS bf16*)stg;
        if (mp == 0) {
#pragma unroll
            for (int r = 0; r < 16; ++r) { const int orow = crow(r, hi);
#pragma unroll
                for (int db = 0; db < 4; ++db) st[orow * 128 + db * 32 + r32] = (bf16)f2bf(o[db][r] * rli[r]); }
            LDS_WAIT();
        } else {
            float ss[16];
#pragma unroll
            for (int r = 0; r < 16; ++r) { const int orow = crow(r, hi); float q = 0.f;
#pragma unroll
                for (int db = 0; db < 4; ++db) { const float a = bf2f(st[orow * 128 + db * 32 + r32]) - lam * (o[db][r] * rli[r]); o[db][r] = a; q += a * a; }
                ss[r] = q; }
#pragma unroll
            for (int r = 0; r < 16; ++r) { float q = ss[r];
#pragma unroll
                for (int x = 1; x < 32; x <<= 1) q += __shfl_xor(q, x);
                ss[r] = __builtin_amdgcn_rsqf(q * (1.0f / 128.0f) + RMS_EPS) * outscale; }
            float g4[4];
#pragma unroll
            for (int db = 0; db < 4; ++db) g4[db] = subg[db * 32 + r32];
            asm volatile("" :: "v"(g4[0]), "v"(g4[1]), "v"(g4[2]), "v"(g4[3]));
#pragma unroll
            for (int db = 0; db < 4; ++db) {
#pragma unroll
                for (int r = 0; r < 16; ++r) o[db][r] *= g4[db]; }
            LDS_WAIT();
            store_o<4>(o, ss, stg, ydf + (rowb + qw0) * YP + H * 128, lane, r32, hi);
        }
    }
    lds_bar();
}

__device__ __forceinline__ void mem_unit(LAS unsigned char* lds, volatile LAS unsigned* LWv, const bf16* proj, const bf16* memkv, bf16* ymem, int b, int h, int qq, int, int) {
    const int tid_ = tid_opaque(), lane = tid_ & 63, wid = __builtin_amdgcn_readfirstlane(tid_ >> 6);
    const int r32 = lane & 31, hi = lane >> 5;
    const size_t rowb = (size_t)b * SEQ;
    const bf16* Kh = memkv + (size_t)b * MEML * 2048 + h * 128; const bf16* Vh = Kh + W;
    const unsigned lds0 = (unsigned)(uintptr_t)lds;
    volatile LAS float* wsf = (volatile LAS float*)(LWv + LW_WSF + wid * 64);
    LAS unsigned char* stg = (LAS unsigned char*)(LWv + LW_MSTG) + wid * 2048;
    constexpr int MK = 0, MV = 4 * SLOT;
#pragma unroll
    for (int j = 0; j < MEML / 64; ++j) dma_tile<2, 2>(Kh + (size_t)j * 64 * 2048, Vh + (size_t)j * 64 * 2048, 2048, lds0 + MK + j * SLOT, lds0 + MV + j * SLOT, wid, lane);
    wait_bar<0>();
    lptr vb = (lptr)lds + MV + ((lane >> 4) & 1) * 32 + (lane & 3) * 8 + (4 * hi + ((lane & 15) >> 2)) * 64;
#pragma unroll 1
    for (int qs = 0; qs < 4; ++qs) {
        const int qw0 = 1024 * qq + 256 * qs + 32 * wid;
        const bf16* Qw = proj + (rowb + qw0) * PP + 6 * W + h * 128;
        bf16x8 qr[8];
#pragma unroll
        for (int d0 = 0; d0 < 8; ++d0) qr[d0] = *(const bf16x8*)(Qw + (size_t)r32 * PP + d0 * 16 + hi * 8);
        f32x16 o[4];
#pragma unroll
        for (int db = 0; db < 4; ++db) o[db] = (f32x16){};
        float m = -INFINITY, l = 0.f;
#pragma unroll 1
        for (int j = 0; j < MEML / 64; ++j) {
            f32x16 p0, p1;
            qkt<8>(p0, p1, (lptr)lds + MK + j * SLOT, qr, r32, hi);
            softmax_tile<4>(p0, p1, o, m, l, 0.f, nullptr, wsf, r32, hi);
            v4u pw0, pw1, pw2, pw3; pack_p(p0, p1, pw0, pw1, pw2, pw3);
            pv<4>(o, vb + j * SLOT, pw0, pw1, pw2, pw3);
        }
        float rli[16]; row_inv_l(l, rli, wsf, r32, hi);
        LAS bf16* st = (LAS bf16*)stg; bf16* Yw = ymem + (rowb + qw0) * YP + h * 128;
#pragma unroll
        for (int g = 0; g < 4; ++g) {
#pragma unroll
            for (int i = 0; i < 4; ++i)
#pragma unroll
                for (int db = 0; db < 4; ++db) st[(4 * hi + i) * 128 + db * 32 + r32] = (bf16)f2bf(o[db][4 * g + i] * rli[4 * g + i]);
            LDS_WAIT();
#pragma unroll
            for (int i = 0; i < 2; ++i) { const int idx = i * 64 + lane, row = idx >> 4, ch = idx & 15;
                const v4u v = *(const LAS v4u*)(stg + row * 256 + ch * 16); *(v4u*)(Yw + (size_t)(8 * g + row) * YP + ch * 8) = v; }
            LDS_WAIT();
        }
    }
    lds_bar();
}
}

#define PH_LOCALS() KArgs ka = ka_opaque(); unsigned char* ws = ka->ws; const int tid = tid_opaque(), lane = tid & 63, wave = __builtin_amdgcn_readfirstlane(tid >> 6); \
    const int G = gridDim.x, bx = blockIdx.x, vcu = (G % 8 == 0) ? (bx % 8) * (G / 8) + bx / 8 : bx, gw = vcu * NWAVES + wave, NGW = G * NWAVES; \
    (void)ws; (void)lane; (void)wave; (void)gw; (void)NGW; (void)vcu; (void)bx
__global__ void __launch_bounds__(NWAVES * 64, 2) mk_fwd(Args args) {
    extern __shared__ __attribute__((aligned(16))) unsigned char lds_raw[];
    LAS unsigned char* lds = (LAS unsigned char*)lds_raw;
    volatile LAS unsigned* LW = (volatile LAS unsigned*)(lds + LDSCTL_OFF);
    for (int u = threadIdx.x; u < (LDS_BYTES - LDSCTL_OFF) / 4; u += NWAVES * 64) ((LAS unsigned*)(lds + LDSCTL_OFF))[u] = 0u;
    __syncthreads();
#if MK_ONE_LAUNCH
    XcdBarrier bar = xcd_barrier_post((unsigned*)((gu32*)(args.ws + WS_CTL) + CW_BAR), LW + LW_BAR);
#define GRID_BAR() xcd_barrier(bar)
#else
#define GRID_BAR() do {} while (0)
#endif
    const int lo = args.ph_lo, hi = args.ph_hi;
#define IN(k) (lo <= (k) && (k) < hi)
#define BOTH(k) (IN(k) && IN((k) + 1))

    if (PH_EN(0) && IN(0)) REP(0) {
        PH_LOCALS();
        LAS float* scr = (LAS float*)(lds + RING_OFF + wave * 16384);
        constexpr int I_IN = 16 * (INW / 32), I_SQ = 16 * 32, I_BR = 8 * 32, I_GU = 16 * 64, I_D = 16 * 32;
        constexpr int PER_LAYER = I_IN + I_SQ + 3 * I_BR + I_SQ + NE * I_GU + NE * I_D;
        constexpr int S_IN = I8_P1 ? INW / 32 : 0, S_GU = I8_P6 ? NE * (2 * DFF / 32) : 0, SPL = S_IN + S_GU, NS = DEPTH * SPL;
#pragma unroll 1
        for (int st = vcu; st < NS; st += G) {
            const int l = st / SPL; int r = st % SPL;
            LAS float* pmax = (LAS float*)(lds + LDSCTL_OFF) + LW_RSLOT;
            if (r < S_IN) { p0_quant_strip_wg(ka->in[2] + (size_t)l * D * INW, INW, (signed char*)(ws + WS_WIN) + (size_t)l * INW * D, (float*)(ws + WS_SWIN) + (size_t)l * INW, 32 * r, 32 * r, (LAS float*)(lds + RING_OFF), pmax, wave, lane); continue; }
            r -= S_IN;
            { const int e = r / (2 * DFF / 32), n0 = 32 * (r % (2 * DFF / 32)); const int cc = (n0 >= DFF) ? n0 - DFF : n0, drow0 = (cc >> 7) * 256 + (n0 >= DFF ? 128 : 0) + (cc & 127);
              p0_quant_strip_wg(ka->in[14] + ((size_t)l * NE + e) * D * 2 * DFF, 2 * DFF, (signed char*)(ws + WS_WGU) + ((size_t)l * NE + e) * 2 * DFF * D, (float*)(ws + WS_SWGU) + ((size_t)l * NE + e) * 2 * DFF, drow0, n0, (LAS float*)(lds + RING_OFF), pmax, wave, lane); }
        }
#pragma unroll 1
        for (int it = gw; it < DEPTH * PER_LAYER; it += NGW) {
            const int l = it / PER_LAYER; int r = it % PER_LAYER;
            if (r < I_IN) { if (!I8_P1) p0_matrix(r, ka->in[2] + (size_t)l * D * INW, D, INW, (bf16*)(ws + WS_WIN) + (size_t)l * INW * D, false, scr, lane); continue; }
            r -= I_IN;
            if (p0_matrix(r, ka->in[7] + (size_t)l * D * 1024, D, 1024, (bf16*)(ws + WS_WMEMKV) + (size_t)l * 1024 * D, false, scr, lane)) continue;
            if (r < 3 * I_BR) { const int b = r / I_BR; int rr = r % I_BR;
                p0_matrix(rr, ka->in[8] + ((size_t)l * 3 + b) * W * D, W, D, (bf16*)(ws + WS_WBR) + (size_t)l * D * 3 * W, false, scr, lane, 3 * W, b * W); continue; }
            r -= 3 * I_BR;
            if (p0_matrix(r, ka->in[9] + (size_t)l * D * D, D, D, (bf16*)(ws + WS_WOUT) + (size_t)l * D * D, false, scr, lane)) continue;
            if (r < NE * I_GU) { if (!I8_P6) { const int e = r / I_GU; int rr = r % I_GU;
                p0_matrix(rr, ka->in[14] + ((size_t)l * NE + e) * D * 2 * DFF, D, 2 * DFF, (bf16*)(ws + WS_WGU) + ((size_t)l * NE + e) * 2 * DFF * D, true, scr, lane); } continue; }
            r -= NE * I_GU;
            { const int e = r / I_D; int rr = r % I_D;
                p0_matrix(rr, ka->in[16] + ((size_t)l * NE + e) * DFF * D, DFF, D, (bf16*)(ws + WS_WD) + ((size_t)l * NE + e) * D * DFF, false, scr, lane); }
        }
        { const float* x_in = ka->in[0]; bf16* XN = (bf16*)(ws + WS_XN); signed char* XQ = (signed char*)(ws + WS_XQ); float* SX = (float*)(ws + WS_SX);
#pragma unroll 1
          for (int m = gw; m < T; m += 2 * NGW) {
              const int mb = (m + NGW < T) ? m + NGW : m;
              if (!(I8_P1 && I8_P6)) { row_to_bf16(x_in + (size_t)m * D, XN + (size_t)m * D, lane); row_to_bf16(x_in + (size_t)mb * D, XN + (size_t)mb * D, lane); }
              if (I8_P1 || I8_P6) { f32x4 v[4], w[4];
#pragma unroll
                  for (int j = 0; j < 4; ++j) { v[j] = ((const GAS f32x4*)(x_in + (size_t)m * D) + lane)[64 * j]; w[j] = ((const GAS f32x4*)(x_in + (size_t)mb * D) + lane)[64 * j]; }
                  quant_row(v, XQ + (size_t)m * D, SX + m, lane); quant_row(w, XQ + (size_t)mb * D, SX + mb, lane); } } }
        { const float* mem_in = ka->in[1]; bf16* MEMB = (bf16*)(ws + WS_MEMB);
#pragma unroll 1
          for (int m = gw; m < MEMT; m += NGW) row_to_bf16(mem_in + (size_t)m * D, MEMB + (size_t)m * D, lane); }
        if (BOTH(0)) GRID_BAR();
    }

#pragma unroll 1
    for (int l = 0; l < DEPTH; ++l) {
        const int pb = 1 + 8 * l;
        if (PH_EN(1) && IN(pb + 0)) REP(1) {
            { PH_LOCALS();
#if I8_P1
              pg8::DenseOrder S{(const char*)(ws + WS_XQ), (const char*)(ws + WS_WIN) + (size_t)l * INW * D, T / 256, INW / 256, G, bx, D / 2};
              pg8::EpiProjQ E{(bf16*)(ws + WS_PROJ), PP, ka->in[3] + (size_t)l * 3 * D, GATE0, GATE0, (unsigned char*)(ws + WS_G8), (const float*)(ws + WS_SX), (const float*)(ws + WS_SWIN) + (size_t)l * INW};
              pg8::gemm_phase<pg8::EpiProjQ, pg8::DenseOrder, false, true, true>(lds + RING_OFF, D / 2, S, E, (unsigned*)(ws + WS_DUMP)); }
#else
              pg8::DenseOrder S{(const char*)(ws + WS_XN), (const char*)((bf16*)(ws + WS_WIN) + (size_t)l * INW * D), T / 256, INW / 256, G, bx, D};
              pg8::EpiProj E{(bf16*)(ws + WS_PROJ), PP, ka->in[3] + (size_t)l * 3 * D, GATE0, GATE0, (unsigned char*)(ws + WS_G8), nullptr, nullptr};
              pg8::gemm_phase<pg8::EpiProj, pg8::DenseOrder, false, true>(lds + RING_OFF, D, S, E, (unsigned*)(ws + WS_DUMP)); }
#endif
            if (l == 0) { PH_LOCALS();
              pg8::DenseOrder S{(const char*)(ws + WS_MEMB), (const char*)(ws + WS_WMEMKV), MEMT / 256, 2048 / 256, G, bx, D};
              pg8::EpiProj E{(bf16*)(ws + WS_MEMKV2), 2048, nullptr, 1 << 30, 0, nullptr, nullptr, nullptr};
              pg8::gemm_phase<pg8::EpiProj, pg8::DenseOrder, false, true>(lds + RING_OFF, D, S, E, (unsigned*)(ws + WS_DUMP)); }
            if (BOTH(pb + 0)) GRID_BAR();
        }
        if (PH_EN(2) && IN(pb + 1)) REP(2) {
            PH_LOCALS();
            const bf16* PROJ = (const bf16*)(ws + WS_PROJ); bf16* YB = (bf16*)(ws + WS_Y);
            { LAS float* tab = (LAS float*)(lds + LDSCTL_OFF) + att::LW_TAB; const float* rel_bias = ka->in[6];
              for (int i = tid; i < 8 * 256; i += NWAVES * 64) tab[i] = rel_bias[t5_bucket((i & 255) - 192) * 8 + (i >> 8)] * att::LOG2E; }
            float lam, outscale;
            { const float* dl = ka->in[4] + (size_t)l * 256; float s1 = 0.f, s2 = 0.f;
              for (int i = 0; i < 64; ++i) { s1 += dl[i] * dl[64 + i]; s2 += dl[128 + i] * dl[192 + i]; }
              const float lam_init = 0.8f - 0.6f * expf(-0.3f * (float)l); lam = expf(s1) - expf(s2) + lam_init; outscale = 1.0f - lam_init; }
            __syncthreads();
            const float* subg = ka->in[5] + (size_t)l * 128;
#pragma unroll 1
            REP(9) for (int it = vcu; ATT_EN(0) && it < BATCH * 4 * 8; it += G) { const int bH = it >> 3, s8 = it & 7;
#pragma unroll 1
                for (int z = 0; z < 2; ++z) att::df_unit(lds, LW, PROJ, YB + W, subg, lam, outscale, bH >> 2, bH & 3, z ? s8 : 15 - s8, wave, lane); }
#pragma unroll 1
            REP(10) for (int u = vcu; ATT_EN(1) && u < BATCH * 8 * 16; u += G) { const int bh = u >> 4; att::sb_unit(lds, LW, PROJ, YB, bh >> 3, bh & 7, u & 15, wave, lane); }
#pragma unroll 1
            REP(11) for (int u = vcu; ATT_EN(2) && u < BATCH * 4 * 4; u += G) { const int bh = u >> 2; att::mem_unit(lds, LW, PROJ, (const bf16*)(ws + WS_MEMKV2) + l * 1024, YB + 2 * W, bh >> 2, bh & 3, u & 3, wave, lane); }
            if (BOTH(pb + 1)) GRID_BAR();
        }
        if (PH_EN(3) && IN(pb + 2)) REP(3) {
            PH_LOCALS();
            pg8::EpiBranch E{(const unsigned char*)(ws + WS_G8), (bf16*)(ws + WS_MERGED)};
            { pg8::PanelOrder S{(const char*)(ws + WS_Y), (const char*)((bf16*)(ws + WS_WBR) + (size_t)l * D * 3 * W), T / 256, D / 256, G, bx, vcu, 3 * W, false};
              pg8::gemm_phase<pg8::EpiBranch, pg8::PanelOrder, false, true>(lds + RING_OFF, 3 * W, S, E, (unsigned*)(ws + WS_DUMP)); }
            if (BOTH(pb + 2)) GRID_BAR();
        }
        if (PH_EN(4) && IN(pb + 3)) REP(4) {
            PH_LOCALS();
            const float* xprev = (l == 0) ? ka->in[0] : ka->out;
            pg8::EpiOut E{xprev, (float*)(ws + WS_X1)};
            { pg8::PanelOrder S{(const char*)(ws + WS_MERGED), (const char*)((bf16*)(ws + WS_WOUT) + (size_t)l * D * D), T / 256, D / 256, G, bx, vcu, D, false};
              pg8::gemm_phase<pg8::EpiOut, pg8::PanelOrder, false, true>(lds + RING_OFF, D, S, E, (unsigned*)(ws + WS_DUMP)); }
            if (BOTH(pb + 3)) GRID_BAR();
        }
        if (PH_EN(5) && IN(pb + 4)) {
            PH_LOCALS();
            gu32* ctl = (gu32*)(ws + WS_CTL); float* X1 = (float*)(ws + WS_X1); bf16* XN = (bf16*)(ws + WS_XN); int* PERM = (int*)(ws + WS_PERM); float* SLOTW = (float*)(ws + WS_SLOTW); unsigned* SLOTPOS = (unsigned*)(ws + WS_SLOTPOS); float* STATS = (float*)(ws + WS_STATS); signed char* XQ = (signed char*)(ws + WS_XQ); float* SX = (float*)(ws + WS_SX); float* SXP = (float*)(ws + WS_SXP);
            LAS float* WT = (LAS float*)(lds + RING_OFF);
            const float* rw = ka->in[12] + (size_t)l * D * NE; const float* rb = ka->in[13] + (size_t)l * NE;
            { f32x4 wv[16];
#pragma unroll
              for (int it = 0; it < 16; ++it) wv[it] = *(const f32x4*)(rw + tid * 4 + it * (NWAVES * 64 * 4));
              asm volatile("" :: "v"(wv[0]), "v"(wv[1]), "v"(wv[2]), "v"(wv[3]), "v"(wv[4]), "v"(wv[5]), "v"(wv[6]), "v"(wv[7]), "v"(wv[8]), "v"(wv[9]), "v"(wv[10]), "v"(wv[11]), "v"(wv[12]), "v"(wv[13]), "v"(wv[14]), "v"(wv[15]));
#pragma unroll
              for (int it = 0; it < 16; ++it) { const int i = tid * 4 + it * (NWAVES * 64 * 4), k = i >> 5, e = i & 31;
#pragma unroll
                  for (int c = 0; c < 4; ++c) WT[(e + c) * WT_STRIDE + k] = wv[it][c]; } }
            if (tid < NE) LW[LW_RCNT + tid] = 0u;
            __syncthreads();
            const float* g1 = ka->in[10] + (size_t)l * D; const float* b1 = ka->in[11] + (size_t)l * D;
            f32x4 gv[4], bv[4];
#pragma unroll
            for (int j = 0; j < 4; ++j) { gv[j] = *(const f32x4*)(g1 + 256 * j + 4 * lane); bv[j] = *(const f32x4*)(b1 + 256 * j + 4 * lane); }
            const int rows_per_wg = (T + G - 1) / G, rows_per_wave = (((rows_per_wg + NWAVES - 1) / NWAVES) + 1) & ~1;
            const int rbase = vcu * rows_per_wg + wave * rows_per_wave;
            const int myexp = (lane >> 1) & 31;
            const float myrb = rb[myexp];
#pragma unroll 1
            for (int ri = 0; ri < rows_per_wave; ri += 2) {
                const int m0 = rbase + ri;
                const bool ok0 = (m0 < T) && (wave * rows_per_wave + ri) < rows_per_wg, ok1 = (m0 + 1 < T) && (wave * rows_per_wave + ri + 1) < rows_per_wg;
                if (!ok0) break;
                const int m1 = ok1 ? m0 + 1 : m0;
                GAS f32x4* xr0 = (GAS f32x4*)(X1 + (size_t)m0 * D) + lane; GAS f32x4* xr1 = (GAS f32x4*)(X1 + (size_t)m1 * D) + lane;
                f32x4 v0[4], v1[4]; float s0 = 0.f, s1 = 0.f;
#pragma unroll
                for (int j = 0; j < 4; ++j) { v0[j] = xr0[64 * j]; v1[j] = xr1[64 * j]; }
#pragma unroll
                for (int j = 0; j < 4; ++j) { s0 += (v0[j].x + v0[j].y) + (v0[j].z + v0[j].w); s1 += (v1[j].x + v1[j].y) + (v1[j].z + v1[j].w); }
                const float mean0 = wave_sum(s0) * (1.f / D), mean1 = wave_sum(s1) * (1.f / D); float q0 = 0.f, q1 = 0.f;
#pragma unroll
                for (int j = 0; j < 4; ++j) { v0[j] = v0[j] - mean0; v1[j] = v1[j] - mean1;
                    q0 += (v0[j].x * v0[j].x + v0[j].y * v0[j].y) + (v0[j].z * v0[j].z + v0[j].w * v0[j].w); q1 += (v1[j].x * v1[j].x + v1[j].y * v1[j].y) + (v1[j].z * v1[j].z + v1[j].w * v1[j].w); }
                const float rstd0 = 1.f / sqrtf(wave_sum(q0) * (1.f / D) + LN_EPS), rstd1 = 1.f / sqrtf(wave_sum(q1) * (1.f / D) + LN_EPS);
                GAS unsigned long long* o80 = (GAS unsigned long long*)(XN + (size_t)m0 * D) + lane; GAS unsigned long long* o81 = (GAS unsigned long long*)(XN + (size_t)m1 * D) + lane;
#pragma unroll
                for (int j = 0; j < 4; ++j) { v0[j] = v0[j] * rstd0 * gv[j] + bv[j]; v1[j] = v1[j] * rstd1 * gv[j] + bv[j];
                    if (!I8_P6) { o80[64 * j] = (unsigned long long)pk2(v0[j].x, v0[j].y) | ((unsigned long long)pk2(v0[j].z, v0[j].w) << 32);
                        if (ok1) o81[64 * j] = (unsigned long long)pk2(v1[j].x, v1[j].y) | ((unsigned long long)pk2(v1[j].z, v1[j].w) << 32); } }
                if (I8_P6) { quant_row(v0, XQ + (size_t)m0 * D, SX + m0, lane); quant_row(v1, XQ + (size_t)m1 * D, SX + m1, lane); }
                if (lane == 0) { STATS[2 * (size_t)m0] = mean0; STATS[2 * (size_t)m0 + 1] = rstd0; if (ok1) { STATS[2 * (size_t)m1] = mean1; STATS[2 * (size_t)m1 + 1] = rstd1; } }
                float pa[NE], pb[NE];
                {
#pragma unroll
                  for (int e = 0; e < NE; e += 2) { f32x4 w[2][4];
#pragma unroll
                      for (int u = 0; u < 2; ++u)
#pragma unroll
                          for (int j = 0; j < 4; ++j) w[u][j] = *(const LAS f32x4*)(WT + (e + u) * WT_STRIDE + 256 * j + 4 * lane);
                      f32x2 alo[2][2], ahi[2][2];
#pragma unroll
                      for (int u = 0; u < 2; ++u) {
                          alo[0][u] = (f32x2){v0[0].x, v0[0].y} * (f32x2){w[u][0].x, w[u][0].y}; ahi[0][u] = (f32x2){v0[0].z, v0[0].w} * (f32x2){w[u][0].z, w[u][0].w};
                          alo[1][u] = (f32x2){v1[0].x, v1[0].y} * (f32x2){w[u][0].x, w[u][0].y}; ahi[1][u] = (f32x2){v1[0].z, v1[0].w} * (f32x2){w[u][0].z, w[u][0].w}; }
#pragma unroll
                      for (int j = 1; j < 4; ++j)
#pragma unroll
                          for (int u = 0; u < 2; ++u) {
                              alo[0][u] = (f32x2){v0[j].x, v0[j].y} * (f32x2){w[u][j].x, w[u][j].y} + alo[0][u]; ahi[0][u] = (f32x2){v0[j].z, v0[j].w} * (f32x2){w[u][j].z, w[u][j].w} + ahi[0][u];
                              alo[1][u] = (f32x2){v1[j].x, v1[j].y} * (f32x2){w[u][j].x, w[u][j].y} + alo[1][u]; ahi[1][u] = (f32x2){v1[j].z, v1[j].w} * (f32x2){w[u][j].z, w[u][j].w} + ahi[1][u]; }
#pragma unroll
                      for (int u = 0; u < 2; ++u) { const f32x2 ta = alo[0][u] + ahi[0][u], tb = alo[1][u] + ahi[1][u]; pa[e + u] = ta.x + ta.y; pb[e + u] = tb.x + tb.y; } } }
#define RT_SWAP(P, n, SW) _Pragma("unroll") for (int e = 0; e < n; ++e) { auto rr = SW(__float_as_uint(P[e]), __float_as_uint(P[e + n]), false, false); P[e] = __uint_as_float(rr[0]) + __uint_as_float(rr[1]); }
                RT_SWAP(pa, 16, __builtin_amdgcn_permlane32_swap) RT_SWAP(pb, 16, __builtin_amdgcn_permlane32_swap)
                RT_SWAP(pa, 8, __builtin_amdgcn_permlane16_swap) RT_SWAP(pb, 8, __builtin_amdgcn_permlane16_swap)
#undef RT_SWAP
#pragma unroll
                for (int e = 0; e < 4; ++e) { const bool up = (lane & 8) != 0; const float ka_ = up ? pa[e + 4] : pa[e], sa_ = up ? pa[e] : pa[e + 4], kb_ = up ? pb[e + 4] : pb[e], sb_ = up ? pb[e] : pb[e + 4];
                    pa[e] = ka_ + dppf<0x128>(sa_); pb[e] = kb_ + dppf<0x128>(sb_); }
#pragma unroll
                for (int e = 0; e < 2; ++e) { const bool up = (lane & 4) != 0; const float ka_ = up ? pa[e + 2] : pa[e], sa_ = up ? pa[e] : pa[e + 2], kb_ = up ? pb[e + 2] : pb[e], sb_ = up ? pb[e] : pb[e + 2];
                    pa[e] = ka_ + __shfl_xor(sa_, 4); pb[e] = kb_ + __shfl_xor(sb_, 4); }
                { const bool up = (lane & 2) != 0; const float ka_ = up ? pa[1] : pa[0], sa_ = up ? pa[0] : pa[1], kb_ = up ? pb[1] : pb[0], sb_ = up ? pb[0] : pb[1];
                    pa[0] = ka_ + dppf<0x4E>(sa_); pb[0] = kb_ + dppf<0x4E>(sb_); }
                const float la = pa[0] + dppf<0xB1>(pa[0]) + myrb, lb = pb[0] + dppf<0xB1>(pb[0]) + myrb;
                float tva[TOPK], tvb[TOPK]; int tea[TOPK], teb[TOPK];
                { float ca = la, cb = lb;
#pragma unroll
                  for (int k = 0; k < TOPK; ++k) {
                      const float mxa = wave_max(ca), mxb = wave_max(cb);
                      const unsigned long long ma = __ballot(ca == mxa), mb = __ballot(cb == mxb);
                      const int lna = ma ? (int)__builtin_ctzll(ma) : 0, lnb = mb ? (int)__builtin_ctzll(mb) : 0;
                      tea[k] = lna >> 1; teb[k] = lnb >> 1; tva[k] = mxa; tvb[k] = mxb;
                      ca = (myexp == tea[k]) ? -INFINITY : ca; cb = (myexp == teb[k]) ? -INFINITY : cb; } }
                float ewa[TOPK], ewb[TOPK], esa = 0.f, esb = 0.f;
#pragma unroll
                for (int k = 0; k < TOPK; ++k) { ewa[k] = fast_exp(tva[k] - tva[0]); esa += ewa[k]; ewb[k] = fast_exp(tvb[k] - tvb[0]); esb += ewb[k]; }
                const float inva = 1.0f / esa, invb = 1.0f / esb;
                if (lane < 2 * TOPK && (lane < TOPK || ok1)) {
                    const int kk = lane & 3; const bool second = lane >= TOPK;
                    const int ek = second ? (kk == 0 ? teb[0] : kk == 1 ? teb[1] : kk == 2 ? teb[2] : teb[3]) : (kk == 0 ? tea[0] : kk == 1 ? tea[1] : kk == 2 ? tea[2] : tea[3]);
                    const float wk = second ? (kk == 0 ? ewb[0] : kk == 1 ? ewb[1] : kk == 2 ? ewb[2] : ewb[3]) * invb : (kk == 0 ? ewa[0] : kk == 1 ? ewa[1] : kk == 2 ? ewa[2] : ewa[3]) * inva;
                    const unsigned lr = __hip_atomic_fetch_add((LAS unsigned*)(LW + LW_RCNT + ek), 1u, __ATOMIC_RELAXED, __HIP_MEMORY_SCOPE_WORKGROUP);
                    LW[LW_RSLOT + wave * RSLOT_STRIDE + ri * 4 + lane] = ((unsigned)ek << 16) | lr;
                    SLOTW[(size_t)m0 * 4 + lane] = wk;
                }
            }
            __syncthreads();
            if (tid < NE) { const unsigned c = LW[LW_RCNT + tid]; LW[LW_RBASE + tid] = c ? __hip_atomic_fetch_add(ctl + CW_CNT + (l * NE + tid) * 64, c, RLX_AGENT) : 0u; }
            __syncthreads();
            for (int q = lane; q < rows_per_wave * 4; q += 64) { const int ri = q >> 2, m = rbase + ri;
                if (m < T && (wave * rows_per_wave + ri) < rows_per_wg) { const unsigned ent = LW[LW_RSLOT + wave * RSLOT_STRIDE + q]; const unsigned e = ent >> 16, lr = ent & 0xffffu;
                    const unsigned rk = LW[LW_RBASE + e] + lr; PERM[(size_t)e * T + rk] = m * 4 + (q & 3); SLOTPOS[(size_t)m * 4 + (q & 3)] = (e << 16) | rk;
                    if (I8_P6) SXP[(size_t)e * T + rk] = SX[m]; } }
            if (BOTH(pb + 4)) GRID_BAR();
        }
        if ((PH_EN(6) && IN(pb + 5)) || (PH_EN(7) && IN(pb + 6)) || (PH_EN(8) && IN(pb + 7))) {
            PH_LOCALS();
            gu32* ctl = (gu32*)(ws + WS_CTL);
            __syncthreads();
            if (tid < 64) {
                const int c = (tid < NE) ? (int)__hip_atomic_load(ctl + CW_CNT + (l * NE + tid) * 64, RLX_AGENT) : 0;
                int tl = (c + 255) >> 8, inc = tl;
#pragma unroll
                for (int o_ = 1; o_ < 32; o_ <<= 1) { const int nb = __shfl_up(inc, o_); if ((tid & 31) >= o_) inc += nb; }
                if (tid < NE) { LW[LW_LCNT + tid] = (unsigned)c; LW[LW_TOFF + tid] = (unsigned)(inc - tl); if (tid == NE - 1) LW[LW_TOFF + NE] = (unsigned)inc; }
            }
            __syncthreads();
        }
        if (PH_EN(6) && IN(pb + 5)) REP(6) {
            PH_LOCALS();
            const LAS int* toff = (const LAS int*)(lds + LDSCTL_OFF) + LW_TOFF; const LAS int* lcnt = (const LAS int*)(lds + LDSCTL_OFF) + LW_LCNT;
#if I8_P6
            pg8::MoeOrder S{(const char*)(ws + WS_XQ), (const char*)(ws + WS_WGU) + (size_t)l * NE * 2 * DFF * D, 2 * DFF / 256, __builtin_amdgcn_readfirstlane(toff[NE]), G, bx, D / 2, (size_t)2 * DFF * D, toff, lcnt, (const int*)(ws + WS_PERM)};
            pg8::EpiGateUpQ E{(bf16*)(ws + WS_ACT), ka->in[15] + (size_t)l * NE * 2 * DFF, (const float*)(ws + WS_SXP), (const float*)(ws + WS_SWGU) + (size_t)l * NE * 2 * DFF};
            pg8::gemm_phase<pg8::EpiGateUpQ, pg8::MoeOrder, true, true, true>(lds + RING_OFF, D / 2, S, E, (unsigned*)(ws + WS_DUMP));
#else
            pg8::MoeOrder S{(const char*)(ws + WS_XN), (const char*)((bf16*)(ws + WS_WGU) + (size_t)l * NE * 2 * DFF * D), 2 * DFF / 256, __builtin_amdgcn_readfirstlane(toff[NE]), G, bx, D, (size_t)2 * DFF * D * 2, toff, lcnt, (const int*)(ws + WS_PERM)};
            pg8::EpiGateUp E{(bf16*)(ws + WS_ACT), ka->in[15] + (size_t)l * NE * 2 * DFF, nullptr, nullptr};
            pg8::gemm_phase<pg8::EpiGateUp, pg8::MoeOrder, true, true>(lds + RING_OFF, D, S, E, (unsigned*)(ws + WS_DUMP));
#endif
            if (BOTH(pb + 5)) GRID_BAR();
        }
        if (PH_EN(7) && IN(pb + 6)) REP(7) {
            PH_LOCALS();
            const LAS int* toff = (const LAS int*)(lds + LDSCTL_OFF) + LW_TOFF; const LAS int* lcnt = (const LAS int*)(lds + LDSCTL_OFF) + LW_LCNT;
            pg8::MoeDenseOrder S{{(const char*)(ws + WS_ACT), (const char*)((bf16*)(ws + WS_WD) + (size_t)l * NE * D * DFF), D / 256, __builtin_amdgcn_readfirstlane(toff[NE]), G, bx, DFF, (size_t)D * DFF * 2, toff, lcnt, (const int*)(ws + WS_PERM)}};
            pg8::EpiDown E{(bf16*)(ws + WS_CONTRIB), ka->in[17] + (size_t)l * NE * D};
            pg8::gemm_phase<pg8::EpiDown, pg8::MoeDenseOrder, false, true>(lds + RING_OFF, DFF, S, E, (unsigned*)(ws + WS_DUMP));
            if (BOTH(pb + 6)) GRID_BAR();
        }
        if (PH_EN(8) && IN(pb + 7)) REP(8) {
            PH_LOCALS();
            const float* X1 = (const float*)(ws + WS_X1); bf16* XN = (bf16*)(ws + WS_XN); const bf16* CONTRIB = (const bf16*)(ws + WS_CONTRIB); float* outp = ka->out; const unsigned* SLOTPOS = (const unsigned*)(ws + WS_SLOTPOS); const float* SLOTW = (const float*)(ws + WS_SLOTW);
            const float* g2 = ka->in[18] + (size_t)l * D; const float* b2 = ka->in[19] + (size_t)l * D; const float* g1 = ka->in[10] + (size_t)l * D; const float* b1 = ka->in[11] + (size_t)l * D;
            const float* STATS = (const float*)(ws + WS_STATS);
            f32x4 gv[4], bv[4], g1v[4], b1v[4];
#pragma unroll
            for (int j = 0; j < 4; ++j) { gv[j] = *(const f32x4*)(g2 + 256 * j + 4 * lane); bv[j] = *(const f32x4*)(b2 + 256 * j + 4 * lane); g1v[j] = *(const f32x4*)(g1 + 256 * j + 4 * lane); b1v[j] = *(const f32x4*)(b1 + 256 * j + 4 * lane); }
#pragma unroll 1
            for (int m = gw; m < T; m += NGW) {
                const GAS f32x4* xr = (const GAS f32x4*)(X1 + (size_t)m * D) + lane;
                f32x4 v[4]; float s = 0.f;
#pragma unroll
                for (int j = 0; j < 4; ++j) v[j] = xr[64 * j];
                { const float mean1 = STATS[2 * (size_t)m], rstd1 = STATS[2 * (size_t)m + 1];
#pragma unroll
                  for (int j = 0; j < 4; ++j) v[j] = (((v[j] - mean1) * rstd1) * g1v[j] + b1v[j]) * DN_ALPHA; }
#pragma unroll
                for (int k = 0; k < TOPK; ++k) { const unsigned sp = SLOTPOS[(size_t)m * 4 + k]; const float cw = SLOTW[(size_t)m * 4 + k];
                    const size_t srow = (size_t)LW[LW_TOFF + (sp >> 16)] * 256 + (sp & 0xffffu);
                    const GAS v2u* cr = (const GAS v2u*)(CONTRIB + srow * D) + lane;
#pragma unroll
                    for (int j = 0; j < 4; ++j) { const v2u c = cr[64 * j]; v[j].x += cw * bflo(c.x); v[j].y += cw * bfhi(c.x); v[j].z += cw * bflo(c.y); v[j].w += cw * bfhi(c.y); } }
#pragma unroll
                for (int j = 0; j < 4; ++j) s += (v[j].x + v[j].y) + (v[j].z + v[j].w);
                const float mean = wave_sum(s) * (1.f / D); float s2 = 0.f;
#pragma unroll
                for (int j = 0; j < 4; ++j) { v[j] = v[j] - mean; s2 += (v[j].x * v[j].x + v[j].y * v[j].y) + (v[j].z * v[j].z + v[j].w * v[j].w); }
                const float rstd = 1.f / sqrtf(wave_sum(s2) * (1.f / D) + LN_EPS);
                GAS f32x4* orow = (GAS f32x4*)(outp + (size_t)m * D) + lane;
                GAS unsigned long long* o8 = (GAS unsigned long long*)(XN + (size_t)m * D) + lane;
#pragma unroll
                for (int j = 0; j < 4; ++j) { v[j] = v[j] * rstd * gv[j] + bv[j]; orow[64 * j] = v[j];
                    if (l + 1 < DEPTH && !I8_P1) o8[64 * j] = (unsigned long long)pk2(v[j].x, v[j].y) | ((unsigned long long)pk2(v[j].z, v[j].w) << 32); }
                if (l + 1 < DEPTH && I8_P1) quant_row(v, (signed char*)(ws + WS_XQ) + (size_t)m * D, (float*)(ws + WS_SX) + m, lane);
            }
            if (BOTH(pb + 7)) GRID_BAR();
        }
    }
#undef IN
#undef BOTH
}

extern "C" void kernel_launch(void* const* d_in, const int* in_sizes, int n_in, void* d_out, int out_size, void* d_ws, size_t ws_size, hipStream_t stream) {
    static int grid = 0;
    if (grid == 0) {
        if (n_in != 20 || in_sizes[0] != T * D || out_size != T * D || ws_size < WS_END) { fprintf(stderr, "kernel_launch: unexpected shapes / workspace (n_in %d, ws %zu, need %zu)\n", n_in, ws_size, (size_t)WS_END); grid = -1; return; }
        int dev = 0, cus = 0, per_cu = 0;
        if (hipGetDevice(&dev) != hipSuccess || hipDeviceGetAttribute(&cus, hipDeviceAttributeMultiprocessorCount, dev) != hipSuccess) { grid = -1; return; }
        if (hipFuncSetAttribute((const void*)mk_fwd, hipFuncAttributeMaxDynamicSharedMemorySize, LDS_BYTES) != hipSuccess) { fprintf(stderr, "kernel_launch: hipFuncSetAttribute failed\n"); grid = -1; return; }
        if (hipOccupancyMaxActiveBlocksPerMultiprocessor(&per_cu, (const void*)mk_fwd, NWAVES * 64, LDS_BYTES) != hipSuccess || per_cu < 1) fprintf(stderr, "kernel_launch: occupancy query reports %d\n", per_cu);
        (void)hipGetLastError();
        grid = cus;
    }
    if (grid < 0) return;
    (void)hipMemsetAsync((char*)d_ws + WS_CTL, 0, CTL_ZERO_BYTES, stream);
    Args a{};
    for (int i = 0; i < 20; ++i) a.in[i] = (const float*)d_in[i];
    a.out = (float*)d_out; a.ws = (unsigned char*)d_ws;
#if MK_ONE_LAUNCH
    a.ph_lo = 0; a.ph_hi = 1 + 8 * DEPTH;
    hipLaunchKernelGGL(mk_fwd, dim3(grid), dim3(NWAVES * 64), LDS_BYTES, stream, a);
#else
    for (int ph = 0; ph < 1 + 8 * DEPTH; ++ph) {
        a.ph_lo = ph; a.ph_hi = ph + 1;
        hipLaunchKernelGGL(mk_fwd, dim3(grid), dim3(NWAVES * 64), LDS_BYTES, stream, a);
    }
#endif
}
```

```cpp
#include <hip/hip_runtime.h>
#include <cstdio>
#include <cstdint>

#ifndef DIS_MASK
#define DIS_MASK 0
#endif
#define PH_EN(k) (((DIS_MASK) >> (k) & 1) == 0)
#ifndef EPI_TWICE_SEL
#define EPI_TWICE_SEL 0
#endif
#if EPI_TWICE_SEL
#define EPI_TWICE 1
#endif
#ifndef GEMM_SKEW_TICKS
#define GEMM_SKEW_TICKS 0
#endif
#ifndef I8_P1
#define I8_P1 1
#endif
#ifndef I8_P6
#define I8_P6 1
#endif
#ifndef REPEAT_MASK
#define REPEAT_MASK 0
#endif
#define REP(k) for (int rep_ = 0; rep_ < (((REPEAT_MASK) >> (k)) & 1) + 1; ++rep_)
#ifndef ATT_MASK
#define ATT_MASK 0
#endif
#define ATT_EN(k) (((ATT_MASK) >> (k) & 1) == 0)
#ifndef MK_ONE_LAUNCH
#define MK_ONE_LAUNCH 1
#endif

constexpr int BATCH = 16, SEQ = 4096, D = 1024, T = BATCH * SEQ, W = 512, INW = 6656, NE = 32, TOPK = 4, DFF = 1024, MEML = 256, MEMT = BATCH * MEML, DEPTH = 2;
constexpr int GATE0 = 7 * W;
constexpr int PP = GATE0;
constexpr float LN_EPS = 1e-5f, RMS_EPS = 1e-5f;
constexpr float DN_ALPHA = 1.4142135623730951f;
constexpr int NWAVES = 8;

constexpr size_t MiB = 1u << 20;
constexpr size_t WS_CTL = 0, CTL_ZERO_BYTES = 1 * MiB;
constexpr size_t WS_DUMP = 1 * MiB;
constexpr size_t WS_PERM = 2 * MiB;
constexpr size_t WS_SLOTW = 10 * MiB;
constexpr size_t WS_SX = 12 * MiB + 512 * 1024;
constexpr size_t WS_SWIN = 13 * MiB;
constexpr size_t WS_SWGU = 13 * MiB + 256 * 1024;
constexpr size_t WS_STATS = 12 * MiB;
constexpr size_t WS_SLOTPOS = 11 * MiB;
constexpr size_t WS_WIN = 16 * MiB;
constexpr size_t WS_WMEMKV = 42 * MiB;
constexpr size_t WS_WBR = 46 * MiB;
constexpr size_t WS_WOUT = 52 * MiB;
constexpr size_t WS_WGU = 56 * MiB;
constexpr size_t WS_WD = 312 * MiB;
constexpr size_t WS_MEMB = 440 * MiB;
constexpr size_t WS_MEMKV = 448 * MiB;
constexpr size_t WS_XN = 456 * MiB;
constexpr size_t WS_X1 = 584 * MiB;
constexpr size_t WS_BIG = 840 * MiB;
constexpr size_t WS_PROJ = WS_BIG;
constexpr size_t WS_G8 = WS_BIG + 448 * MiB;
constexpr size_t WS_Y = WS_BIG + 832 * MiB;
constexpr size_t WS_MERGED = WS_BIG + 1024 * MiB;
constexpr size_t WS_ACT = WS_BIG;
constexpr size_t WS_CONTRIB = WS_BIG + 528 * MiB;
constexpr size_t WS_MEMKV2 = WS_BIG + 1152 * MiB;
constexpr size_t WS_SXP = WS_MEMKV2 + 16 * MiB;
constexpr size_t WS_XQ = WS_BIG + 1088 * MiB;
constexpr size_t WS_END = WS_SXP + 8 * MiB;
static_assert(WS_CONTRIB + (size_t)528 * MiB <= WS_END && WS_MERGED + (size_t)T * D * 2 <= WS_END, "ws map");

constexpr int CW_TMO = 0, CW_CODE = 1;
constexpr int CW_BAR = 4096;
constexpr int CW_CNT = 32768;

constexpr int RING_OFF = 0, RING_BYTES = 132096;
constexpr int LDSCTL_OFF = RING_BYTES;
constexpr int LDS_BYTES = 163840;
constexpr int LW_BAR = 8;
constexpr int LW_TOFF = 64;
constexpr int LW_LCNT = 128;
constexpr int LW_RCNT = 192;
constexpr int LW_RBASE = 256;
constexpr int LW_RSLOT = 320, RSLOT_STRIDE = 256;

#define GAS __attribute__((address_space(1)))
#define LAS __attribute__((address_space(3)))
typedef unsigned short bf16;
typedef unsigned v4u __attribute__((ext_vector_type(4)));
typedef unsigned v2u __attribute__((ext_vector_type(2)));
typedef float f32x4 __attribute__((ext_vector_type(4)));
typedef float f32x2 __attribute__((ext_vector_type(2)));
typedef short bf16x8 __attribute__((ext_vector_type(8)));
typedef GAS unsigned gu32;
#define RLX_AGENT __ATOMIC_RELAXED, __HIP_MEMORY_SCOPE_AGENT
#define LDS_WAIT() asm volatile("s_waitcnt lgkmcnt(0)" ::: "memory")
#define VM_WAIT() asm volatile("s_waitcnt vmcnt(0)" ::: "memory")

__device__ __forceinline__ unsigned f2bf(float f) { unsigned u = __builtin_bit_cast(unsigned, f); return (u + 0x7fffu + ((u >> 16) & 1u)) >> 16; }
__device__ __forceinline__ unsigned pk2(float lo, float hi) { return f2bf(lo) | (f2bf(hi) << 16); }
__device__ __forceinline__ float bflo(unsigned w) { return __uint_as_float(w << 16); }
__device__ __forceinline__ float bfhi(unsigned w) { return __uint_as_float(w & 0xffff0000u); }
__device__ __forceinline__ float bf2f(bf16 b) { return __uint_as_float((unsigned)b << 16); }
__device__ __forceinline__ float fast_exp(float x) { return __builtin_amdgcn_exp2f(x * 1.4426950408889634f); }
__device__ __forceinline__ float fast_sigmoid(float x) { return __builtin_amdgcn_rcpf(1.0f + fast_exp(-x)); }

__device__ __forceinline__ int lane_opaque() { int l = (int)__builtin_amdgcn_mbcnt_hi(~0u, __builtin_amdgcn_mbcnt_lo(~0u, 0u)); asm volatile("" : "+v"(l)); return l; }
__device__ __forceinline__ int tid_opaque() { int t = threadIdx.x; asm volatile("" : "+v"(t)); return t; }
namespace pg8 {
#define PG8_LAS __attribute__((address_space(3)))
typedef unsigned short bf16_t;
typedef unsigned u32x4 __attribute__((ext_vector_type(4)));
typedef int i32x4 __attribute__((ext_vector_type(4)));
constexpr int BM = 256, BK = 64, HALF = 128, HTB = HALF * BK * 2, STAGE_BYTES = 8 * HTB, NXCD = 8, WGM = 8;
constexpr int EPI_BUF_OFF = 132096 + 4096, EPI_BUF_BYTES = 3072;

__host__ __device__ __forceinline__ int lds_byte(int r, int c) { const int st = (r >> 4) * 2 + (c >> 5), rr = r & 15, cc = c & 31, ob = rr * 64 + cc * 2; return st * 1024 + (ob ^ (((ob >> 9) & 1) << 5)); }
__host__ __device__ __forceinline__ void stage_rc(int b, int& R, int& C) { const int st = b / 1024, sb = b % 1024, swz = sb ^ (((sb >> 9) & 1) << 5); R = (st >> 1) * 16 + swz / 64; C = (st & 1) * 32 + (swz % 64) / 2; }
__host__ __device__ __forceinline__ int perm32(int rho) { const int n = rho >> 4, i = rho & 15; return 8 * (i >> 2) + 4 * n + (i & 3); }

struct Unit { int pm, pn, e, rt; };

__device__ __forceinline__ bool tile_order(long L, int nM, int nN, int& pm, int& pn) {
    const int nwg = nM * nN; if (L >= nwg) return false;
    int wgid = (int)L; { const int q = nwg / NXCD, r = nwg % NXCD, xcd = wgid % NXCD, off = wgid / NXCD; wgid = (xcd < r ? xcd * (q + 1) : r * (q + 1) + (xcd - r) * q) + off; }
    const int nig = WGM * nN, gid = wgid / nig, fm = gid * WGM, gsz = (nM - fm) < WGM ? (nM - fm) : WGM;
    const int w = wgid % nig;
    if (gsz == WGM) { pm = fm + (w % WGM); pn = w / WGM; } else { pm = fm + (w % gsz); pn = w / gsz; }
    return true;
}

__device__ __forceinline__ unsigned cvt_pk_bf16(float lo, float hi) { unsigned r; asm volatile("v_cvt_pk_bf16_f32 %0, %1, %2" : "=v"(r) : "v"(lo), "v"(hi)); return r; }

template <class Epi, class Sched, bool GATHER, bool ALIGN_EPI, bool I8 = false>
__device__ __forceinline__ void gemm_phase(PG8_LAS unsigned char* lds, const int K, const Sched& S, const Epi& E, unsigned* dump  ) {
    const int tid = tid_opaque();
    const int wid = __builtin_amdgcn_readfirstlane(tid >> 6), lane = tid & 63, wr = wid >> 2, wc = wid & 3, fr = lane & 15, fq = lane >> 4;
    int nt = K / BK; asm volatile("" : "+s"(nt));
    unsigned voffA[2], voffB[2]; int gR[2], gC[2];
#pragma unroll
    for (int i = 0; i < 2; ++i) { int R, C; stage_rc(tid * 16 + i * 8192, R, C); const int Rb = Epi::PERM ? ((R & ~31) + perm32(R & 31)) : R;
        voffA[i] = (unsigned)(R * K + C) * 2u; voffB[i] = (unsigned)(Rb * K + C) * 2u; gR[i] = R; gC[i] = C * 2; }
    const size_t kstep = (size_t)(BK * 2);
    const size_t hstep = (size_t)HALF * K * 2;
    const unsigned ldsw = (unsigned)wid * 1024u;
    const int aoff = lds_byte(wr * 64 + fr, fq * 8), boff = lds_byte(wc * 32 + fr, fq * 8);
#define PG8_SA(b, h) (((b) * 2 + (h)) * HTB)
#define PG8_SB(b, h) ((4 + (b) * 2 + (h)) * HTB)
#define PG8_STAGE(bufoff, gbase, voff) do { _Pragma("unroll") for (int _i = 0; _i < 2; ++_i) \
        __builtin_amdgcn_global_load_lds((const unsigned*)((const char*)(gbase) + (voff)[_i]), (PG8_LAS unsigned*)(lds + (bufoff) + ldsw + _i * 8192), 16, 0, 0); } while (0)
#define PG8_STAGE_A(bufoff, kptr, h, G) do { if constexpr (GATHER) { PG8_STAGE(bufoff, kptr, (G)[h]); } else { PG8_STAGE(bufoff, (kptr) + (h) * hstep, voffA); } } while (0)
#define PG8_LDA(dst, b, h) do { _Pragma("unroll") for (int m = 0; m < 4; ++m) _Pragma("unroll") for (int k = 0; k < 2; ++k) dst[m][k] = *(const PG8_LAS bf16x8*)(lds + PG8_SA(b, h) + aoff + m * 2048 + k * 1024); } while (0)
#define PG8_LDB(dst, b, h) do { _Pragma("unroll") for (int n = 0; n < 2; ++n) _Pragma("unroll") for (int k = 0; k < 2; ++k) dst[n][k] = *(const PG8_LAS bf16x8*)(lds + PG8_SB(b, h) + boff + n * 2048 + k * 1024); } while (0)
#define PG8_MMA(ai, bj, At, Bt) do { __builtin_amdgcn_s_setprio(1); _Pragma("unroll") for (int m = 0; m < 4; ++m) _Pragma("unroll") for (int n = 0; n < 2; ++n) _Pragma("unroll") for (int k = 0; k < 2; ++k) { \
        if constexpr (I8) acc[ai][bj][m][n] = __builtin_bit_cast(f32x4, __builtin_amdgcn_mfma_i32_16x16x64_i8(__builtin_bit_cast(i32x4, Bt[n][k]), __builtin_bit_cast(i32x4, At[m][k]), __builtin_bit_cast(i32x4, acc[ai][bj][m][n]), 0, 0, 0)); \
        else acc[ai][bj][m][n] = __builtin_amdgcn_mfma_f32_16x16x32_bf16(Bt[n][k], At[m][k], acc[ai][bj][m][n], 0, 0, 0); } __builtin_amdgcn_s_setprio(0); } while (0)
#define PG8_WAIT_V(n) asm volatile("s_waitcnt vmcnt(" #n ")" ::: "memory")
#define PG8_WAIT_V8R(t) asm volatile("s_cmp_lg_u32 %0, 0\n\ts_cbranch_scc1 1f\n\ts_waitcnt vmcnt(%1)\n\ts_branch 2f\n1:\n\ts_waitcnt vmcnt(8)\n2:" :: "s"(t), "n"(8 + Epi::NSTORES) : "memory", "scc")
#define PG8_WAIT_L(n) asm volatile("s_waitcnt lgkmcnt(" #n ")" ::: "memory")
#define PG8_BAR __builtin_amdgcn_s_barrier()
#define PG8_SCHED __builtin_amdgcn_sched_barrier(0)
    Unit cur, nxt; int ui = 0;
    if (!S.next(0, cur)) return;
#if GEMM_SKEW_TICKS
    { const unsigned long long t0_ = __builtin_amdgcn_s_memrealtime(); const unsigned long long want_ = (unsigned long long)((blockIdx.x >> 3) & 7) * GEMM_SKEW_TICKS;
      while (__builtin_amdgcn_s_memrealtime() - t0_ < want_) __builtin_amdgcn_s_sleep(8); }
#endif
    f32x4 acc[2][2][4][2];
#pragma unroll
    for (int a = 0; a < 2; ++a)
#pragma unroll
        for (int b = 0; b < 2; ++b)
#pragma unroll
            for (int m = 0; m < 4; ++m)
#pragma unroll
                for (int n = 0; n < 2; ++n) acc[a][b][m][n] = (f32x4){0.f, 0.f, 0.f, 0.f};
    bf16x8 At[4][2], B0[2][2], B1[2][2];
    unsigned cG[2][2] = {{0u, 0u}, {0u, 0u}}, nG[2][2] = {{0u, 0u}, {0u, 0u}}, sG[2][2] = {{0u, 0u}, {0u, 0u}};
    if constexpr (GATHER) S.gather(cur, gR, gC, K, cG);
    if constexpr (GATHER) asm volatile("" : "+v"(cG[0][0]), "+v"(cG[0][1]), "+v"(cG[1][0]), "+v"(cG[1][1]));
    const char* cA = S.a_base(cur); const char* cB = S.b_base(cur);
    PG8_STAGE(PG8_SB(0, 0), cB, voffB); PG8_STAGE(PG8_SB(0, 1), cB + hstep, voffB); PG8_STAGE_A(PG8_SA(0, 0), cA, 0, cG); PG8_STAGE_A(PG8_SA(0, 1), cA, 1, cG);
    if (wr == 1) PG8_BAR;
    PG8_WAIT_V(2); PG8_BAR;
    PG8_STAGE(PG8_SB(1, 0), cB + kstep, voffB); PG8_STAGE_A(PG8_SA(1, 0), cA + kstep, 0, cG); PG8_STAGE(PG8_SB(1, 1), cB + hstep + kstep, voffB);
    PG8_WAIT_V(6); PG8_BAR;
    if constexpr (Epi::NSTORES > 0) {
        unsigned* dp = dump + (size_t)blockIdx.x * 512 + tid;
#pragma unroll
        for (int i = 0; i < Epi::NSTORES; ++i) asm volatile("global_store_dword %0, %1, off" :: "v"(dp), "v"(i) : "memory"); }
    for (;;) {
        const bool has_next = S.next(ui + 1, nxt);
        const char* nA = has_next ? S.a_base(nxt) : cA; const char* nB = has_next ? S.b_base(nxt) : cB;
        const PG8_LAS float* eb = (const PG8_LAS float*)(lds + EPI_BUF_OFF + (ui & 1) * EPI_BUF_BYTES);
        if constexpr (Epi::PREF) E.prefetch(cur, (PG8_LAS unsigned char*)eb, wid);
        if constexpr (GATHER) { if (has_next && wid == 3) S.stage_idx(nxt, lds + 2 * STAGE_BYTES / 2, lane); }
#pragma unroll 1
        for (int t = 0; t < nt; t += 2) {
            const bool last = (t == nt - 2);
            const char* a1 = cA + (size_t)(t + 1) * kstep;
            const char* a2 = last ? nA : cA + (size_t)(t + 2) * kstep; const char* b2 = last ? nB : cB + (size_t)(t + 2) * kstep;
            const char* a3 = a2 + kstep; const char* b3 = b2 + kstep;
            if constexpr (GATHER) {
                if (last) { if (has_next) S.gather_lds(nxt, gR, gC, K, nG, (const PG8_LAS int*)(lds + 2 * STAGE_BYTES / 2)); else { nG[0][0] = cG[0][0]; nG[0][1] = cG[0][1]; nG[1][0] = cG[1][0]; nG[1][1] = cG[1][1]; }
                    asm volatile("" : "+v"(nG[0][0]), "+v"(nG[0][1]), "+v"(nG[1][0]), "+v"(nG[1][1])); }
                sG[0][0] = last ? nG[0][0] : cG[0][0]; sG[0][1] = last ? nG[0][1] : cG[0][1]; sG[1][0] = last ? nG[1][0] : cG[1][0]; sG[1][1] = last ? nG[1][1] : cG[1][1]; }
            PG8_LDB(B0, 0, 0); PG8_LDB(B1, 0, 1); PG8_SCHED; PG8_LDA(At, 0, 0); PG8_STAGE_A(PG8_SA(1, 1), a1, 1, cG);
            PG8_WAIT_V8R(t); PG8_WAIT_L(0); PG8_BAR; PG8_MMA(0, 0, At, B0); PG8_MMA(0, 1, At, B1); PG8_BAR; PG8_SCHED;
            PG8_LDA(At, 0, 1); PG8_STAGE(PG8_SB(0, 0), b2, voffB); PG8_STAGE(PG8_SB(0, 1), b2 + hstep, voffB); PG8_STAGE_A(PG8_SA(0, 0), a2, 0, sG);
            PG8_WAIT_V8R(t); PG8_WAIT_L(0); PG8_BAR; PG8_MMA(1, 0, At, B0); PG8_MMA(1, 1, At, B1); PG8_BAR; PG8_SCHED;
            PG8_LDB(B0, 1, 0); PG8_LDB(B1, 1, 1); PG8_SCHED; PG8_LDA(At, 1, 0); PG8_STAGE_A(PG8_SA(0, 1), a2, 1, sG);
            PG8_WAIT_V(8); PG8_WAIT_L(0); PG8_BAR; PG8_MMA(0, 0, At, B0); PG8_MMA(0, 1, At, B1); PG8_BAR; PG8_SCHED;
            PG8_LDA(At, 1, 1); PG8_STAGE(PG8_SB(1, 0), b3, voffB); PG8_STAGE(PG8_SB(1, 1), b3 + hstep, voffB); PG8_STAGE_A(PG8_SA(1, 0), a3, 0, sG);
            PG8_WAIT_V(8); PG8_WAIT_L(0); PG8_BAR; PG8_MMA(1, 0, At, B0); PG8_MMA(1, 1, At, B1); PG8_BAR; PG8_SCHED;
            if constexpr (Epi::HAS_MID) { if (t == 6 || t == 14) E.mid(acc, cur, wr, wc, fr, fq, (t + 2) >> 3); }
        }
        if constexpr (ALIGN_EPI) { if (wr == 0) PG8_BAR; }
        E(acc, cur, wr, wc, fr, fq, eb);
#if defined(EPI_TWICE)
        if constexpr (Epi::TWICE) { asm volatile("" ::: "memory"); E(acc, cur, wr, wc, fr, fq, eb); }
#endif
        if constexpr (Epi::DRAIN_AFTER) __builtin_amdgcn_s_waitcnt(0x0F70);
        if (!has_next) break;
#pragma unroll
        for (int a = 0; a < 2; ++a)
#pragma unroll
            for (int b = 0; b < 2; ++b)
#pragma unroll
                for (int m = 0; m < 4; ++m)
#pragma unroll
                    for (int n = 0; n < 2; ++n) acc[a][b][m][n] = (f32x4){0.f, 0.f, 0.f, 0.f};
        cur = nxt; cA = nA; cB = nB; ++ui;
        if constexpr (GATHER) { cG[0][0] = nG[0][0]; cG[0][1] = nG[0][1]; cG[1][0] = nG[1][0]; cG[1][1] = nG[1][1]; }
        if constexpr (ALIGN_EPI) { if (wr == 1) PG8_BAR; }
    }
    PG8_WAIT_V(0);
    if constexpr (!ALIGN_EPI) { if (wr == 0) PG8_BAR; }
    PG8_BAR;
#undef PG8_SA
#undef PG8_SB
#undef PG8_STAGE
#undef PG8_STAGE_A
#undef PG8_LDA
#undef PG8_LDB
#undef PG8_MMA
#undef PG8_WAIT_V
#undef PG8_WAIT_V8R
#undef PG8_WAIT_L
#undef PG8_BAR
#undef PG8_SCHED
}

struct DenseOrder {
    const char* A; const char* Bt; int nM, nN, G, c, K;
    __device__ __forceinline__ bool next(int i, Unit& u) const { u.e = 0; u.rt = 0; return tile_order((long)i * G + c, nM, nN, u.pm, u.pn); }
    __device__ __forceinline__ const char* a_base(const Unit& u) const { return A + (size_t)u.pm * BM * K * 2; }
    __device__ __forceinline__ const char* b_base(const Unit& u) const { return Bt + (size_t)u.pn * BM * K * 2; }
};
struct PanelOrder {
    const char* A; const char* Bt; int nM, nN, G, c, v, K; bool own;
    __device__ __forceinline__ bool next(int i, Unit& u) const { u.e = 0; u.rt = 0; if (own) { u.pm = v; u.pn = i; return i < nN; } return tile_order((long)i * G + c, nM, nN, u.pm, u.pn); }
    __device__ __forceinline__ const char* a_base(const Unit& u) const { return A + (size_t)u.pm * BM * K * 2; }
    __device__ __forceinline__ const char* b_base(const Unit& u) const { return Bt + (size_t)u.pn * BM * K * 2; }
};
struct MoeOrder {
    const char* A; const char* Wt; int nN, NT, G, c, K; size_t wstride;
    const PG8_LAS int* toff; const PG8_LAS int* lcnt; const int* perm;
    __device__ __forceinline__ bool next(int i, Unit& u) const {
        if (!tile_order((long)i * G + c, NT, nN, u.pm, u.pn)) return false;
        const int j = (int)__builtin_amdgcn_mbcnt_lo(~0u, 0u);
        const int e = __builtin_popcountll(__builtin_amdgcn_ballot_w64(j >= 1 && j < NE && toff[j] <= u.pm));
        u.e = e; u.rt = u.pm - toff[e]; return true;
    }
    __device__ __forceinline__ const char* a_base(const Unit& u) const { return A; }
    __device__ __forceinline__ const char* a_dense(const Unit& u) const { return A + (size_t)u.pm * BM * K * 2; }
    __device__ __forceinline__ const char* b_base(const Unit& u) const { return Wt + (size_t)u.e * wstride + (size_t)u.pn * BM * K * 2; }
    __device__ __forceinline__ void stage_idx(const Unit& u, PG8_LAS unsigned char* dst, int lane) const {
        const unsigned off = ((unsigned)(u.e * T + u.rt * BM) + (unsigned)lane_opaque() * 4u) * 4u;
        __builtin_amdgcn_global_load_lds((const unsigned*)((const char*)perm + off), (PG8_LAS unsigned*)dst, 16, 0, 0); }
    __device__ __forceinline__ void gather_lds(const Unit& u, const int (&gR)[2], const int (&gC)[2], int K_, unsigned (&Gv)[2][2], const PG8_LAS int* idx) const {
        const int n = lcnt[u.e] - u.rt * BM;
#pragma unroll
        for (int h = 0; h < 2; ++h)
#pragma unroll
            for (int i = 0; i < 2; ++i) { const int r = h * HALF + gR[i]; const int tok = (r < n) ? (idx[r] >> 2) : 0; Gv[h][i] = (unsigned)tok * (unsigned)(K_ * 2) + (unsigned)gC[i]; }
    }
    __device__ __forceinline__ void gather(const Unit& u, const int (&gR)[2], const int (&gC)[2], int K_, unsigned (&Gv)[2][2]) const {
        const int n = lcnt[u.e] - u.rt * BM; const int* p = perm + (size_t)u.e * T + u.rt * BM;
#pragma unroll
        for (int h = 0; h < 2; ++h)
#pragma unroll
            for (int i = 0; i < 2; ++i) { const int r = h * HALF + gR[i]; const int tok = (r < n) ? (p[r] >> 2) : 0; Gv[h][i] = (unsigned)tok * (unsigned)(K_ * 2) + (unsigned)gC[i]; }
    }
};
struct MoeDenseOrder : MoeOrder {
    __device__ __forceinline__ const char* a_base(const Unit& u) const { return a_dense(u); }
};

template <bool Q8> struct EpiProjT {
    static constexpr bool PERM = true, DRAIN_AFTER = false, TWICE = (EPI_TWICE_SEL == 1), HAS_MID = false; static constexpr int NSTORES = TWICE ? 0 : 16;
    static constexpr bool PREF = Q8;
    bf16_t* O; int ldc; const float* bias; int act_from; int qscale_upto;
    unsigned char* G8;
    const float* sxr; const float* swc;
    __device__ __forceinline__ void prefetch(const Unit& u, PG8_LAS unsigned char* buf, int wid) const {
        const int colt = u.pn * BM, ln4 = lane_opaque() * 4;
        if (wid == 0) { if (colt >= act_from) __builtin_amdgcn_global_load_lds((const unsigned*)(bias + (colt - act_from) + ln4), (PG8_LAS unsigned*)buf, 16, 0, 0); }
        else if (wid == 1) __builtin_amdgcn_global_load_lds((const unsigned*)(swc + colt + ln4), (PG8_LAS unsigned*)(buf + 1024), 16, 0, 0);
        else if (wid == 2) __builtin_amdgcn_global_load_lds((const unsigned*)(sxr + u.pm * BM + ln4), (PG8_LAS unsigned*)(buf + 2048), 16, 0, 0); }
    __device__ __forceinline__ void operator()(const f32x4 (&acc)[2][2][4][2], const Unit& u, int wr, int wc, int fr, int fq, const PG8_LAS float* eb) const {
        const int row0 = u.pm * BM + wr * 64 + fr, colt = u.pn * BM, col0 = colt + wc * 32 + 8 * fq;
        const bool gate = colt >= act_from;
        float qs = 1.0f;
        if (colt < qscale_upto) { const int seg = colt / W; qs = (seg == 0 || seg == 3) ? 0.125f * 1.4426950408889634f : (seg == 6 ? 0.08838834764831845f * 1.4426950408889634f : 1.0f); }
        f32x4 bv[2][2], sw[2][2]; float rsc[2][4];
#pragma unroll
        for (int bj = 0; bj < 2; ++bj)
#pragma unroll
            for (int n = 0; n < 2; ++n) { const int cl = wc * 32 + 8 * fq + bj * HALF + 4 * n;
                if constexpr (Q8) { bv[bj][n] = gate ? *(const PG8_LAS f32x4*)(eb + cl) : (f32x4){0.f, 0.f, 0.f, 0.f}; sw[bj][n] = *(const PG8_LAS f32x4*)(eb + 256 + cl); }
                else { bv[bj][n] = gate ? *(const f32x4*)(bias + (col0 - act_from) + bj * HALF + 4 * n) : (f32x4){0.f, 0.f, 0.f, 0.f}; sw[bj][n] = (f32x4){1.f, 1.f, 1.f, 1.f}; } }
#pragma unroll
        for (int ai = 0; ai < 2; ++ai)
#pragma unroll
            for (int m = 0; m < 4; ++m) rsc[ai][m] = Q8 ? eb[512 + wr * 64 + fr + ai * HALF + m * 16] * qs : qs;
        if (gate) {
#pragma unroll
            for (int bj = 0; bj < 2; ++bj)
#pragma unroll
                for (int n = 0; n < 2; ++n) { bv[bj][n] = bv[bj][n] * -1.4426950408889634f; sw[bj][n] = sw[bj][n] * -1.4426950408889634f; } }
#pragma unroll
        for (int ai = 0; ai < 2; ++ai)
#pragma unroll
            for (int m = 0; m < 4; ++m) { bf16_t* rowp = O + (size_t)(row0 + ai * HALF + m * 16) * ldc + col0;
                const float rs = rsc[ai][m]; const f32x2 rs2 = (f32x2){rs, rs};
#pragma unroll
                for (int bj = 0; bj < 2; ++bj) {
                    f32x2 t[2][2];
#pragma unroll
                    for (int n = 0; n < 2; ++n) { const f32x4 a = acc[ai][bj][m][n];
                        if constexpr (Q8) { const i32x4 ia = __builtin_bit_cast(i32x4, a); t[n][0] = (f32x2){(float)ia[0], (float)ia[1]} * rs2; t[n][1] = (f32x2){(float)ia[2], (float)ia[3]} * rs2; }
                        else { t[n][0] = (f32x2){a[0], a[1]} * rs2; t[n][1] = (f32x2){a[2], a[3]} * rs2; } }
                    if (gate) {
                        unsigned g[2] = {0u, 0u};
#pragma unroll
                        for (int n = 0; n < 2; ++n)
#pragma unroll
                            for (int p = 0; p < 2; ++p) {
                                f32x2 e = t[n][p] * (f32x2){sw[bj][n][2 * p], sw[bj][n][2 * p + 1]} + (f32x2){bv[bj][n][2 * p], bv[bj][n][2 * p + 1]};
                                e.x = __builtin_amdgcn_exp2f(e.x); e.y = __builtin_amdgcn_exp2f(e.y);
                                e = e * (f32x2){1.0f / 255.0f, 1.0f / 255.0f} + (f32x2){1.0f / 255.0f, 1.0f / 255.0f};
                                g[n] = __builtin_amdgcn_cvt_pk_u8_f32(__builtin_rintf(__builtin_amdgcn_rcpf(e.x)), 2 * p, g[n]);
                                g[n] = __builtin_amdgcn_cvt_pk_u8_f32(__builtin_rintf(__builtin_amdgcn_rcpf(e.y)), 2 * p + 1, g[n]); }
                        *(v2u*)(G8 + (size_t)(row0 + ai * HALF + m * 16) * (3 * D) + (col0 - act_from) + bj * HALF) = (v2u){g[0], g[1]};
                        continue; }
                    u32x4 w;
                    { const f32x2 o0 = t[0][0] * (f32x2){sw[bj][0][0], sw[bj][0][1]}, o1 = t[0][1] * (f32x2){sw[bj][0][2], sw[bj][0][3]}, o2 = t[1][0] * (f32x2){sw[bj][1][0], sw[bj][1][1]}, o3 = t[1][1] * (f32x2){sw[bj][1][2], sw[bj][1][3]};
                      w.x = cvt_pk_bf16(o0.x, o0.y); w.y = cvt_pk_bf16(o1.x, o1.y); w.z = cvt_pk_bf16(o2.x, o2.y); w.w = cvt_pk_bf16(o3.x, o3.y); }
                    __builtin_nontemporal_store(w, (u32x4*)(rowp + bj * HALF)); } }
    }
};
typedef EpiProjT<false> EpiProj; typedef EpiProjT<true> EpiProjQ;
struct EpiBranch {
    static constexpr bool PERM = true, DRAIN_AFTER = false, TWICE = false, HAS_MID = true, PREF = false; static constexpr int NSTORES = 16;
    const unsigned char* G8; bf16_t* Mg;
    static __device__ __forceinline__ float ub(unsigned w, int i) { return (float)((w >> (8 * i)) & 0xffu); }
    __device__ __forceinline__ void mid(f32x4 (&acc)[2][2][4][2], const Unit& u, int wr, int wc, int fr, int fq, int seg  ) const {
        asm volatile("" : "+v"(fr), "+v"(fq));
        const int row0 = u.pm * BM + wr * 64 + fr, col0 = u.pn * BM + wc * 32 + 8 * fq;
        v2u gn[2][4][2], gd[2][4][2];
#pragma unroll
        for (int ai = 0; ai < 2; ++ai)
#pragma unroll
            for (int m = 0; m < 4; ++m) { const unsigned char* gp = G8 + (size_t)(row0 + ai * HALF + m * 16) * (3 * D) + (seg - 1) * D + col0;
#pragma unroll
                for (int bj = 0; bj < 2; ++bj) { gn[ai][m][bj] = *(const v2u*)(gp + bj * HALF); gd[ai][m][bj] = *(const v2u*)(gp + D + bj * HALF); } }
        asm volatile("" :: "v"(gn[0][0][0]), "v"(gn[0][0][1]), "v"(gn[0][1][0]), "v"(gn[0][1][1]), "v"(gn[0][2][0]), "v"(gn[0][2][1]), "v"(gn[0][3][0]), "v"(gn[0][3][1]),
                           "v"(gn[1][0][0]), "v"(gn[1][0][1]), "v"(gn[1][1][0]), "v"(gn[1][1][1]), "v"(gn[1][2][0]), "v"(gn[1][2][1]), "v"(gn[1][3][0]), "v"(gn[1][3][1]));
        asm volatile("" :: "v"(gd[0][0][0]), "v"(gd[0][0][1]), "v"(gd[0][1][0]), "v"(gd[0][1][1]), "v"(gd[0][2][0]), "v"(gd[0][2][1]), "v"(gd[0][3][0]), "v"(gd[0][3][1]),
                           "v"(gd[1][0][0]), "v"(gd[1][0][1]), "v"(gd[1][1][0]), "v"(gd[1][1][1]), "v"(gd[1][2][0]), "v"(gd[1][2][1]), "v"(gd[1][3][0]), "v"(gd[1][3][1]));
#pragma unroll
        for (int ai = 0; ai < 2; ++ai)
#pragma unroll
            for (int m = 0; m < 4; ++m)
#pragma unroll
                for (int bj = 0; bj < 2; ++bj) { const v2u n_ = gn[ai][m][bj], d_ = gd[ai][m][bj];
                    f32x4& a0 = acc[ai][bj][m][0]; f32x4& a1 = acc[ai][bj][m][1];
#pragma unroll
                    for (int j = 0; j < 4; ++j) { a0[j] *= ub(n_.x, j) * __builtin_amdgcn_rcpf(__builtin_fmaxf(ub(d_.x, j), 1.0f)); a1[j] *= ub(n_.y, j) * __builtin_amdgcn_rcpf(__builtin_fmaxf(ub(d_.y, j), 1.0f)); } }
    }
    __device__ __forceinline__ void operator()(const f32x4 (&acc)[2][2][4][2], const Unit& u, int wr, int wc, int fr, int fq, const PG8_LAS float* eb) const {
        const int row0 = u.pm * BM + wr * 64 + fr, col0 = u.pn * BM + wc * 32 + 8 * fq;
        v2u gl[2][4][2];
#pragma unroll
        for (int ai = 0; ai < 2; ++ai)
#pragma unroll
            for (int m = 0; m < 4; ++m) { const unsigned char* gp = G8 + (size_t)(row0 + ai * HALF + m * 16) * (3 * D) + 2 * D + col0;
#pragma unroll
                for (int bj = 0; bj < 2; ++bj) gl[ai][m][bj] = *(const v2u*)(gp + bj * HALF); }
        asm volatile("" :: "v"(gl[0][0][0]), "v"(gl[0][0][1]), "v"(gl[0][1][0]), "v"(gl[0][1][1]), "v"(gl[0][2][0]), "v"(gl[0][2][1]), "v"(gl[0][3][0]), "v"(gl[0][3][1]),
                           "v"(gl[1][0][0]), "v"(gl[1][0][1]), "v"(gl[1][1][0]), "v"(gl[1][1][1]), "v"(gl[1][2][0]), "v"(gl[1][2][1]), "v"(gl[1][3][0]), "v"(gl[1][3][1]));
#pragma unroll
        for (int ai = 0; ai < 2; ++ai)
#pragma unroll
            for (int m = 0; m < 4; ++m) { const size_t row = (size_t)(row0 + ai * HALF + m * 16);
                bf16_t* mp = Mg + row * D + col0;
#pragma unroll
                for (int bj = 0; bj < 2; ++bj) {
                    const v2u g = gl[ai][m][bj]; const f32x4 a0 = acc[ai][bj][m][0], a1 = acc[ai][bj][m][1];
                    float r0[4], r1[4];
#pragma unroll
                    for (int j = 0; j < 4; ++j) { r0[j] = __builtin_fmaxf(ub(g.x, j), 1.0f) * (1.0f / 255.0f) * a0[j]; r1[j] = __builtin_fmaxf(ub(g.y, j), 1.0f) * (1.0f / 255.0f) * a1[j]; }
                    u32x4 w; w.x = cvt_pk_bf16(r0[0], r0[1]); w.y = cvt_pk_bf16(r0[2], r0[3]); w.z = cvt_pk_bf16(r1[0], r1[1]); w.w = cvt_pk_bf16(r1[2], r1[3]);
                    *(u32x4*)(mp + bj * HALF) = w; } }
    }
};
struct EpiOut {
    static constexpr bool PERM = false, DRAIN_AFTER = false, TWICE = (EPI_TWICE_SEL == 4), HAS_MID = false, PREF = false; static constexpr int NSTORES = TWICE ? 0 : 32;
    const float* X; float* V1;
    __device__ __forceinline__ void operator()(const f32x4 (&acc)[2][2][4][2], const Unit& u, int wr, int wc, int fr, int fq, const PG8_LAS float* eb) const {
        const int row0 = u.pm * BM + wr * 64 + fr, col0 = u.pn * BM + wc * 32 + 4 * fq;
#pragma unroll
        for (int ai = 0; ai < 2; ++ai)
#pragma unroll
            for (int m = 0; m < 4; ++m) { const size_t off = (size_t)(row0 + ai * HALF + m * 16) * D + col0;
#pragma unroll
                for (int bj = 0; bj < 2; ++bj)
#pragma unroll
                    for (int n = 0; n < 2; ++n) { const f32x4 xv = *(const f32x4*)(X + off + bj * HALF + n * 16); *(f32x4*)(V1 + off + bj * HALF + n * 16) = xv * DN_ALPHA + acc[ai][bj][m][n]; } }
    }
};
template <bool Q8> struct EpiGateUpT {
    static constexpr bool PERM = true, DRAIN_AFTER = false, TWICE = (EPI_TWICE_SEL == 6), HAS_MID = false, PREF = Q8; static constexpr int NSTORES = TWICE ? 0 : 8;
    bf16_t* Act; const float* bgu;
    const float* sxp; const float* swr;
    __device__ __forceinline__ void prefetch(const Unit& u, PG8_LAS unsigned char* buf, int wid) const {
        const int ln = lane_opaque();
        if (wid == 0) __builtin_amdgcn_global_load_lds((const unsigned*)(bgu + (size_t)u.e * 2 * DFF + (ln >> 5) * DFF + u.pn * HALF + (ln & 31) * 4), (PG8_LAS unsigned*)buf, 16, 0, 0);
        else if (wid == 1) __builtin_amdgcn_global_load_lds((const unsigned*)(swr + (size_t)u.e * 2 * DFF + u.pn * BM + ln * 4), (PG8_LAS unsigned*)(buf + 1024), 16, 0, 0);
        else if (wid == 2) __builtin_amdgcn_global_load_lds((const unsigned*)(sxp + (size_t)u.e * T + u.rt * BM + ln * 4), (PG8_LAS unsigned*)(buf + 2048), 16, 0, 0); }
    __device__ __forceinline__ void operator()(const f32x4 (&acc)[2][2][4][2], const Unit& u, int wr, int wc, int fr, int fq, const PG8_LAS float* eb) const {
        const int row0 = u.pm * BM + wr * 64 + fr, c0 = u.pn * HALF + wc * 32 + 8 * fq;
        f32x4 bg0, bg1, bu0, bu1, sg0 = (f32x4){1.f, 1.f, 1.f, 1.f}, sg1 = sg0, su0 = sg0, su1 = sg0;
        float rsc[2][4];
        if constexpr (Q8) { const PG8_LAS float* lp = eb + wc * 32 + 8 * fq;
            bg0 = *(const PG8_LAS f32x4*)(lp); bg1 = *(const PG8_LAS f32x4*)(lp + 4); bu0 = *(const PG8_LAS f32x4*)(lp + HALF); bu1 = *(const PG8_LAS f32x4*)(lp + HALF + 4);
            sg0 = *(const PG8_LAS f32x4*)(lp + 256); sg1 = *(const PG8_LAS f32x4*)(lp + 260); su0 = *(const PG8_LAS f32x4*)(lp + 256 + HALF); su1 = *(const PG8_LAS f32x4*)(lp + 260 + HALF); }
        else { const float* bg = bgu + (size_t)u.e * 2 * DFF + c0; bg0 = *(const f32x4*)(bg); bg1 = *(const f32x4*)(bg + 4); bu0 = *(const f32x4*)(bg + DFF); bu1 = *(const f32x4*)(bg + DFF + 4); }
#pragma unroll
        for (int ai = 0; ai < 2; ++ai)
#pragma unroll
            for (int m = 0; m < 4; ++m) rsc[ai][m] = Q8 ? eb[512 + wr * 64 + fr + ai * HALF + m * 16] : 1.0f;
        const f32x4 bgv[2] = {bg0, bg1}, buv[2] = {bu0, bu1}, sgv[2] = {sg0, sg1}, suv[2] = {su0, su1};
#pragma unroll
        for (int ai = 0; ai < 2; ++ai)
#pragma unroll
            for (int m = 0; m < 4; ++m) {
                const float rs = rsc[ai][m]; const f32x2 rs2 = (f32x2){rs, rs};
                unsigned wv[4];
#pragma unroll
                for (int h = 0; h < 2; ++h) { const f32x4 ga4 = acc[ai][0][m][h], ua4 = acc[ai][1][m][h];
#pragma unroll
                    for (int p = 0; p < 2; ++p) {
                        f32x2 g, uu;
                        if constexpr (Q8) { const i32x4 gi = __builtin_bit_cast(i32x4, ga4), ui = __builtin_bit_cast(i32x4, ua4);
                            g = (f32x2){(float)gi[2 * p], (float)gi[2 * p + 1]} * rs2; uu = (f32x2){(float)ui[2 * p], (float)ui[2 * p + 1]} * rs2; }
                        else { g = (f32x2){ga4[2 * p], ga4[2 * p + 1]}; uu = (f32x2){ua4[2 * p], ua4[2 * p + 1]}; }
                        g = g * (f32x2){sgv[h][2 * p], sgv[h][2 * p + 1]} + (f32x2){bgv[h][2 * p], bgv[h][2 * p + 1]};
                        uu = uu * (f32x2){suv[h][2 * p], suv[h][2 * p + 1]} + (f32x2){buv[h][2 * p], buv[h][2 * p + 1]};
                        g.x = __builtin_fminf(g.x, 7.0f); g.y = __builtin_fminf(g.y, 7.0f);
                        uu.x = __builtin_fminf(__builtin_fmaxf(uu.x, -7.0f), 7.0f); uu.y = __builtin_fminf(__builtin_fmaxf(uu.y, -7.0f), 7.0f);
                        f32x2 e = g * (f32x2){-1.702f * 1.4426950408889634f, -1.702f * 1.4426950408889634f};
                        e.x = __builtin_amdgcn_exp2f(e.x); e.y = __builtin_amdgcn_exp2f(e.y);
                        e = e + (f32x2){1.0f, 1.0f};
                        e.x = __builtin_amdgcn_rcpf(e.x); e.y = __builtin_amdgcn_rcpf(e.y);
                        const f32x2 o = (uu + (f32x2){1.0f, 1.0f}) * (g * e);
                        wv[2 * h + p] = cvt_pk_bf16(o.x, o.y); } }
                *(u32x4*)(Act + (size_t)(row0 + ai * HALF + m * 16) * DFF + c0) = (u32x4){wv[0], wv[1], wv[2], wv[3]}; }
    }
};
typedef EpiGateUpT<false> EpiGateUp; typedef EpiGateUpT<true> EpiGateUpQ;
struct EpiDown {
    static constexpr bool PERM = true, DRAIN_AFTER = false, TWICE = (EPI_TWICE_SEL == 7), HAS_MID = false, PREF = true; static constexpr int NSTORES = TWICE ? 0 : 16;
    bf16_t* C; const float* bd;
    __device__ __forceinline__ void prefetch(const Unit& u, PG8_LAS unsigned char* buf, int wid) const {
        if (wid == 0) __builtin_amdgcn_global_load_lds((const unsigned*)(bd + (size_t)u.e * D + u.pn * BM + lane_opaque() * 4), (PG8_LAS unsigned*)buf, 16, 0, 0); }
    __device__ __forceinline__ void operator()(const f32x4 (&acc)[2][2][4][2], const Unit& u, int wr, int wc, int fr, int fq, const PG8_LAS float* eb) const {
        const int row0 = u.pm * BM + wr * 64 + fr, col0 = u.pn * BM + wc * 32 + 8 * fq;
        f32x4 bv[2][2];
#pragma unroll
        for (int bj = 0; bj < 2; ++bj)
#pragma unroll
            for (int nn = 0; nn < 2; ++nn) bv[bj][nn] = *(const PG8_LAS f32x4*)(eb + wc * 32 + 8 * fq + bj * HALF + 4 * nn);
#pragma unroll
        for (int ai = 0; ai < 2; ++ai)
#pragma unroll
            for (int m = 0; m < 4; ++m) { bf16_t* rowp = C + (size_t)(row0 + ai * HALF + m * 16) * D + col0;
#pragma unroll
                for (int bj = 0; bj < 2; ++bj) { const f32x4 v0 = acc[ai][bj][m][0] + bv[bj][0], v1 = acc[ai][bj][m][1] + bv[bj][1];
                    u32x4 w; w.x = cvt_pk_bf16(v0[0], v0[1]); w.y = cvt_pk_bf16(v0[2], v0[3]); w.z = cvt_pk_bf16(v1[0], v1[1]); w.w = cvt_pk_bf16(v1[2], v1[3]);
                    *(u32x4*)(rowp + bj * HALF) = w; } }
    }
};
}

#define XB_TMO      128
#define XB_XCNT(j)  (256  + 64 * (j))
#define XB_XSUB(j)  (1280 + 64 * (j))
#define XB_XGEN(j)  (2304 + 64 * (j))
#define XB_TOP      3328
#define XB_TOPGEN   3392
#define XCD_BAR_WORDS 3456
#define XB_SPIN_CAP (1u << 18)
__device__ __forceinline__ unsigned xb_ld(unsigned* p)              { return __hip_atomic_load(p, __ATOMIC_RELAXED, __HIP_MEMORY_SCOPE_AGENT); }
__device__ __forceinline__ unsigned xb_add(unsigned* p, unsigned v) { return __hip_atomic_fetch_add(p, v, __ATOMIC_RELAXED, __HIP_MEMORY_SCOPE_AGENT); }
__device__ __forceinline__ unsigned xb_xcc_id() { return (unsigned)__builtin_amdgcn_s_getreg((3 << 11) | 20) & 0xFu; }
#define XB_SPIN(cond, bar) do { unsigned _sp = 0; while (cond) { __builtin_amdgcn_s_sleep(1); \
    if ((++_sp & 255u) == 0u) { if (xb_ld(&(bar)[XB_TMO])) break; if (_sp > XB_SPIN_CAP) { atomicAdd(&(bar)[XB_TMO], 1u); break; } } } } while (0)
struct XcdBarrier { unsigned* bar; unsigned x; volatile LAS unsigned* st; };
__device__ __forceinline__ XcdBarrier xcd_barrier_post(unsigned* bar, volatile LAS unsigned* st) {
    XcdBarrier b; b.bar = bar; b.x = xb_xcc_id(); b.st = st;
    if (threadIdx.x == 0) (void)xb_add(&bar[XB_XCNT(b.x)], 1u);
    return b;
}
__device__ __forceinline__ void xcd_barrier_complete(unsigned* bar, unsigned x, unsigned& nloc, unsigned& nx) {
    const unsigned G = gridDim.x * gridDim.y * gridDim.z;
    unsigned sum, cnt, mine, sp = 0u;
    for (;;) {
        sum = 0u; cnt = 0u; mine = 0u;
#pragma unroll
        for (unsigned j = 0; j < 16; ++j) { const unsigned c = xb_ld(&bar[XB_XCNT(j)]); sum += c; cnt += (c > 0u) ? 1u : 0u; mine = (j == x) ? c : mine; }
        if (sum == G) break;
        __builtin_amdgcn_s_sleep(1);
        if ((++sp & 255u) == 0u) { if (xb_ld(&bar[XB_TMO])) break; if (sp > XB_SPIN_CAP) { atomicAdd(&bar[XB_TMO], 1u); break; } }
    }
    nloc = mine > 0u ? mine : 1u; nx = cnt > 0u ? cnt : 1u;
}
__device__ __forceinline__ void xcd_barrier(const XcdBarrier& b) {
    asm volatile("s_waitcnt vmcnt(0)" ::: "memory");
    __syncthreads();
    if (threadIdx.x == 0) {
        unsigned* bar = b.bar;
        __builtin_amdgcn_s_waitcnt(0);
        unsigned nloc = b.st[0], nx = b.st[1];
        if (nloc == 0u) { xcd_barrier_complete(bar, b.x, nloc, nx); b.st[0] = nloc; b.st[1] = nx; }
        const unsigned old = xb_add(&bar[XB_XSUB(b.x)], 1u);
        const unsigned gen = old / nloc;
        if (old + 1u == (gen + 1u) * nloc) {
            __builtin_amdgcn_fence(__ATOMIC_RELEASE, "agent");
            asm volatile("s_waitcnt vmcnt(0)" ::: "memory");
            const unsigned og = xb_add(&bar[XB_TOP], 1u);
            const unsigned tg = og / nx;
            if (og + 1u == (tg + 1u) * nx) xb_add(&bar[XB_TOPGEN], 1u);
            else XB_SPIN(xb_ld(&bar[XB_TOPGEN]) == tg, bar);
            __builtin_amdgcn_fence(__ATOMIC_ACQUIRE, "agent");
            xb_add(&bar[XB_XGEN(b.x)], 1u);
            asm volatile("s_waitcnt vmcnt(0)" ::: "memory");
        } else {
            XB_SPIN(xb_ld(&bar[XB_XGEN(b.x)]) == gen, bar);
            __builtin_amdgcn_fence(__ATOMIC_ACQUIRE, "agent");
            asm volatile("s_waitcnt vmcnt(0)" ::: "memory");
        }
    }
    __syncthreads();
}

template <int CTRL> __device__ __forceinline__ float dppf(float v) { return __int_as_float(__builtin_amdgcn_update_dpp(0, __float_as_int(v), CTRL, 0xf, 0xf, true)); }
__device__ __forceinline__ float wave_sum(float v) {
    v += dppf<0xB1>(v); v += dppf<0x4E>(v); v += dppf<0x141>(v); v += dppf<0x140>(v);
    { auto rr = __builtin_amdgcn_permlane16_swap(__float_as_uint(v), __float_as_uint(v), false, false); v = __uint_as_float(rr[0]) + __uint_as_float(rr[1]); }
    { auto rr = __builtin_amdgcn_permlane32_swap(__float_as_uint(v), __float_as_uint(v), false, false); v = __uint_as_float(rr[0]) + __uint_as_float(rr[1]); }
    return v;
}
__device__ __forceinline__ float wave_max(float v) {
    asm volatile("s_nop 1\n\tv_max_f32_dpp %0, %0, %0 quad_perm:[1,0,3,2] row_mask:0xf bank_mask:0xf\n\ts_nop 1\n\t"
                 "v_max_f32_dpp %0, %0, %0 quad_perm:[2,3,0,1] row_mask:0xf bank_mask:0xf\n\ts_nop 1\n\t"
                 "v_max_f32_dpp %0, %0, %0 row_half_mirror row_mask:0xf bank_mask:0xf\n\ts_nop 1\n\t"
                 "v_max_f32_dpp %0, %0, %0 row_mirror row_mask:0xf bank_mask:0xf" : "+v"(v));
    { auto rr = __builtin_amdgcn_permlane16_swap(__float_as_uint(v), __float_as_uint(v), false, false); float a = __uint_as_float(rr[0]), b = __uint_as_float(rr[1]); asm volatile("v_max_f32 %0, %1, %2" : "=v"(v) : "v"(a), "v"(b)); }
    { auto rr = __builtin_amdgcn_permlane32_swap(__float_as_uint(v), __float_as_uint(v), false, false); float a = __uint_as_float(rr[0]), b = __uint_as_float(rr[1]); asm volatile("v_max_f32 %0, %1, %2" : "=v"(v) : "v"(a), "v"(b)); }
    return v;
}
__device__ __forceinline__ unsigned q4(f32x4 x, float inv) {
    unsigned w = 0u;
    w = __builtin_amdgcn_cvt_pk_u8_f32(__builtin_rintf(__builtin_fmaf(x.x, inv, 128.0f)), 0, w); w = __builtin_amdgcn_cvt_pk_u8_f32(__builtin_rintf(__builtin_fmaf(x.y, inv, 128.0f)), 1, w);
    w = __builtin_amdgcn_cvt_pk_u8_f32(__builtin_rintf(__builtin_fmaf(x.z, inv, 128.0f)), 2, w); w = __builtin_amdgcn_cvt_pk_u8_f32(__builtin_rintf(__builtin_fmaf(x.w, inv, 128.0f)), 3, w);
    return w ^ 0x80808080u;
}
__device__ __forceinline__ void quant_row(const f32x4 (&v)[4], signed char* qrow, float* sc, int lane) {
    float am = 0.f;
#pragma unroll
    for (int j = 0; j < 4; ++j) am = __builtin_fmaxf(am, __builtin_fmaxf(__builtin_fmaxf(__builtin_fabsf(v[j].x), __builtin_fabsf(v[j].y)), __builtin_fmaxf(__builtin_fabsf(v[j].z), __builtin_fabsf(v[j].w))));
    am = wave_max(am);
    const float inv = am > 0.f ? 127.0f / am : 0.f;
    GAS unsigned* o = (GAS unsigned*)qrow + lane;
#pragma unroll
    for (int j = 0; j < 4; ++j) o[64 * j] = q4(v[j], inv);
    if (lane == 0) *sc = am * (1.0f / 127.0f);
}
constexpr int WT_STRIDE = D + 4;

struct Args { const float* in[20]; float* out; unsigned char* ws; int ph_lo, ph_hi; };
typedef const __attribute__((address_space(4))) Args* KArgs;

__device__ __forceinline__ KArgs ka_opaque() { unsigned long long p = (unsigned long long)__builtin_amdgcn_kernarg_segment_ptr(); asm volatile("" : "+s"(p)); return (KArgs)p; }


__device__ __forceinline__ void p0_transpose_item(const float* Wsrc, int K, int N, bf16* WT, int drow0, int k0, int n0, int dpitch, int dcol0, LAS float* scr, int lane) {
#pragma unroll 8
    for (int i = 0; i < 32; ++i) { const int kk = 2 * i + (lane >> 5); scr[kk * 33 + (lane & 31)] = Wsrc[(size_t)(k0 + kk) * N + n0 + (lane & 31)]; }
    LDS_WAIT(); asm volatile("" ::: "memory");
    const int c = lane & 7;
#pragma unroll
    for (int j = 0; j < 4; ++j) { const int n = (lane >> 3) + 8 * j; const LAS float* s = scr + (8 * c) * 33 + n;
        v4u o; o.x = pk2(s[0 * 33], s[1 * 33]); o.y = pk2(s[2 * 33], s[3 * 33]); o.z = pk2(s[4 * 33], s[5 * 33]); o.w = pk2(s[6 * 33], s[7 * 33]);
        *(GAS v4u*)(WT + (size_t)(drow0 + n) * dpitch + dcol0 + k0 + 8 * c) = o; }
    LDS_WAIT(); asm volatile("" ::: "memory");
}
__device__ __forceinline__ void p0_quant_strip_wg(const float* Wsrc, int N, signed char* WQ, float* SC, int drow0, int n0, LAS float* scr  , LAS float* pmax  , int wave, int lane) {
    constexpr int K = 1024;
    LAS float* mine = scr + wave * 128 * 32;
    float am = 0.f;
#pragma unroll 8
    for (int i = 0; i < 64; ++i) { const int kk = 2 * i + (lane >> 5); const float x = Wsrc[(size_t)(128 * wave + kk) * N + n0 + (lane & 31)];
        am = __builtin_fmaxf(am, __builtin_fabsf(x)); mine[kk * 32 + ((lane & 31) ^ (kk & 31))] = x; }
    am = __builtin_fmaxf(am, __shfl_xor(am, 32));
    if (lane < 32) pmax[wave * 32 + lane] = am;
    __syncthreads();
    float cm = 0.f;
#pragma unroll
    for (int w = 0; w < 8; ++w) cm = __builtin_fmaxf(cm, pmax[w * 32 + (lane & 31)]);
    const float inv = cm > 0.f ? 127.0f / cm : 0.f;
    if (wave == 0 && lane < 32) SC[drow0 + lane] = cm * (1.0f / 127.0f);
    const int c = lane & 3;
#pragma unroll
    for (int kb = 0; kb < 2; ++kb)
#pragma unroll
        for (int j = 0; j < 2; ++j) { const int n = (lane >> 2) + 16 * j; const float invn = __shfl(inv, n);
            float x[16];
#pragma unroll
            for (int t = 0; t < 16; ++t) { const int kk = 64 * kb + 16 * c + t; x[t] = mine[kk * 32 + (n ^ (kk & 31))]; }
            v4u o; o.x = q4((f32x4){x[0], x[1], x[2], x[3]}, invn); o.y = q4((f32x4){x[4], x[5], x[6], x[7]}, invn); o.z = q4((f32x4){x[8], x[9], x[10], x[11]}, invn); o.w = q4((f32x4){x[12], x[13], x[14], x[15]}, invn);
            *(GAS v4u*)(WQ + (size_t)(drow0 + n) * K + 128 * wave + 64 * kb + 16 * c) = o; }
    __syncthreads();
}
__device__ __forceinline__ bool p0_matrix(int& r, const float* src, int K, int N, bf16* dst, bool gu_rows, LAS float* scr, int lane, int dpitch = 0, int dcol0 = 0) {
    const int nblk = N / 32, items = (K / 64) * nblk;
    if (r >= items) { r -= items; return false; }
    const int kb = r / nblk, nb = r % nblk, n0 = 32 * nb;
    int drow0 = n0;
    if (gu_rows) { const int cc = (n0 >= DFF) ? n0 - DFF : n0; drow0 = (cc >> 7) * 256 + (n0 >= DFF ? 128 : 0) + (cc & 127); }
    p0_transpose_item(src, K, N, dst, drow0, 64 * kb, n0, dpitch ? dpitch : K, dcol0, scr, lane);
    return true;
}
__device__ __forceinline__ void row_to_bf16(const float* xrow, bf16* orow, int lane) {
    const GAS f32x4* xr = (const GAS f32x4*)xrow + lane; GAS unsigned long long* o8 = (GAS unsigned long long*)orow + lane;
    f32x4 v[4];
#pragma unroll
    for (int j = 0; j < 4; ++j) v[j] = xr[64 * j];
    asm volatile("" :: "v"(v[0]), "v"(v[1]), "v"(v[2]), "v"(v[3]));
#pragma unroll
    for (int j = 0; j < 4; ++j) o8[64 * j] = (unsigned long long)pk2(v[j].x, v[j].y) | ((unsigned long long)pk2(v[j].z, v[j].w) << 32);
}

__device__ __forceinline__ int t5_bucket(int rel) {
    const int n = rel < 0 ? -rel : rel;
    int b;
    if (n < 8) b = n; else b = 8 + (n >= 12) + (n >= 16) + (n >= 23) + (n >= 32) + (n >= 46) + (n >= 64) + (n >= 91);
    return (rel > 0 ? 16 : 0) + b;
}
namespace att {
typedef float f32x16 __attribute__((ext_vector_type(16)));
typedef short s16x4 __attribute__((ext_vector_type(4)));
typedef short v4i16_t __attribute__((ext_vector_type(4)));
typedef __bf16 bf16x2_t __attribute__((ext_vector_type(2)));
constexpr float LOG2E = 1.4426950408889634f;
constexpr int YP = 3 * W;
constexpr int SLOT = 16384, LDS_K = 0, LDS_V = 2 * SLOT, LDS_STG = 4 * SLOT, STG_W = 8192;
constexpr int LW_MSTG = 3072;
constexpr int LW_WSF = 320, LW_FLAG = 832, LW_TAB = 896;
__device__ __forceinline__ int crow(int r, int hi) { return (r & 3) + 8 * (r >> 2) + 4 * hi; }
__device__ __forceinline__ void glds16(const void* gsrc, unsigned lds_dst) { unsigned keep;
    asm volatile("s_mov_b32 %0, m0\n\ts_mov_b32 m0, %2\n\ts_nop 0\n\tglobal_load_lds_dwordx4 %1, off\n\ts_mov_b32 m0, %0" : "=&s"(keep) : "v"(gsrc), "s"(lds_dst) : "memory"); }
__device__ __forceinline__ unsigned cvtpk(float lo, float hi) { f32x2 v = {lo, hi}; bf16x2_t b = __builtin_convertvector(v, bf16x2_t); return __builtin_bit_cast(unsigned, b); }
template <int N> __device__ __forceinline__ void wait_bar() {
    if constexpr (N == 0) asm volatile("s_waitcnt vmcnt(0) lgkmcnt(0)\n\ts_barrier" ::: "memory");
    else if constexpr (N == 2) asm volatile("s_waitcnt vmcnt(2) lgkmcnt(0)\n\ts_barrier" ::: "memory");
    else if constexpr (N == 3) asm volatile("s_waitcnt vmcnt(3) lgkmcnt(0)\n\ts_barrier" ::: "memory");
    else asm volatile("s_waitcnt vmcnt(4) lgkmcnt(0)\n\ts_barrier" ::: "memory");
}
__device__ __forceinline__ void lds_bar() { asm volatile("s_waitcnt lgkmcnt(0)\n\ts_barrier" ::: "memory"); }
typedef LAS const char* lptr;
template <int ND0, int BT = 4> __device__ __forceinline__ void qkt(f32x16& p0, f32x16& p1, lptr kslot, const bf16x8* qr, int r32, int hi) {
    lptr kb = kslot + hi * 1024 + r32 * 16;
    p0 = (f32x16){}; p1 = (f32x16){};
    bf16x8 b0[BT], b1[BT];
#pragma unroll
    for (int g = 0; g < ND0 / BT; ++g) {
#pragma unroll
        for (int d = 0; d < BT; ++d) { b0[d] = *(const LAS bf16x8*)(kb + (BT * g + d) * 2048); b1[d] = *(const LAS bf16x8*)(kb + (BT * g + d) * 2048 + 512); }
        __builtin_amdgcn_sched_barrier(0);
#pragma unroll
        for (int d = 0; d < BT; ++d) { p0 = __builtin_amdgcn_mfma_f32_32x32x16_bf16(b0[d], qr[BT * g + d], p0, 0, 0, 0); p1 = __builtin_amdgcn_mfma_f32_32x32x16_bf16(b1[d], qr[BT * g + d], p1, 0, 0, 0); }
        __builtin_amdgcn_sched_barrier(0);
    }
}
__device__ __forceinline__ s16x4 vtr(lptr p) { return __builtin_bit_cast(s16x4, __builtin_amdgcn_ds_read_tr16_b64_v4i16((LAS v4i16_t*)p)); }
template <int NDB> __device__ __forceinline__ void pv(f32x16* o, lptr vb, v4u pw0, v4u pw1, v4u pw2, v4u pw3) {
    s16x4 lo[2][4], hh[2][4];
#pragma unroll
    for (int ks = 0; ks < 4; ++ks) { lo[0][ks] = vtr(vb + ks * 1024); hh[0][ks] = vtr(vb + ks * 1024 + 512); }
#pragma unroll
    for (int db = 0; db < NDB; ++db) {
        if (db + 1 < NDB) {
#pragma unroll
            for (int ks = 0; ks < 4; ++ks) { lo[(db + 1) & 1][ks] = vtr(vb + (db + 1) * 4096 + ks * 1024); hh[(db + 1) & 1][ks] = vtr(vb + (db + 1) * 4096 + ks * 1024 + 512); }
        }
        __builtin_amdgcn_sched_barrier(0);
#pragma unroll
        for (int ks = 0; ks < 4; ++ks) {
            const s16x4 l_ = lo[db & 1][ks], h_ = hh[db & 1][ks];
            const bf16x8 vf = (bf16x8){l_[0], l_[1], l_[2], l_[3], h_[0], h_[1], h_[2], h_[3]};
            const v4u pw = ks == 0 ? pw0 : ks == 1 ? pw1 : ks == 2 ? pw2 : pw3;
            o[db] = __builtin_amdgcn_mfma_f32_32x32x16_bf16(__builtin_bit_cast(bf16x8, pw), vf, o[db], 0, 0, 0); }
        __builtin_amdgcn_sched_barrier(0);
    }
}
__device__ __forceinline__ void pack_p(const f32x16& p0, const f32x16& p1, v4u& pw0, v4u& pw1, v4u& pw2, v4u& pw3) {
    pw0 = (v4u){cvtpk(p0[0], p0[1]), cvtpk(p0[2], p0[3]), cvtpk(p0[4], p0[5]), cvtpk(p0[6], p0[7])};
    pw1 = (v4u){cvtpk(p0[8], p0[9]), cvtpk(p0[10], p0[11]), cvtpk(p0[12], p0[13]), cvtpk(p0[14], p0[15])};
    pw2 = (v4u){cvtpk(p1[0], p1[1]), cvtpk(p1[2], p1[3]), cvtpk(p1[4], p1[5]), cvtpk(p1[6], p1[7])};
    pw3 = (v4u){cvtpk(p1[8], p1[9]), cvtpk(p1[10], p1[11]), cvtpk(p1[12], p1[13]), cvtpk(p1[14], p1[15])};
}
__device__ __forceinline__ float half_swap(float x, int hi) {
    auto rr = __builtin_amdgcn_permlane32_swap(__float_as_uint(x), __float_as_uint(x), false, false);
    return __uint_as_float(hi ? rr[0] : rr[1]);
}
__device__ __forceinline__ float rowmax32(const f32x16& p0, const f32x16& p1, int hi) {
    float a = __builtin_fmaxf(p0[0], p1[0]);
#pragma unroll
    for (int r = 1; r < 16; ++r) a = __builtin_fmaxf(a, __builtin_fmaxf(p0[r], p1[r]));
    return __builtin_fmaxf(a, half_swap(a, hi));
}
template <int NKC  , int NVP  >
__device__ __forceinline__ void dma_tile(const bf16* Kt, const bf16* Vt, int pitch, unsigned kdst, unsigned vdst, int wid, int lane) {
#pragma unroll
    for (int i = 0; i < NKC; ++i) { const int c = wid + 8 * i; glds16(Kt + (size_t)lane * pitch + c * 8, (unsigned)__builtin_amdgcn_readfirstlane(kdst + c * 1024)); }
#pragma unroll
    for (int i = 0; i < NVP; ++i) { const int pc = wid + 8 * i, dh = pc >> 2, rg = pc & 3;
        glds16(Vt + (size_t)(16 * rg + (lane >> 2)) * pitch + dh * 32 + (lane & 3) * 8, (unsigned)__builtin_amdgcn_readfirstlane(vdst + pc * 1024)); }
}
template <int NDB> __device__ __forceinline__ void store_o(const f32x16* o, const float* rsc  , LAS unsigned char* stg, bf16* Yw  , int lane, int r32, int hi) {
    LAS bf16* st = (LAS bf16*)stg;
#pragma unroll
    for (int r = 0; r < 16; ++r) { const int orow = crow(r, hi);
#pragma unroll
        for (int db = 0; db < NDB; ++db) st[orow * (NDB * 32) + db * 32 + r32] = (bf16)f2bf(o[db][r] * rsc[r]); }
    LDS_WAIT();
    constexpr int CPR = NDB * 4;
#pragma unroll
    for (int i = 0; i < (32 * CPR) / 64; ++i) { const int idx = i * 64 + lane, row = idx / CPR, ch = idx % CPR;
        const v4u v = *(const LAS v4u*)(stg + row * (NDB * 64) + ch * 16); *(v4u*)(Yw + (size_t)row * YP + ch * 8) = v; }
    LDS_WAIT();
}

template <int NKC> __device__ __forceinline__ void dma_k(const bf16* Kt, int pitch, unsigned kdst, int wid, int lane) {
#pragma unroll
    for (int i = 0; i < NKC; ++i) { const int c = wid + 8 * i; glds16(Kt + (size_t)lane * pitch + c * 8, (unsigned)__builtin_amdgcn_readfirstlane(kdst + c * 1024)); }
}
template <int NVP> __device__ __forceinline__ void dma_v(const bf16* Vt, int pitch, unsigned vdst, int wid, int lane) {
#pragma unroll
    for (int i = 0; i < NVP; ++i) { const int pc = wid + 8 * i, dh = pc >> 2, rg = pc & 3;
        glds16(Vt + (size_t)(16 * rg + (lane >> 2)) * pitch + dh * 32 + (lane & 3) * 8, (unsigned)__builtin_amdgcn_readfirstlane(vdst + pc * 1024)); }
}
template <int NDB> __device__ __forceinline__ void store_rows(const f32x16* o, const float* rsc, LAS unsigned char* stg, bf16* Yw, int lane, int r32, int hi) {
    constexpr int RPP = 2048 / (NDB * 64), RH = RPP / 2, NP = 32 / RPP, CPR = NDB * 4, NIT = RPP * CPR / 64;
    LAS bf16* st = (LAS bf16*)stg;
#pragma unroll
    for (int g = 0; g < NP; ++g) {
#pragma unroll
        for (int rp = 0; rp < RH; ++rp)
#pragma unroll
            for (int db = 0; db < NDB; ++db) st[crow(rp, hi) * (NDB * 32) + db * 32 + r32] = (bf16)f2bf(o[db][g * RH + rp] * rsc[g * RH + rp]);
        LDS_WAIT();
#pragma unroll
        for (int i = 0; i < NIT; ++i) { const int idx = i * 64 + lane, row = idx / CPR, ch = idx % CPR;
            const v4u v = *(const LAS v4u*)(stg + row * (NDB * 64) + ch * 16); *(v4u*)(Yw + (size_t)(g * RPP + row) * YP + ch * 8) = v; }
        LDS_WAIT();
    }
}
__device__ __forceinline__ float mul1(float a, float b) { float r; asm("v_mul_f32 %0, %1, %2" : "=v"(r) : "v"(a), "v"(b)); return r; }
__device__ __forceinline__ void sb_tile(f32x16* o, float& R, lptr kslot, lptr vbt, const bf16x8* qr, int delta  , int r32, int hi) {
    f32x16 p0, p1;
    qkt<4>(p0, p1, kslot, qr, r32, hi);
    if (delta < 64 + 31) {
#pragma unroll
        for (int r = 0; r < 16; ++r) { const int kv = crow(r, hi) - r32; if (!(kv < delta)) p0[r] = -INFINITY; if (!(kv + 32 < delta)) p1[r] = -INFINITY; }
    }
#pragma unroll
    for (int r = 0; r < 16; ++r) { p0[r] = __builtin_amdgcn_rcpf(1.0f + __builtin_amdgcn_exp2f(p0[r])); p1[r] = __builtin_amdgcn_rcpf(1.0f + __builtin_amdgcn_exp2f(p1[r])); }
    float To[8], Tp[8], F[8];
#pragma unroll
    for (int g = 0; g < 4; ++g) { To[g] = mul1(mul1(p0[4 * g + 3], p0[4 * g + 2]), mul1(p0[4 * g + 1], p0[4 * g])); To[4 + g] = mul1(mul1(p1[4 * g + 3], p1[4 * g + 2]), mul1(p1[4 * g + 1], p1[4 * g])); }
#pragma unroll
    for (int g = 0; g < 8; ++g) Tp[g] = half_swap(To[g], hi);
    F[7] = 1.0f;
#pragma unroll
    for (int g = 6; g >= 0; --g) F[g] = mul1(F[g + 1], mul1(To[g + 1], Tp[g + 1]));
    const float total = mul1(F[0], mul1(To[0], Tp[0]));
#pragma unroll
    for (int g = 0; g < 8; ++g) { const float E = mul1(mul1(R, F[g]), (hi == 0 ? Tp[g] : 1.0f));
        f32x16& pp = (g < 4) ? p0 : p1; const int q = 4 * (g & 3);
        f32x4 x;
        x[3] = E; x[2] = mul1(E, pp[q + 3]); x[1] = mul1(x[2], pp[q + 2]); x[0] = mul1(x[1], pp[q + 1]);
        const f32x2 w01 = ((f32x2){1.0f, 1.0f} - (f32x2){pp[q], pp[q + 1]}) * (f32x2){x[0], x[1]}, w23 = ((f32x2){1.0f, 1.0f} - (f32x2){pp[q + 2], pp[q + 3]}) * (f32x2){x[2], x[3]};
        pp[q] = w01.x; pp[q + 1] = w01.y; pp[q + 2] = w23.x; pp[q + 3] = w23.y; }
    R *= total;
    v4u pw0, pw1, pw2, pw3; pack_p(p0, p1, pw0, pw1, pw2, pw3);
    pv<2>(o, vbt, pw0, pw1, pw2, pw3);
}
__device__ __forceinline__ void sb_unit(LAS unsigned char* lds, volatile LAS unsigned* LWv, const bf16* proj, bf16* ysb, int b, int h, int qt, bool pre, int nb, int nh, int nqt) {
    const int tid_ = tid_opaque(), lane = tid_ & 63, wid = __builtin_amdgcn_readfirstlane(tid_ >> 6);
    const int r32 = lane & 31, hi = lane >> 5, q0 = qt * 256, qw0 = q0 + 32 * wid;
    const size_t rowb = (size_t)b * SEQ;
    const bf16* Qw = proj + (rowb + qw0) * PP + h * 64; const bf16* Kh = proj + rowb * PP + W + h * 64; const bf16* Vh = proj + rowb * PP + 2 * W + h * 64;
    const unsigned lds0 = (unsigned)(uintptr_t)lds;
    constexpr int WK = 0, WV = 4 * SLOT, TB = 8192;
    const int jhi = q0 / 64 + 3, jlo = jhi >= 7 ? jhi - 7 : 0;
    if (!pre) {
#pragma unroll 1
        for (int j = jhi; j >= jlo; --j) dma_tile<1, 1>(Kh + (size_t)j * 64 * PP, Vh + (size_t)j * 64 * PP, PP, lds0 + WK + (jhi - j) * TB, lds0 + WV + (jhi - j) * TB, wid, lane); }
    bf16x8 qr[4];
#pragma unroll
    for (int d0 = 0; d0 < 4; ++d0) qr[d0] = *(const bf16x8*)(Qw + (size_t)r32 * PP + d0 * 16 + hi * 8);
    asm volatile("" : "+v"(qr[0]), "+v"(qr[1]), "+v"(qr[2]), "+v"(qr[3]));
    f32x16 o[2]; o[0] = (f32x16){}; o[1] = (f32x16){};
    float R = 1.0f;
    const float RTH = 7.5231638e-37f;
    bool done = false;
    lptr vb = (lptr)lds + WV + ((lane >> 4) & 1) * 32 + (lane & 3) * 8 + (4 * hi + ((lane & 15) >> 2)) * 64;
    wait_bar<0>();
#pragma unroll 1
    for (int j = jhi; j >= jlo; --j) {
        const int delta = qw0 - 64 * j;
        if (delta <= -31) continue;
        sb_tile(o, R, (lptr)lds + WK + (jhi - j) * TB, vb + (jhi - j) * TB, qr, delta, r32, hi);
        done = __all(R < RTH);
        if (done) break;
    }
    if (lane == 0) LWv[LW_FLAG + wid] = (!done && jlo > 0) ? 1u : 0u;
    lds_bar();
    unsigned more = 0u;
#pragma unroll
    for (int w = 0; w < 8; ++w) more |= LWv[LW_FLAG + w];
    if (more) {
        lds_bar();
        dma_tile<1, 1>(Kh + (size_t)(jlo - 1) * 64 * PP, Vh + (size_t)(jlo - 1) * 64 * PP, PP, lds0 + WK, lds0 + WV, wid, lane);
        int slot = 0;
#pragma unroll 1
        for (int j = jlo - 1; j >= 0; --j) {
            if (j > 0) { dma_tile<1, 1>(Kh + (size_t)(j - 1) * 64 * PP, Vh + (size_t)(j - 1) * 64 * PP, PP, lds0 + WK + (slot ^ 1) * TB, lds0 + WV + (slot ^ 1) * TB, wid, lane); wait_bar<2>(); }
            else wait_bar<0>();
            if (!done) { sb_tile(o, R, (lptr)lds + WK + slot * TB, vb + slot * TB, qr, qw0 - 64 * j, r32, hi); done = __all(R < RTH); }
            if (lane == 0) LWv[LW_FLAG + wid] = (done || j == 0) ? 1u : 0u;
            lds_bar();
            unsigned alld = 1u;
#pragma unroll
            for (int w = 0; w < 8; ++w) alld &= LWv[LW_FLAG + w];
            slot ^= 1;
            if (alld) break;
        }
        wait_bar<0>();
    }
    if (nqt >= 0) {
        const bf16* nK = proj + (size_t)nb * SEQ * PP + W + nh * 64; const bf16* nV = proj + (size_t)nb * SEQ * PP + 2 * W + nh * 64;
        const int njhi = nqt * 4 + 3, njlo = njhi >= 7 ? njhi - 7 : 0;
#pragma unroll 1
        for (int j = njhi; j >= njlo; --j) dma_tile<1, 1>(nK + (size_t)j * 64 * PP, nV + (size_t)j * 64 * PP, PP, lds0 + WK + (njhi - j) * TB, lds0 + WV + (njhi - j) * TB, wid, lane); }
    float ones[16];
#pragma unroll
    for (int r = 0; r < 16; ++r) ones[r] = 1.0f;
    store_rows<2>(o, ones, (LAS unsigned char*)(LWv + LW_MSTG) + wid * 2048, ysb + (rowb + qw0) * YP + h * 64, lane, r32, hi);
    lds_bar();
}

template <int NDB> __device__ __forceinline__ void softmax_tile(f32x16& p0, f32x16& p1, f32x16* o, float& m, float& l, float cb, const LAS float* tabp, volatile LAS float* wsf, int r32, int hi) {
    if (tabp) {
#pragma unroll
        for (int r = 0; r < 16; ++r) { p0[r] += tabp[crow(r, 0)] - cb; p1[r] += tabp[32 + crow(r, 0)] - cb; }
    }
    float a = __builtin_fmaxf(__builtin_fmaxf(p0[0], p0[1]), p1[0]), b = __builtin_fmaxf(__builtin_fmaxf(p0[2], p0[3]), p1[1]); a = __builtin_fmaxf(__builtin_fmaxf(a, p1[2]), p1[3]);
#pragma unroll
    for (int r = 4; r < 16; r += 4) { a = __builtin_fmaxf(__builtin_fmaxf(a, p0[r]), p0[r + 1]); b = __builtin_fmaxf(__builtin_fmaxf(b, p0[r + 2]), p0[r + 3]); a = __builtin_fmaxf(__builtin_fmaxf(a, p1[r]), p1[r + 1]); b = __builtin_fmaxf(__builtin_fmaxf(b, p1[r + 2]), p1[r + 3]); }
    float rm = __builtin_fmaxf(a, b); rm = __builtin_fmaxf(rm, half_swap(rm, hi));
    if (__any(rm > m + 8.0f)) {
        const float mn = __builtin_fmaxf(m, rm), f = __builtin_amdgcn_exp2f(m - mn);
        l *= f; m = mn;
        if (hi == 0) wsf[r32] = f;
        LDS_WAIT();
#pragma unroll
        for (int r = 0; r < 16; ++r) { const float fr_ = wsf[crow(r, hi)];
#pragma unroll
            for (int db = 0; db < NDB; ++db) o[db][r] *= fr_; }
        LDS_WAIT();
    }
    float s = 0.f;
#pragma unroll
    for (int r = 0; r < 16; ++r) { p0[r] = __builtin_amdgcn_exp2f(p0[r] - m); p1[r] = __builtin_amdgcn_exp2f(p1[r] - m); s += p0[r] + p1[r]; }
    l += s;
}
__device__ __forceinline__ void row_inv_l(float l, float* rli, volatile LAS float* wsf, int r32, int hi) {
    l += half_swap(l, hi);
    if (hi == 0) wsf[r32] = l;
    LDS_WAIT();
#pragma unroll
    for (int r = 0; r < 16; ++r) rli[r] = __builtin_amdgcn_rcpf(wsf[crow(r, hi)]);
    LDS_WAIT();
}

__device__ __forceinline__ bool sm_decide(f32x16& p0, f32x16& p1, float& m, float& f, float cb, const LAS float* tabp, int hi) {
    if (tabp) {
#pragma unroll
        for (int r = 0; r < 16; ++r) { p0[r] += tabp[crow(r, 0)] - cb; p1[r] += tabp[32 + crow(r, 0)] - cb; }
    }
    float a = __builtin_fmaxf(__builtin_fmaxf(p0[0], p0[1]), p1[0]), b = __builtin_fmaxf(__builtin_fmaxf(p0[2], p0[3]), p1[1]); a = __builtin_fmaxf(__builtin_fmaxf(a, p1[2]), p1[3]);
#pragma unroll
    for (int r = 4; r < 16; r += 4) { a = __builtin_fmaxf(__builtin_fmaxf(a, p0[r]), p0[r + 1]); b = __builtin_fmaxf(__builtin_fmaxf(b, p0[r + 2]), p0[r + 3]); a = __builtin_fmaxf(__builtin_fmaxf(a, p1[r]), p1[r + 1]); b = __builtin_fmaxf(__builtin_fmaxf(b, p1[r + 2]), p1[r + 3]); }
    float rm = __builtin_fmaxf(a, b); rm = __builtin_fmaxf(rm, half_swap(rm, hi));
    f = 1.0f;
    if (__any(rm > m + 8.0f)) { const float mn = __builtin_fmaxf(m, rm); f = __builtin_amdgcn_exp2f(m - mn); m = mn; return true; }
    return false;
}
__device__ __forceinline__ void pv_exp(f32x16* o, lptr vbp, v4u pw0, v4u pw1, v4u pw2, v4u pw3, f32x16& p0, f32x16& p1, float m) {
    asm volatile("" : "+v"(p0), "+v"(p1));
    s16x4 lo[3], hh[3];
#pragma unroll
    for (int g = 0; g < 2; ++g) { lo[g] = vtr(vbp + (g >> 2) * 4096 + (g & 3) * 1024); hh[g] = vtr(vbp + (g >> 2) * 4096 + (g & 3) * 1024 + 512); }
    __builtin_amdgcn_sched_barrier(0);
#pragma unroll
    for (int g = 0; g < 16; ++g) {
        const int db = g >> 2, ks = g & 3;
        if (g + 2 < 16) { const int gn = g + 2; lo[gn % 3] = vtr(vbp + (gn >> 2) * 4096 + (gn & 3) * 1024); hh[gn % 3] = vtr(vbp + (gn >> 2) * 4096 + (gn & 3) * 1024 + 512); }
        const s16x4 l_ = lo[g % 3], h_ = hh[g % 3];
        const bf16x8 vf = (bf16x8){l_[0], l_[1], l_[2], l_[3], h_[0], h_[1], h_[2], h_[3]};
        const v4u pw = ks == 0 ? pw0 : ks == 1 ? pw1 : ks == 2 ? pw2 : pw3;
        o[db] = __builtin_amdgcn_mfma_f32_32x32x16_bf16(__builtin_bit_cast(bf16x8, pw), vf, o[db], 0, 0, 0);
        if (g < 8) { float e0_ = __builtin_amdgcn_exp2f(p0[2 * g] - m), e1_ = __builtin_amdgcn_exp2f(p0[2 * g + 1] - m); asm volatile("" : "+v"(e0_), "+v"(e1_)); p0[2 * g] = e0_; p0[2 * g + 1] = e1_; }
        else { float e0_ = __builtin_amdgcn_exp2f(p1[2 * g - 16] - m), e1_ = __builtin_amdgcn_exp2f(p1[2 * g - 15] - m); asm volatile("" : "+v"(e0_), "+v"(e1_)); p1[2 * g - 16] = e0_; p1[2 * g - 15] = e1_; }
        __builtin_amdgcn_sched_barrier(0);
    }
}

__device__ __forceinline__ void df_unit(LAS unsigned char* lds, volatile LAS unsigned* LWv, const bf16* proj, bf16* ydf, const float* subg, float lam, float outscale, int b, int H, int qt, int, int) {
    const int tid_ = tid_opaque(), lane = tid_ & 63, wid = __builtin_amdgcn_readfirstlane(tid_ >> 6);
    const int r32 = lane & 31, hi = lane >> 5, q0 = qt * 256, qw0 = q0 + 32 * wid;
    const size_t rowb = (size_t)b * SEQ;
    const bf16* Vh = proj + rowb * PP + 5 * W + H * 128;
    const unsigned lds0 = (unsigned)(uintptr_t)lds;
    volatile LAS float* wsf = (volatile LAS float*)(LWv + LW_WSF + wid * 64);
    LAS unsigned char* stg = lds + LDS_STG + wid * STG_W;
    constexpr int DK = 0, DV = SLOT, KSL = 8192;
    lptr vb = (lptr)lds + DV + ((lane >> 4) & 1) * 32 + (lane & 3) * 8 + (4 * hi + ((lane & 15) >> 2)) * 64;
    const int jmax = q0 / 64 + 3, jw = qw0 / 64;
    f32x16 o[4];
#pragma unroll 1
    for (int mp = 0; mp < 2; ++mp) {
        const int h2 = 2 * H + mp;
        const bf16* Qw = proj + (rowb + qw0) * PP + 3 * W + h2 * 64; const bf16* Kh = proj + rowb * PP + 4 * W + h2 * 64;
        const LAS float* tab = (const LAS float*)(LWv + LW_TAB) + h2 * 256;
        const float cfar = tab[0];
        bf16x8 qr[4];
#pragma unroll
        for (int d0 = 0; d0 < 4; ++d0) qr[d0] = *(const bf16x8*)(Qw + (size_t)r32 * PP + d0 * 16 + hi * 8);
#pragma unroll
        for (int db = 0; db < 4; ++db) o[db] = (f32x16){};
        float m = -INFINITY, l = 0.f;
        v4u pw0 = (v4u){0u, 0u, 0u, 0u}, pw1 = pw0, pw2 = pw0, pw3 = pw0; bool have = false;
        dma_k<1>(Kh, PP, lds0 + DK, wid, lane); dma_v<2>(Vh, PP, lds0 + DV, wid, lane);
        asm volatile("" : "+v"(qr[0]), "+v"(qr[1]), "+v"(qr[2]), "+v"(qr[3]));
        int vs = 0, vprev = 0;
#pragma unroll 1
        for (int j = 0; j <= jmax + 1; ++j) {
            wait_bar<0>();
            const int vnext = (vs == 2) ? 0 : vs + 1;
            if (j < jmax) { dma_k<1>(Kh + (size_t)(j + 1) * 64 * PP, PP, lds0 + DK + ((j + 1) & 1) * KSL, wid, lane); dma_v<2>(Vh + (size_t)(j + 1) * 64 * PP, PP, lds0 + DV + vnext * SLOT, wid, lane); }
            if (j <= jw) {
                f32x16 p0, p1;
                qkt<4, 4>(p0, p1, (lptr)lds + DK + (j & 1) * KSL, qr, r32, hi);
                const int relmax = 64 * j + 63 - qw0;
                const LAS float* tabp = (relmax > -91) ? tab + (64 * j - qw0 + 192 + 4 * hi - r32) : nullptr;
                float f; const bool resc = sm_decide(p0, p1, m, f, cfar, tabp, hi);
                if (have) pv_exp(o, vb + vprev * SLOT, pw0, pw1, pw2, pw3, p0, p1, m);
                else {
#pragma unroll
                    for (int r = 0; r < 16; ++r) { p0[r] = __builtin_amdgcn_exp2f(p0[r] - m); p1[r] = __builtin_amdgcn_exp2f(p1[r] - m); } }
                if (resc) {
                    if (hi == 0) wsf[r32] = f;
                    LDS_WAIT();
#pragma unroll
                    for (int r = 0; r < 16; ++r) { const float fr_ = wsf[crow(r, hi)];
#pragma unroll
                        for (int db = 0; db < 4; ++db) o[db][r] *= fr_; }
                    LDS_WAIT();
                }
                float sacc = 0.f;
#pragma unroll
                for (int r = 0; r < 16; ++r) sacc += p0[r] + p1[r];
                l = l * f + sacc;
                pack_p(p0, p1, pw0, pw1, pw2, pw3); have = true;
            } else if (have) { pv<4>(o, vb + vprev * SLOT, pw0, pw1, pw2, pw3); have = false; }
            vprev = vs; vs = vnext;
        }
        lds_bar();
        float rli[16]; row_inv_l(l, rli, wsf, r32, hi);
        LAS bf16* st = (LAS bf16*)stg;
        if (mp == 0) {
#pragma unroll
            for (int r = 0; r < 16; ++r) { const int orow = crow(r, hi);
#pragma unroll
                for (int db = 0; db < 4; ++db) st[orow * 128 + db * 32 + r32] = (bf16)f2bf(o[db][r] * rli[r]); }
            LDS_WAIT();
        } else {
            float ss[16];
#pragma unroll
            for (int r = 0; r < 16; ++r) { const int orow = crow(r, hi); float q = 0.f;
#pragma unroll
                for (int db = 0; db < 4; ++db) { const float a = bf2f(st[orow * 128 + db * 32 + r32]) - lam * (o[db][r] * rli[r]); o[db][r] = a; q += a * a; }
                ss[r] = q; }
#pragma unroll
            for (int r = 0; r < 16; ++r) { float q = ss[r];
#pragma unroll
                for (int x = 1; x < 32; x <<= 1) q += __shfl_xor(q, x);
                ss[r] = __builtin_amdgcn_rsqf(q * (1.0f / 128.0f) + RMS_EPS) * outscale; }
            float g4[4];
#pragma unroll
            for (int db = 0; db < 4; ++db) g4[db] = subg[db * 32 + r32];
            asm volatile("" :: "v"(g4[0]), "v"(g4[1]), "v"(g4[2]), "v"(g4[3]));
#pragma unroll
            for (int db = 0; db < 4; ++db) {
#pragma unroll
                for (int r = 0; r < 16; ++r) o[db][r] *= g4[db]; }
            LDS_WAIT();
            store_o<4>(o, ss, stg, ydf + (rowb + qw0) * YP + H * 128, lane, r32, hi);
        }
    }
    lds_bar();
}

__device__ __forceinline__ void mem_unit(LAS unsigned char* lds, volatile LAS unsigned* LWv, const bf16* proj, const bf16* memkv, bf16* ymem, int b, int h, int qq, int, int) {
    const int tid_ = tid_opaque(), lane = tid_ & 63, wid = __builtin_amdgcn_readfirstlane(tid_ >> 6);
    const int r32 = lane & 31, hi = lane >> 5;
    const size_t rowb = (size_t)b * SEQ;
    const bf16* Kh = memkv + (size_t)b * MEML * 2048 + h * 128; const bf16* Vh = Kh + W;
    const unsigned lds0 = (unsigned)(uintptr_t)lds;
    volatile LAS float* wsf = (volatile LAS float*)(LWv + LW_WSF + wid * 64);
    LAS unsigned char* stg = (LAS unsigned char*)(LWv + LW_MSTG) + wid * 2048;
    constexpr int MK = 0, MV = 4 * SLOT;
#pragma unroll
    for (int j = 0; j < MEML / 64; ++j) dma_tile<2, 2>(Kh + (size_t)j * 64 * 2048, Vh + (size_t)j * 64 * 2048, 2048, lds0 + MK + j * SLOT, lds0 + MV + j * SLOT, wid, lane);
    wait_bar<0>();
    lptr vb = (lptr)lds + MV + ((lane >> 4) & 1) * 32 + (lane & 3) * 8 + (4 * hi + ((lane & 15) >> 2)) * 64;
#pragma unroll 1
    for (int qs = 0; qs < 4; ++qs) {
        const int qw0 = 1024 * qq + 256 * qs + 32 * wid;
        const bf16* Qw = proj + (rowb + qw0) * PP + 6 * W + h * 128;
        bf16x8 qr[8];
#pragma unroll
        for (int d0 = 0; d0 < 8; ++d0) qr[d0] = *(const bf16x8*)(Qw + (size_t)r32 * PP + d0 * 16 + hi * 8);
        f32x16 o[4];
#pragma unroll
        for (int db = 0; db < 4; ++db) o[db] = (f32x16){};
        float m = -INFINITY, l = 0.f;
#pragma unroll 1
        for (int j = 0; j < MEML / 64; ++j) {
            f32x16 p0, p1;
            qkt<8>(p0, p1, (lptr)lds + MK + j * SLOT, qr, r32, hi);
            softmax_tile<4>(p0, p1, o, m, l, 0.f, nullptr, wsf, r32, hi);
            v4u pw0, pw1, pw2, pw3; pack_p(p0, p1, pw0, pw1, pw2, pw3);
            pv<4>(o, vb + j * SLOT, pw0, pw1, pw2, pw3);
        }
        float rli[16]; row_inv_l(l, rli, wsf, r32, hi);
        LAS bf16* st = (LAS bf16*)stg; bf16* Yw = ymem + (rowb + qw0) * YP + h * 128;
#pragma unroll
        for (int g = 0; g < 4; ++g) {
#pragma unroll
            for (int i = 0; i < 4; ++i)
#pragma unroll
                for (int db = 0; db < 4; ++db) st[(4 * hi + i) * 128 + db * 32 + r32] = (bf16)f2bf(o[db][4 * g + i] * rli[4 * g + i]);
            LDS_WAIT();
#pragma unroll
            for (int i = 0; i < 2; ++i) { const int idx = i * 64 + lane, row = idx >> 4, ch = idx & 15;
                const v4u v = *(const LAS v4u*)(stg + row * 256 + ch * 16); *(v4u*)(Yw + (size_t)(8 * g + row) * YP + ch * 8) = v; }
            LDS_WAIT();
        }
    }
    lds_bar();
}
}

#define PH_LOCALS() KArgs ka = ka_opaque(); unsigned char* ws = ka->ws; const int tid = tid_opaque(), lane = tid & 63, wave = __builtin_amdgcn_readfirstlane(tid >> 6); \
    const int G = gridDim.x, bx = blockIdx.x, vcu = (G % 8 == 0) ? (bx % 8) * (G / 8) + bx / 8 : bx, gw = vcu * NWAVES + wave, NGW = G * NWAVES; \
    (void)ws; (void)lane; (void)wave; (void)gw; (void)NGW; (void)vcu; (void)bx
__global__ void __launch_bounds__(NWAVES * 64, 2) mk_fwd(Args args) {
    extern __shared__ __attribute__((aligned(16))) unsigned char lds_raw[];
    LAS unsigned char* lds = (LAS unsigned char*)lds_raw;
    volatile LAS unsigned* LW = (volatile LAS unsigned*)(lds + LDSCTL_OFF);
    for (int u = threadIdx.x; u < (LDS_BYTES - LDSCTL_OFF) / 4; u += NWAVES * 64) ((LAS unsigned*)(lds + LDSCTL_OFF))[u] = 0u;
    __syncthreads();
#if MK_ONE_LAUNCH
    XcdBarrier bar = xcd_barrier_post((unsigned*)((gu32*)(args.ws + WS_CTL) + CW_BAR), LW + LW_BAR);
#define GRID_BAR() xcd_barrier(bar)
#else
#define GRID_BAR() do {} while (0)
#endif
    const int lo = args.ph_lo, hi = args.ph_hi;
#define IN(k) (lo <= (k) && (k) < hi)
#define BOTH(k) (IN(k) && IN((k) + 1))

    if (PH_EN(0) && IN(0)) REP(0) {
        PH_LOCALS();
        LAS float* scr = (LAS float*)(lds + RING_OFF + wave * 16384);
        constexpr int I_IN = 16 * (INW / 32), I_SQ = 16 * 32, I_BR = 8 * 32, I_GU = 16 * 64, I_D = 16 * 32;
        constexpr int PER_LAYER = I_IN + I_SQ + 3 * I_BR + I_SQ + NE * I_GU + NE * I_D;
        constexpr int S_IN = I8_P1 ? INW / 32 : 0, S_GU = I8_P6 ? NE * (2 * DFF / 32) : 0, SPL = S_IN + S_GU, NS = DEPTH * SPL;
#pragma unroll 1
        for (int st = vcu; st < NS; st += G) {
            const int l = st / SPL; int r = st % SPL;
            LAS float* pmax = (LAS float*)(lds + LDSCTL_OFF) + LW_RSLOT;
            if (r < S_IN) { p0_quant_strip_wg(ka->in[2] + (size_t)l * D * INW, INW, (signed char*)(ws + WS_WIN) + (size_t)l * INW * D, (float*)(ws + WS_SWIN) + (size_t)l * INW, 32 * r, 32 * r, (LAS float*)(lds + RING_OFF), pmax, wave, lane); continue; }
            r -= S_IN;
            { const int e = r / (2 * DFF / 32), n0 = 32 * (r % (2 * DFF / 32)); const int cc = (n0 >= DFF) ? n0 - DFF : n0, drow0 = (cc >> 7) * 256 + (n0 >= DFF ? 128 : 0) + (cc & 127);
              p0_quant_strip_wg(ka->in[14] + ((size_t)l * NE + e) * D * 2 * DFF, 2 * DFF, (signed char*)(ws + WS_WGU) + ((size_t)l * NE + e) * 2 * DFF * D, (float*)(ws + WS_SWGU) + ((size_t)l * NE + e) * 2 * DFF, drow0, n0, (LAS float*)(lds + RING_OFF), pmax, wave, lane); }
        }
#pragma unroll 1
        for (int it = gw; it < DEPTH * PER_LAYER; it += NGW) {
            const int l = it / PER_LAYER; int r = it % PER_LAYER;
            if (r < I_IN) { if (!I8_P1) p0_matrix(r, ka->in[2] + (size_t)l * D * INW, D, INW, (bf16*)(ws + WS_WIN) + (size_t)l * INW * D, false, scr, lane); continue; }
            r -= I_IN;
            if (p0_matrix(r, ka->in[7] + (size_t)l * D * 1024, D, 1024, (bf16*)(ws + WS_WMEMKV) + (size_t)l * 1024 * D, false, scr, lane)) continue;
            if (r < 3 * I_BR) { const int b = r / I_BR; int rr = r % I_BR;
                p0_matrix(rr, ka->in[8] + ((size_t)l * 3 + b) * W * D, W, D, (bf16*)(ws + WS_WBR) + (size_t)l * D * 3 * W, false, scr, lane, 3 * W, b * W); continue; }
            r -= 3 * I_BR;
            if (p0_matrix(r, ka->in[9] + (size_t)l * D * D, D, D, (bf16*)(ws + WS_WOUT) + (size_t)l * D * D, false, scr, lane)) continue;
            if (r < NE * I_GU) { if (!I8_P6) { const int e = r / I_GU; int rr = r % I_GU;
                p0_matrix(rr, ka->in[14] + ((size_t)l * NE + e) * D * 2 * DFF, D, 2 * DFF, (bf16*)(ws + WS_WGU) + ((size_t)l * NE + e) * 2 * DFF * D, true, scr, lane); } continue; }
            r -= NE * I_GU;
            { const int e = r / I_D; int rr = r % I_D;
                p0_matrix(rr, ka->in[16] + ((size_t)l * NE + e) * DFF * D, DFF, D, (bf16*)(ws + WS_WD) + ((size_t)l * NE + e) * D * DFF, false, scr, lane); }
        }
        { const float* x_in = ka->in[0]; bf16* XN = (bf16*)(ws + WS_XN); signed char* XQ = (signed char*)(ws + WS_XQ); float* SX = (float*)(ws + WS_SX);
#pragma unroll 1
          for (int m = gw; m < T; m += 2 * NGW) {
              const int mb = (m + NGW < T) ? m + NGW : m;
              if (!(I8_P1 && I8_P6)) { row_to_bf16(x_in + (size_t)m * D, XN + (size_t)m * D, lane); row_to_bf16(x_in + (size_t)mb * D, XN + (size_t)mb * D, lane); }
              if (I8_P1 || I8_P6) { f32x4 v[4], w[4];
#pragma unroll
                  for (int j = 0; j < 4; ++j) { v[j] = ((const GAS f32x4*)(x_in + (size_t)m * D) + lane)[64 * j]; w[j] = ((const GAS f32x4*)(x_in + (size_t)mb * D) + lane)[64 * j]; }
                  quant_row(v, XQ + (size_t)m * D, SX + m, lane); quant_row(w, XQ + (size_t)mb * D, SX + mb, lane); } } }
        { const float* mem_in = ka->in[1]; bf16* MEMB = (bf16*)(ws + WS_MEMB);
#pragma unroll 1
          for (int m = gw; m < MEMT; m += NGW) row_to_bf16(mem_in + (size_t)m * D, MEMB + (size_t)m * D, lane); }
        if (BOTH(0)) GRID_BAR();
    }

#pragma unroll 1
    for (int l = 0; l < DEPTH; ++l) {
        const int pb = 1 + 8 * l;
        if (PH_EN(1) && IN(pb + 0)) REP(1) {
            { PH_LOCALS();
#if I8_P1
              pg8::DenseOrder S{(const char*)(ws + WS_XQ), (const char*)(ws + WS_WIN) + (size_t)l * INW * D, T / 256, INW / 256, G, bx, D / 2};
              pg8::EpiProjQ E{(bf16*)(ws + WS_PROJ), PP, ka->in[3] + (size_t)l * 3 * D, GATE0, GATE0, (unsigned char*)(ws + WS_G8), (const float*)(ws + WS_SX), (const float*)(ws + WS_SWIN) + (size_t)l * INW};
              pg8::gemm_phase<pg8::EpiProjQ, pg8::DenseOrder, false, true, true>(lds + RING_OFF, D / 2, S, E, (unsigned*)(ws + WS_DUMP)); }
#else
              pg8::DenseOrder S{(const char*)(ws + WS_XN), (const char*)((bf16*)(ws + WS_WIN) + (size_t)l * INW * D), T / 256, INW / 256, G, bx, D};
              pg8::EpiProj E{(bf16*)(ws + WS_PROJ), PP, ka->in[3] + (size_t)l * 3 * D, GATE0, GATE0, (unsigned char*)(ws + WS_G8), nullptr, nullptr};
              pg8::gemm_phase<pg8::EpiProj, pg8::DenseOrder, false, true>(lds + RING_OFF, D, S, E, (unsigned*)(ws + WS_DUMP)); }
#endif
            if (l == 0) { PH_LOCALS();
              pg8::DenseOrder S{(const char*)(ws + WS_MEMB), (const char*)(ws + WS_WMEMKV), MEMT / 256, 2048 / 256, G, bx, D};
              pg8::EpiProj E{(bf16*)(ws + WS_MEMKV2), 2048, nullptr, 1 << 30, 0, nullptr, nullptr, nullptr};
              pg8::gemm_phase<pg8::EpiProj, pg8::DenseOrder, false, true>(lds + RING_OFF, D, S, E, (unsigned*)(ws + WS_DUMP)); }
            if (BOTH(pb + 0)) GRID_BAR();
        }
        if (PH_EN(2) && IN(pb + 1)) REP(2) {
            PH_LOCALS();
            const bf16* PROJ = (const bf16*)(ws + WS_PROJ); bf16* YB = (bf16*)(ws + WS_Y);
            { LAS float* tab = (LAS float*)(lds + LDSCTL_OFF) + att::LW_TAB; const float* rel_bias = ka->in[6];
              for (int i = tid; i < 8 * 256; i += NWAVES * 64) tab[i] = rel_bias[t5_bucket((i & 255) - 192) * 8 + (i >> 8)] * att::LOG2E; }
            float lam, outscale;
            { const float* dl = ka->in[4] + (size_t)l * 256; float s1 = 0.f, s2 = 0.f;
              for (int i = 0; i < 64; ++i) { s1 += dl[i] * dl[64 + i]; s2 += dl[128 + i] * dl[192 + i]; }
              const float lam_init = 0.8f - 0.6f * expf(-0.3f * (float)l); lam = expf(s1) - expf(s2) + lam_init; outscale = 1.0f - lam_init; }
            __syncthreads();
            const float* subg = ka->in[5] + (size_t)l * 128;
#pragma unroll 1
            REP(9) for (int it = vcu; ATT_EN(0) && it < BATCH * 4 * 8; it += G) { const int bH = it >> 3, s8 = it & 7;
#pragma unroll 1
                for (int z = 0; z < 2; ++z) att::df_unit(lds, LW, PROJ, YB + W, subg, lam, outscale, bH >> 2, bH & 3, z ? s8 : 15 - s8, wave, lane); }
#pragma unroll 1
            REP(10) for (int u = vcu; ATT_EN(1) && u < BATCH * 8 * 16; u += G) { const int bh = u >> 4, un = u + G, nbh = un >> 4; const bool hn = un < BATCH * 8 * 16;
                att::sb_unit(lds, LW, PROJ, YB, bh >> 3, bh & 7, u & 15, u != vcu, nbh >> 3, nbh & 7, hn ? (un & 15) : -1); }
#pragma unroll 1
            REP(11) for (int u = vcu; ATT_EN(2) && u < BATCH * 4 * 4; u += G) { const int bh = u >> 2; att::mem_unit(lds, LW, PROJ, (const bf16*)(ws + WS_MEMKV2) + l * 1024, YB + 2 * W, bh >> 2, bh & 3, u & 3, wave, lane); }
            if (BOTH(pb + 1)) GRID_BAR();
        }
        if (PH_EN(3) && IN(pb + 2)) REP(3) {
            PH_LOCALS();
            pg8::EpiBranch E{(const unsigned char*)(ws + WS_G8), (bf16*)(ws + WS_MERGED)};
            { pg8::PanelOrder S{(const char*)(ws + WS_Y), (const char*)((bf16*)(ws + WS_WBR) + (size_t)l * D * 3 * W), T / 256, D / 256, G, bx, vcu, 3 * W, false};
              pg8::gemm_phase<pg8::EpiBranch, pg8::PanelOrder, false, true>(lds + RING_OFF, 3 * W, S, E, (unsigned*)(ws + WS_DUMP)); }
            if (BOTH(pb + 2)) GRID_BAR();
        }
        if (PH_EN(4) && IN(pb + 3)) REP(4) {
            PH_LOCALS();
            const float* xprev = (l == 0) ? ka->in[0] : ka->out;
            pg8::EpiOut E{xprev, (float*)(ws + WS_X1)};
            { pg8::PanelOrder S{(const char*)(ws + WS_MERGED), (const char*)((bf16*)(ws + WS_WOUT) + (size_t)l * D * D), T / 256, D / 256, G, bx, vcu, D, false};
              pg8::gemm_phase<pg8::EpiOut, pg8::PanelOrder, false, true>(lds + RING_OFF, D, S, E, (unsigned*)(ws + WS_DUMP)); }
            if (BOTH(pb + 3)) GRID_BAR();
        }
        if (PH_EN(5) && IN(pb + 4)) {
            PH_LOCALS();
            gu32* ctl = (gu32*)(ws + WS_CTL); float* X1 = (float*)(ws + WS_X1); bf16* XN = (bf16*)(ws + WS_XN); int* PERM = (int*)(ws + WS_PERM); float* SLOTW = (float*)(ws + WS_SLOTW); unsigned* SLOTPOS = (unsigned*)(ws + WS_SLOTPOS); float* STATS = (float*)(ws + WS_STATS); signed char* XQ = (signed char*)(ws + WS_XQ); float* SX = (float*)(ws + WS_SX); float* SXP = (float*)(ws + WS_SXP);
            LAS float* WT = (LAS float*)(lds + RING_OFF);
            const float* rw = ka->in[12] + (size_t)l * D * NE; const float* rb = ka->in[13] + (size_t)l * NE;
            { f32x4 wv[16];
#pragma unroll
              for (int it = 0; it < 16; ++it) wv[it] = *(const f32x4*)(rw + tid * 4 + it * (NWAVES * 64 * 4));
              asm volatile("" :: "v"(wv[0]), "v"(wv[1]), "v"(wv[2]), "v"(wv[3]), "v"(wv[4]), "v"(wv[5]), "v"(wv[6]), "v"(wv[7]), "v"(wv[8]), "v"(wv[9]), "v"(wv[10]), "v"(wv[11]), "v"(wv[12]), "v"(wv[13]), "v"(wv[14]), "v"(wv[15]));
#pragma unroll
              for (int it = 0; it < 16; ++it) { const int i = tid * 4 + it * (NWAVES * 64 * 4), k = i >> 5, e = i & 31;
#pragma unroll
                  for (int c = 0; c < 4; ++c) WT[(e + c) * WT_STRIDE + k] = wv[it][c]; } }
            if (tid < NE) LW[LW_RCNT + tid] = 0u;
            __syncthreads();
            const float* g1 = ka->in[10] + (size_t)l * D; const float* b1 = ka->in[11] + (size_t)l * D;
            f32x4 gv[4], bv[4];
#pragma unroll
            for (int j = 0; j < 4; ++j) { gv[j] = *(const f32x4*)(g1 + 256 * j + 4 * lane); bv[j] = *(const f32x4*)(b1 + 256 * j + 4 * lane); }
            const int rows_per_wg = (T + G - 1) / G, rows_per_wave = (((rows_per_wg + NWAVES - 1) / NWAVES) + 1) & ~1;
            const int rbase = vcu * rows_per_wg + wave * rows_per_wave;
            const int myexp = (lane >> 1) & 31;
            const float myrb = rb[myexp];
#pragma unroll 1
            for (int ri = 0; ri < rows_per_wave; ri += 2) {
                const int m0 = rbase + ri;
                const bool ok0 = (m0 < T) && (wave * rows_per_wave + ri) < rows_per_wg, ok1 = (m0 + 1 < T) && (wave * rows_per_wave + ri + 1) < rows_per_wg;
                if (!ok0) break;
                const int m1 = ok1 ? m0 + 1 : m0;
                GAS f32x4* xr0 = (GAS f32x4*)(X1 + (size_t)m0 * D) + lane; GAS f32x4* xr1 = (GAS f32x4*)(X1 + (size_t)m1 * D) + lane;
                f32x4 v0[4], v1[4]; float s0 = 0.f, s1 = 0.f;
#pragma unroll
                for (int j = 0; j < 4; ++j) { v0[j] = xr0[64 * j]; v1[j] = xr1[64 * j]; }
#pragma unroll
                for (int j = 0; j < 4; ++j) { s0 += (v0[j].x + v0[j].y) + (v0[j].z + v0[j].w); s1 += (v1[j].x + v1[j].y) + (v1[j].z + v1[j].w); }
                const float mean0 = wave_sum(s0) * (1.f / D), mean1 = wave_sum(s1) * (1.f / D); float q0 = 0.f, q1 = 0.f;
#pragma unroll
                for (int j = 0; j < 4; ++j) { v0[j] = v0[j] - mean0; v1[j] = v1[j] - mean1;
                    q0 += (v0[j].x * v0[j].x + v0[j].y * v0[j].y) + (v0[j].z * v0[j].z + v0[j].w * v0[j].w); q1 += (v1[j].x * v1[j].x + v1[j].y * v1[j].y) + (v1[j].z * v1[j].z + v1[j].w * v1[j].w); }
                const float rstd0 = 1.f / sqrtf(wave_sum(q0) * (1.f / D) + LN_EPS), rstd1 = 1.f / sqrtf(wave_sum(q1) * (1.f / D) + LN_EPS);
                GAS unsigned long long* o80 = (GAS unsigned long long*)(XN + (size_t)m0 * D) + lane; GAS unsigned long long* o81 = (GAS unsigned long long*)(XN + (size_t)m1 * D) + lane;
#pragma unroll
                for (int j = 0; j < 4; ++j) { v0[j] = v0[j] * rstd0 * gv[j] + bv[j]; v1[j] = v1[j] * rstd1 * gv[j] + bv[j];
                    if (!I8_P6) { o80[64 * j] = (unsigned long long)pk2(v0[j].x, v0[j].y) | ((unsigned long long)pk2(v0[j].z, v0[j].w) << 32);
                        if (ok1) o81[64 * j] = (unsigned long long)pk2(v1[j].x, v1[j].y) | ((unsigned long long)pk2(v1[j].z, v1[j].w) << 32); } }
                if (I8_P6) { quant_row(v0, XQ + (size_t)m0 * D, SX + m0, lane); quant_row(v1, XQ + (size_t)m1 * D, SX + m1, lane); }
                if (lane == 0) { STATS[2 * (size_t)m0] = mean0; STATS[2 * (size_t)m0 + 1] = rstd0; if (ok1) { STATS[2 * (size_t)m1] = mean1; STATS[2 * (size_t)m1 + 1] = rstd1; } }
                float pa[NE], pb[NE];
                {
#pragma unroll
                  for (int e = 0; e < NE; e += 2) { f32x4 w[2][4];
#pragma unroll
                      for (int u = 0; u < 2; ++u)
#pragma unroll
                          for (int j = 0; j < 4; ++j) w[u][j] = *(const LAS f32x4*)(WT + (e + u) * WT_STRIDE + 256 * j + 4 * lane);
                      f32x2 alo[2][2], ahi[2][2];
#pragma unroll
                      for (int u = 0; u < 2; ++u) {
                          alo[0][u] = (f32x2){v0[0].x, v0[0].y} * (f32x2){w[u][0].x, w[u][0].y}; ahi[0][u] = (f32x2){v0[0].z, v0[0].w} * (f32x2){w[u][0].z, w[u][0].w};
                          alo[1][u] = (f32x2){v1[0].x, v1[0].y} * (f32x2){w[u][0].x, w[u][0].y}; ahi[1][u] = (f32x2){v1[0].z, v1[0].w} * (f32x2){w[u][0].z, w[u][0].w}; }
#pragma unroll
                      for (int j = 1; j < 4; ++j)
#pragma unroll
                          for (int u = 0; u < 2; ++u) {
                              alo[0][u] = (f32x2){v0[j].x, v0[j].y} * (f32x2){w[u][j].x, w[u][j].y} + alo[0][u]; ahi[0][u] = (f32x2){v0[j].z, v0[j].w} * (f32x2){w[u][j].z, w[u][j].w} + ahi[0][u];
                              alo[1][u] = (f32x2){v1[j].x, v1[j].y} * (f32x2){w[u][j].x, w[u][j].y} + alo[1][u]; ahi[1][u] = (f32x2){v1[j].z, v1[j].w} * (f32x2){w[u][j].z, w[u][j].w} + ahi[1][u]; }
#pragma unroll
                      for (int u = 0; u < 2; ++u) { const f32x2 ta = alo[0][u] + ahi[0][u], tb = alo[1][u] + ahi[1][u]; pa[e + u] = ta.x + ta.y; pb[e + u] = tb.x + tb.y; } } }
#define RT_SWAP(P, n, SW) _Pragma("unroll") for (int e = 0; e < n; ++e) { auto rr = SW(__float_as_uint(P[e]), __float_as_uint(P[e + n]), false, false); P[e] = __uint_as_float(rr[0]) + __uint_as_float(rr[1]); }
                RT_SWAP(pa, 16, __builtin_amdgcn_permlane32_swap) RT_SWAP(pb, 16, __builtin_amdgcn_permlane32_swap)
                RT_SWAP(pa, 8, __builtin_amdgcn_permlane16_swap) RT_SWAP(pb, 8, __builtin_amdgcn_permlane16_swap)
#undef RT_SWAP
#pragma unroll
                for (int e = 0; e < 4; ++e) { const bool up = (lane & 8) != 0; const float ka_ = up ? pa[e + 4] : pa[e], sa_ = up ? pa[e] : pa[e + 4], kb_ = up ? pb[e + 4] : pb[e], sb_ = up ? pb[e] : pb[e + 4];
                    pa[e] = ka_ + dppf<0x128>(sa_); pb[e] = kb_ + dppf<0x128>(sb_); }
#pragma unroll
                for (int e = 0; e < 2; ++e) { const bool up = (lane & 4) != 0; const float ka_ = up ? pa[e + 2] : pa[e], sa_ = up ? pa[e] : pa[e + 2], kb_ = up ? pb[e + 2] : pb[e], sb_ = up ? pb[e] : pb[e + 2];
                    pa[e] = ka_ + __shfl_xor(sa_, 4); pb[e] = kb_ + __shfl_xor(sb_, 4); }
                { const bool up = (lane & 2) != 0; const float ka_ = up ? pa[1] : pa[0], sa_ = up ? pa[0] : pa[1], kb_ = up ? pb[1] : pb[0], sb_ = up ? pb[0] : pb[1];
                    pa[0] = ka_ + dppf<0x4E>(sa_); pb[0] = kb_ + dppf<0x4E>(sb_); }
                const float la = pa[0] + dppf<0xB1>(pa[0]) + myrb, lb = pb[0] + dppf<0xB1>(pb[0]) + myrb;
                float tva[TOPK], tvb[TOPK]; int tea[TOPK], teb[TOPK];
                { float ca = la, cb = lb;
#pragma unroll
                  for (int k = 0; k < TOPK; ++k) {
                      const float mxa = wave_max(ca), mxb = wave_max(cb);
                      const unsigned long long ma = __ballot(ca == mxa), mb = __ballot(cb == mxb);
                      const int lna = ma ? (int)__builtin_ctzll(ma) : 0, lnb = mb ? (int)__builtin_ctzll(mb) : 0;
                      tea[k] = lna >> 1; teb[k] = lnb >> 1; tva[k] = mxa; tvb[k] = mxb;
                      ca = (myexp == tea[k]) ? -INFINITY : ca; cb = (myexp == teb[k]) ? -INFINITY : cb; } }
                float ewa[TOPK], ewb[TOPK], esa = 0.f, esb = 0.f;
#pragma unroll
                for (int k = 0; k < TOPK; ++k) { ewa[k] = fast_exp(tva[k] - tva[0]); esa += ewa[k]; ewb[k] = fast_exp(tvb[k] - tvb[0]); esb += ewb[k]; }
                const float inva = 1.0f / esa, invb = 1.0f / esb;
                if (lane < 2 * TOPK && (lane < TOPK || ok1)) {
                    const int kk = lane & 3; const bool second = lane >= TOPK;
                    const int ek = second ? (kk == 0 ? teb[0] : kk == 1 ? teb[1] : kk == 2 ? teb[2] : teb[3]) : (kk == 0 ? tea[0] : kk == 1 ? tea[1] : kk == 2 ? tea[2] : tea[3]);
                    const float wk = second ? (kk == 0 ? ewb[0] : kk == 1 ? ewb[1] : kk == 2 ? ewb[2] : ewb[3]) * invb : (kk == 0 ? ewa[0] : kk == 1 ? ewa[1] : kk == 2 ? ewa[2] : ewa[3]) * inva;
                    const unsigned lr = __hip_atomic_fetch_add((LAS unsigned*)(LW + LW_RCNT + ek), 1u, __ATOMIC_RELAXED, __HIP_MEMORY_SCOPE_WORKGROUP);
                    LW[LW_RSLOT + wave * RSLOT_STRIDE + ri * 4 + lane] = ((unsigned)ek << 16) | lr;
                    SLOTW[(size_t)m0 * 4 + lane] = wk;
                }
            }
            __syncthreads();
            if (tid < NE) { const unsigned c = LW[LW_RCNT + tid]; LW[LW_RBASE + tid] = c ? __hip_atomic_fetch_add(ctl + CW_CNT + (l * NE + tid) * 64, c, RLX_AGENT) : 0u; }
            __syncthreads();
            for (int q = lane; q < rows_per_wave * 4; q += 64) { const int ri = q >> 2, m = rbase + ri;
                if (m < T && (wave * rows_per_wave + ri) < rows_per_wg) { const unsigned ent = LW[LW_RSLOT + wave * RSLOT_STRIDE + q]; const unsigned e = ent >> 16, lr = ent & 0xffffu;
                    const unsigned rk = LW[LW_RBASE + e] + lr; PERM[(size_t)e * T + rk] = m * 4 + (q & 3); SLOTPOS[(size_t)m * 4 + (q & 3)] = (e << 16) | rk;
                    if (I8_P6) SXP[(size_t)e * T + rk] = SX[m]; } }
            if (BOTH(pb + 4)) GRID_BAR();
        }
        if ((PH_EN(6) && IN(pb + 5)) || (PH_EN(7) && IN(pb + 6)) || (PH_EN(8) && IN(pb + 7))) {
            PH_LOCALS();
            gu32* ctl = (gu32*)(ws + WS_CTL);
            __syncthreads();
            if (tid < 64) {
                const int c = (tid < NE) ? (int)__hip_atomic_load(ctl + CW_CNT + (l * NE + tid) * 64, RLX_AGENT) : 0;
                int tl = (c + 255) >> 8, inc = tl;
#pragma unroll
                for (int o_ = 1; o_ < 32; o_ <<= 1) { const int nb = __shfl_up(inc, o_); if ((tid & 31) >= o_) inc += nb; }
                if (tid < NE) { LW[LW_LCNT + tid] = (unsigned)c; LW[LW_TOFF + tid] = (unsigned)(inc - tl); if (tid == NE - 1) LW[LW_TOFF + NE] = (unsigned)inc; }
            }
            __syncthreads();
        }
        if (PH_EN(6) && IN(pb + 5)) REP(6) {
            PH_LOCALS();
            const LAS int* toff = (const LAS int*)(lds + LDSCTL_OFF) + LW_TOFF; const LAS int* lcnt = (const LAS int*)(lds + LDSCTL_OFF) + LW_LCNT;
#if I8_P6
            pg8::MoeOrder S{(const char*)(ws + WS_XQ), (const char*)(ws + WS_WGU) + (size_t)l * NE * 2 * DFF * D, 2 * DFF / 256, __builtin_amdgcn_readfirstlane(toff[NE]), G, bx, D / 2, (size_t)2 * DFF * D, toff, lcnt, (const int*)(ws + WS_PERM)};
            pg8::EpiGateUpQ E{(bf16*)(ws + WS_ACT), ka->in[15] + (size_t)l * NE * 2 * DFF, (const float*)(ws + WS_SXP), (const float*)(ws + WS_SWGU) + (size_t)l * NE * 2 * DFF};
            pg8::gemm_phase<pg8::EpiGateUpQ, pg8::MoeOrder, true, true, true>(lds + RING_OFF, D / 2, S, E, (unsigned*)(ws + WS_DUMP));
#else
            pg8::MoeOrder S{(const char*)(ws + WS_XN), (const char*)((bf16*)(ws + WS_WGU) + (size_t)l * NE * 2 * DFF * D), 2 * DFF / 256, __builtin_amdgcn_readfirstlane(toff[NE]), G, bx, D, (size_t)2 * DFF * D * 2, toff, lcnt, (const int*)(ws + WS_PERM)};
            pg8::EpiGateUp E{(bf16*)(ws + WS_ACT), ka->in[15] + (size_t)l * NE * 2 * DFF, nullptr, nullptr};
            pg8::gemm_phase<pg8::EpiGateUp, pg8::MoeOrder, true, true>(lds + RING_OFF, D, S, E, (unsigned*)(ws + WS_DUMP));
#endif
            if (BOTH(pb + 5)) GRID_BAR();
        }
        if (PH_EN(7) && IN(pb + 6)) REP(7) {
            PH_LOCALS();
            const LAS int* toff = (const LAS int*)(lds + LDSCTL_OFF) + LW_TOFF; const LAS int* lcnt = (const LAS int*)(lds + LDSCTL_OFF) + LW_LCNT;
            pg8::MoeDenseOrder S{{(const char*)(ws + WS_ACT), (const char*)((bf16*)(ws + WS_WD) + (size_t)l * NE * D * DFF), D / 256, __builtin_amdgcn_readfirstlane(toff[NE]), G, bx, DFF, (size_t)D * DFF * 2, toff, lcnt, (const int*)(ws + WS_PERM)}};
            pg8::EpiDown E{(bf16*)(ws + WS_CONTRIB), ka->in[17] + (size_t)l * NE * D};
            pg8::gemm_phase<pg8::EpiDown, pg8::MoeDenseOrder, false, true>(lds + RING_OFF, DFF, S, E, (unsigned*)(ws + WS_DUMP));
            if (BOTH(pb + 6)) GRID_BAR();
        }
        if (PH_EN(8) && IN(pb + 7)) REP(8) {
            PH_LOCALS();
            const float* X1 = (const float*)(ws + WS_X1); bf16* XN = (bf16*)(ws + WS_XN); const bf16* CONTRIB = (const bf16*)(ws + WS_CONTRIB); float* outp = ka->out; const unsigned* SLOTPOS = (const unsigned*)(ws + WS_SLOTPOS); const float* SLOTW = (const float*)(ws + WS_SLOTW);
            const float* g2 = ka->in[18] + (size_t)l * D; const float* b2 = ka->in[19] + (size_t)l * D; const float* g1 = ka->in[10] + (size_t)l * D; const float* b1 = ka->in[11] + (size_t)l * D;
            const float* STATS = (const float*)(ws + WS_STATS);
            f32x4 gv[4], bv[4], g1v[4], b1v[4];
#pragma unroll
            for (int j = 0; j < 4; ++j) { gv[j] = *(const f32x4*)(g2 + 256 * j + 4 * lane); bv[j] = *(const f32x4*)(b2 + 256 * j + 4 * lane); g1v[j] = *(const f32x4*)(g1 + 256 * j + 4 * lane); b1v[j] = *(const f32x4*)(b1 + 256 * j + 4 * lane); }
#pragma unroll 1
            for (int m = gw; m < T; m += NGW) {
                const GAS f32x4* xr = (const GAS f32x4*)(X1 + (size_t)m * D) + lane;
                f32x4 v[4]; float s = 0.f;
#pragma unroll
                for (int j = 0; j < 4; ++j) v[j] = xr[64 * j];
                { const float mean1 = STATS[2 * (size_t)m], rstd1 = STATS[2 * (size_t)m + 1];
#pragma unroll
                  for (int j = 0; j < 4; ++j) v[j] = (((v[j] - mean1) * rstd1) * g1v[j] + b1v[j]) * DN_ALPHA; }
#pragma unroll
                for (int k = 0; k < TOPK; ++k) { const unsigned sp = SLOTPOS[(size_t)m * 4 + k]; const float cw = SLOTW[(size_t)m * 4 + k];
                    const size_t srow = (size_t)LW[LW_TOFF + (sp >> 16)] * 256 + (sp & 0xffffu);
                    const GAS v2u* cr = (const GAS v2u*)(CONTRIB + srow * D) + lane;
#pragma unroll
                    for (int j = 0; j < 4; ++j) { const v2u c = cr[64 * j]; v[j].x += cw * bflo(c.x); v[j].y += cw * bfhi(c.x); v[j].z += cw * bflo(c.y); v[j].w += cw * bfhi(c.y); } }
#pragma unroll
                for (int j = 0; j < 4; ++j) s += (v[j].x + v[j].y) + (v[j].z + v[j].w);
                const float mean = wave_sum(s) * (1.f / D); float s2 = 0.f;
#pragma unroll
                for (int j = 0; j < 4; ++j) { v[j] = v[j] - mean; s2 += (v[j].x * v[j].x + v[j].y * v[j].y) + (v[j].z * v[j].z + v[j].w * v[j].w); }
                const float rstd = 1.f / sqrtf(wave_sum(s2) * (1.f / D) + LN_EPS);
                GAS f32x4* orow = (GAS f32x4*)(outp + (size_t)m * D) + lane;
                GAS unsigned long long* o8 = (GAS unsigned long long*)(XN + (size_t)m * D) + lane;
#pragma unroll
                for (int j = 0; j < 4; ++j) { v[j] = v[j] * rstd * gv[j] + bv[j]; orow[64 * j] = v[j];
                    if (l + 1 < DEPTH && !I8_P1) o8[64 * j] = (unsigned long long)pk2(v[j].x, v[j].y) | ((unsigned long long)pk2(v[j].z, v[j].w) << 32); }
                if (l + 1 < DEPTH && I8_P1) quant_row(v, (signed char*)(ws + WS_XQ) + (size_t)m * D, (float*)(ws + WS_SX) + m, lane);
            }
            if (BOTH(pb + 7)) GRID_BAR();
        }
    }
#undef IN
#undef BOTH
}

extern "C" void kernel_launch(void* const* d_in, const int* in_sizes, int n_in, void* d_out, int out_size, void* d_ws, size_t ws_size, hipStream_t stream) {
    static int grid = 0;
    if (grid == 0) {
        if (n_in != 20 || in_sizes[0] != T * D || out_size != T * D || ws_size < WS_END) { fprintf(stderr, "kernel_launch: unexpected shapes / workspace (n_in %d, ws %zu, need %zu)\n", n_in, ws_size, (size_t)WS_END); grid = -1; return; }
        int dev = 0, cus = 0, per_cu = 0;
        if (hipGetDevice(&dev) != hipSuccess || hipDeviceGetAttribute(&cus, hipDeviceAttributeMultiprocessorCount, dev) != hipSuccess) { grid = -1; return; }
        if (hipFuncSetAttribute((const void*)mk_fwd, hipFuncAttributeMaxDynamicSharedMemorySize, LDS_BYTES) != hipSuccess) { fprintf(stderr, "kernel_launch: hipFuncSetAttribute failed\n"); grid = -1; return; }
        if (hipOccupancyMaxActiveBlocksPerMultiprocessor(&per_cu, (const void*)mk_fwd, NWAVES * 64, LDS_BYTES) != hipSuccess || per_cu < 1) fprintf(stderr, "kernel_launch: occupancy query reports %d\n", per_cu);
        (void)hipGetLastError();
        grid = cus;
    }
    if (grid < 0) return;
    (void)hipMemsetAsync((char*)d_ws + WS_CTL, 0, CTL_ZERO_BYTES, stream);
    Args a{};
    for (int i = 0; i < 20; ++i) a.in[i] = (const float*)d_in[i];
    a.out = (float*)d_out; a.ws = (unsigned char*)d_ws;
#if MK_ONE_LAUNCH
    a.ph_lo = 0; a.ph_hi = 1 + 8 * DEPTH;
    hipLaunchKernelGGL(mk_fwd, dim3(grid), dim3(NWAVES * 64), LDS_BYTES, stream, a);
#else
    for (int ph = 0; ph < 1 + 8 * DEPTH; ++ph) {
        a.ph_lo = ph; a.ph_hi = ph + 1;
        hipLaunchKernelGGL(mk_fwd, dim3(grid), dim3(NWAVES * 64), LDS_BYTES, stream, a);
    }
#endif
}
```

```cpp
#include <hip/hip_runtime.h>
#include <cstdio>
#include <cstdint>

#ifndef DIS_MASK
#define DIS_MASK 0
#endif
#define PH_EN(k) (((DIS_MASK) >> (k) & 1) == 0)
#ifndef EPI_TWICE_SEL
#define EPI_TWICE_SEL 0
#endif
#if EPI_TWICE_SEL
#define EPI_TWICE 1
#endif
#ifndef GEMM_SKEW_TICKS
#define GEMM_SKEW_TICKS 0
#endif
#ifndef I8_P1
#define I8_P1 1
#endif
#ifndef I8_P6
#define I8_P6 1
#endif
#ifndef REPEAT_MASK
#define REPEAT_MASK 0
#endif
#define REP(k) for (int rep_ = 0; rep_ < (((REPEAT_MASK) >> (k)) & 1) + 1; ++rep_)
#ifndef ATT_MASK
#define ATT_MASK 0
#endif
#define ATT_EN(k) (((ATT_MASK) >> (k) & 1) == 0)
#ifndef MK_ONE_LAUNCH
#define MK_ONE_LAUNCH 1
#endif

constexpr int BATCH = 16, SEQ = 4096, D = 1024, T = BATCH * SEQ, W = 512, INW = 6656, NE = 32, TOPK = 4, DFF = 1024, MEML = 256, MEMT = BATCH * MEML, DEPTH = 2;
constexpr int GATE0 = 7 * W;
constexpr int PP = GATE0;
constexpr float LN_EPS = 1e-5f, RMS_EPS = 1e-5f;
constexpr float DN_ALPHA = 1.4142135623730951f;
constexpr int NWAVES = 8;

constexpr size_t MiB = 1u << 20;
constexpr size_t WS_CTL = 0, CTL_ZERO_BYTES = 1 * MiB;
constexpr size_t WS_DUMP = 1 * MiB;
constexpr size_t WS_PERM = 2 * MiB;
constexpr size_t WS_SLOTW = 10 * MiB;
constexpr size_t WS_SX = 12 * MiB + 512 * 1024;
constexpr size_t WS_SWIN = 13 * MiB;
constexpr size_t WS_SWGU = 13 * MiB + 256 * 1024;
constexpr size_t WS_STATS = 12 * MiB;
constexpr size_t WS_SLOTPOS = 11 * MiB;
constexpr size_t WS_WIN = 16 * MiB;
constexpr size_t WS_WMEMKV = 42 * MiB;
constexpr size_t WS_WBR = 46 * MiB;
constexpr size_t WS_WOUT = 52 * MiB;
constexpr size_t WS_WGU = 56 * MiB;
constexpr size_t WS_WD = 312 * MiB;
constexpr size_t WS_MEMB = 440 * MiB;
constexpr size_t WS_MEMKV = 448 * MiB;
constexpr size_t WS_XN = 456 * MiB;
constexpr size_t WS_X1 = 584 * MiB;
constexpr size_t WS_BIG = 840 * MiB;
constexpr size_t WS_PROJ = WS_BIG;
constexpr size_t WS_G8 = WS_BIG + 448 * MiB;
constexpr size_t WS_Y = WS_BIG + 832 * MiB;
constexpr size_t WS_MERGED = WS_BIG + 1024 * MiB;
constexpr size_t WS_ACT = WS_BIG;
constexpr size_t WS_CONTRIB = WS_BIG + 528 * MiB;
constexpr size_t WS_MEMKV2 = WS_BIG + 1152 * MiB;
constexpr size_t WS_SXP = WS_MEMKV2 + 16 * MiB;
constexpr size_t WS_XQ = WS_BIG + 1088 * MiB;
constexpr size_t WS_END = WS_SXP + 8 * MiB;
static_assert(WS_CONTRIB + (size_t)528 * MiB <= WS_END && WS_MERGED + (size_t)T * D * 2 <= WS_END, "ws map");

constexpr int CW_TMO = 0, CW_CODE = 1;
constexpr int CW_BAR = 4096;
constexpr int CW_CNT = 32768;

constexpr int RING_OFF = 0, RING_BYTES = 132096;
constexpr int LDSCTL_OFF = RING_BYTES;
constexpr int LDS_BYTES = 163840;
constexpr int LW_BAR = 8;
constexpr int LW_TOFF = 64;
constexpr int LW_LCNT = 128;
constexpr int LW_RCNT = 192;
constexpr int LW_RBASE = 256;
constexpr int LW_RSLOT = 320, RSLOT_STRIDE = 256;

#define GAS __attribute__((address_space(1)))
#define LAS __attribute__((address_space(3)))
typedef unsigned short bf16;
typedef unsigned v4u __attribute__((ext_vector_type(4)));
typedef unsigned v2u __attribute__((ext_vector_type(2)));
typedef float f32x4 __attribute__((ext_vector_type(4)));
typedef float f32x2 __attribute__((ext_vector_type(2)));
typedef short bf16x8 __attribute__((ext_vector_type(8)));
typedef GAS unsigned gu32;
#define RLX_AGENT __ATOMIC_RELAXED, __HIP_MEMORY_SCOPE_AGENT
#define LDS_WAIT() asm volatile("s_waitcnt lgkmcnt(0)" ::: "memory")
#define VM_WAIT() asm volatile("s_waitcnt vmcnt(0)" ::: "memory")

__device__ __forceinline__ unsigned f2bf(float f) { unsigned u = __builtin_bit_cast(unsigned, f); return (u + 0x7fffu + ((u >> 16) & 1u)) >> 16; }
__device__ __forceinline__ unsigned pk2(float lo, float hi) { return f2bf(lo) | (f2bf(hi) << 16); }
__device__ __forceinline__ float bflo(unsigned w) { return __uint_as_float(w << 16); }
__device__ __forceinline__ float bfhi(unsigned w) { return __uint_as_float(w & 0xffff0000u); }
__device__ __forceinline__ float bf2f(bf16 b) { return __uint_as_float((unsigned)b << 16); }
__device__ __forceinline__ float fast_exp(float x) { return __builtin_amdgcn_exp2f(x * 1.4426950408889634f); }
__device__ __forceinline__ float fast_sigmoid(float x) { return __builtin_amdgcn_rcpf(1.0f + fast_exp(-x)); }

__device__ __forceinline__ int lane_opaque() { int l = (int)__builtin_amdgcn_mbcnt_hi(~0u, __builtin_amdgcn_mbcnt_lo(~0u, 0u)); asm volatile("" : "+v"(l)); return l; }
__device__ __forceinline__ int tid_opaque() { int t = threadIdx.x; asm volatile("" : "+v"(t)); return t; }
namespace pg8 {
#define PG8_LAS __attribute__((address_space(3)))
typedef unsigned short bf16_t;
typedef unsigned u32x4 __attribute__((ext_vector_type(4)));
typedef int i32x4 __attribute__((ext_vector_type(4)));
constexpr int BM = 256, BK = 64, HALF = 128, HTB = HALF * BK * 2, STAGE_BYTES = 8 * HTB, NXCD = 8, WGM = 8;
constexpr int EPI_BUF_OFF = 132096 + 4096, EPI_BUF_BYTES = 3072;

__host__ __device__ __forceinline__ int lds_byte(int r, int c) { const int st = (r >> 4) * 2 + (c >> 5), rr = r & 15, cc = c & 31, ob = rr * 64 + cc * 2; return st * 1024 + (ob ^ (((ob >> 9) & 1) << 5)); }
__host__ __device__ __forceinline__ void stage_rc(int b, int& R, int& C) { const int st = b / 1024, sb = b % 1024, swz = sb ^ (((sb >> 9) & 1) << 5); R = (st >> 1) * 16 + swz / 64; C = (st & 1) * 32 + (swz % 64) / 2; }
__host__ __device__ __forceinline__ int perm32(int rho) { const int n = rho >> 4, i = rho & 15; return 8 * (i >> 2) + 4 * n + (i & 3); }

struct Unit { int pm, pn, e, rt; };

__device__ __forceinline__ bool tile_order(long L, int nM, int nN, int& pm, int& pn) {
    const int nwg = nM * nN; if (L >= nwg) return false;
    int wgid = (int)L; { const int q = nwg / NXCD, r = nwg % NXCD, xcd = wgid % NXCD, off = wgid / NXCD; wgid = (xcd < r ? xcd * (q + 1) : r * (q + 1) + (xcd - r) * q) + off; }
    const int nig = WGM * nN, gid = wgid / nig, fm = gid * WGM, gsz = (nM - fm) < WGM ? (nM - fm) : WGM;
    const int w = wgid % nig;
    if (gsz == WGM) { pm = fm + (w % WGM); pn = w / WGM; } else { pm = fm + (w % gsz); pn = w / gsz; }
    return true;
}

__device__ __forceinline__ unsigned cvt_pk_bf16(float lo, float hi) { unsigned r; asm volatile("v_cvt_pk_bf16_f32 %0, %1, %2" : "=v"(r) : "v"(lo), "v"(hi)); return r; }

template <class Epi, class Sched, bool GATHER, bool ALIGN_EPI, bool I8 = false>
__device__ __forceinline__ void gemm_phase(PG8_LAS unsigned char* lds, const int K, const Sched& S, const Epi& E, unsigned* dump  ) {
    const int tid = tid_opaque();
    const int wid = __builtin_amdgcn_readfirstlane(tid >> 6), lane = tid & 63, wr = wid >> 2, wc = wid & 3, fr = lane & 15, fq = lane >> 4;
    int nt = K / BK; asm volatile("" : "+s"(nt));
    unsigned voffA[2], voffB[2]; int gR[2], gC[2];
#pragma unroll
    for (int i = 0; i < 2; ++i) { int R, C; stage_rc(tid * 16 + i * 8192, R, C); const int Rb = Epi::PERM ? ((R & ~31) + perm32(R & 31)) : R;
        voffA[i] = (unsigned)(R * K + C) * 2u; voffB[i] = (unsigned)(Rb * K + C) * 2u; gR[i] = R; gC[i] = C * 2; }
    const size_t kstep = (size_t)(BK * 2);
    const size_t hstep = (size_t)HALF * K * 2;
    const unsigned ldsw = (unsigned)wid * 1024u;
    const int aoff = lds_byte(wr * 64 + fr, fq * 8), boff = lds_byte(wc * 32 + fr, fq * 8);
#define PG8_SA(b, h) (((b) * 2 + (h)) * HTB)
#define PG8_SB(b, h) ((4 + (b) * 2 + (h)) * HTB)
#define PG8_STAGE(bufoff, gbase, voff) do { _Pragma("unroll") for (int _i = 0; _i < 2; ++_i) \
        __builtin_amdgcn_global_load_lds((const unsigned*)((const char*)(gbase) + (voff)[_i]), (PG8_LAS unsigned*)(lds + (bufoff) + ldsw + _i * 8192), 16, 0, 0); } while (0)
#define PG8_STAGE_A(bufoff, kptr, h, G) do { if constexpr (GATHER) { PG8_STAGE(bufoff, kptr, (G)[h]); } else { PG8_STAGE(bufoff, (kptr) + (h) * hstep, voffA); } } while (0)
#define PG8_LDA(dst, b, h) do { _Pragma("unroll") for (int m = 0; m < 4; ++m) _Pragma("unroll") for (int k = 0; k < 2; ++k) dst[m][k] = *(const PG8_LAS bf16x8*)(lds + PG8_SA(b, h) + aoff + m * 2048 + k * 1024); } while (0)
#define PG8_LDB(dst, b, h) do { _Pragma("unroll") for (int n = 0; n < 2; ++n) _Pragma("unroll") for (int k = 0; k < 2; ++k) dst[n][k] = *(const PG8_LAS bf16x8*)(lds + PG8_SB(b, h) + boff + n * 2048 + k * 1024); } while (0)
#define PG8_MMA(ai, bj, At, Bt) do { __builtin_amdgcn_s_setprio(1); _Pragma("unroll") for (int m = 0; m < 4; ++m) _Pragma("unroll") for (int n = 0; n < 2; ++n) _Pragma("unroll") for (int k = 0; k < 2; ++k) { \
        if constexpr (I8) acc[ai][bj][m][n] = __builtin_bit_cast(f32x4, __builtin_amdgcn_mfma_i32_16x16x64_i8(__builtin_bit_cast(i32x4, Bt[n][k]), __builtin_bit_cast(i32x4, At[m][k]), __builtin_bit_cast(i32x4, acc[ai][bj][m][n]), 0, 0, 0)); \
        else acc[ai][bj][m][n] = __builtin_amdgcn_mfma_f32_16x16x32_bf16(Bt[n][k], At[m][k], acc[ai][bj][m][n], 0, 0, 0); } __builtin_amdgcn_s_setprio(0); } while (0)
#define PG8_WAIT_V(n) asm volatile("s_waitcnt vmcnt(" #n ")" ::: "memory")
#define PG8_WAIT_V8R(t) asm volatile("s_cmp_lg_u32 %0, 0\n\ts_cbranch_scc1 1f\n\ts_waitcnt vmcnt(%1)\n\ts_branch 2f\n1:\n\ts_waitcnt vmcnt(8)\n2:" :: "s"(t), "n"(8 + Epi::NSTORES) : "memory", "scc")
#define PG8_WAIT_L(n) asm volatile("s_waitcnt lgkmcnt(" #n ")" ::: "memory")
#define PG8_BAR __builtin_amdgcn_s_barrier()
#define PG8_SCHED __builtin_amdgcn_sched_barrier(0)
    Unit cur, nxt; int ui = 0;
    if (!S.next(0, cur)) return;
#if GEMM_SKEW_TICKS
    { const unsigned long long t0_ = __builtin_amdgcn_s_memrealtime(); const unsigned long long want_ = (unsigned long long)((blockIdx.x >> 3) & 7) * GEMM_SKEW_TICKS;
      while (__builtin_amdgcn_s_memrealtime() - t0_ < want_) __builtin_amdgcn_s_sleep(8); }
#endif
    f32x4 acc[2][2][4][2];
#pragma unroll
    for (int a = 0; a < 2; ++a)
#pragma unroll
        for (int b = 0; b < 2; ++b)
#pragma unroll
            for (int m = 0; m < 4; ++m)
#pragma unroll
                for (int n = 0; n < 2; ++n) acc[a][b][m][n] = (f32x4){0.f, 0.f, 0.f, 0.f};
    bf16x8 At[4][2], B0[2][2], B1[2][2];
    unsigned cG[2][2] = {{0u, 0u}, {0u, 0u}}, nG[2][2] = {{0u, 0u}, {0u, 0u}}, sG[2][2] = {{0u, 0u}, {0u, 0u}};
    if constexpr (GATHER) S.gather(cur, gR, gC, K, cG);
    if constexpr (GATHER) asm volatile("" : "+v"(cG[0][0]), "+v"(cG[0][1]), "+v"(cG[1][0]), "+v"(cG[1][1]));
    const char* cA = S.a_base(cur); const char* cB = S.b_base(cur);
    PG8_STAGE(PG8_SB(0, 0), cB, voffB); PG8_STAGE(PG8_SB(0, 1), cB + hstep, voffB); PG8_STAGE_A(PG8_SA(0, 0), cA, 0, cG); PG8_STAGE_A(PG8_SA(0, 1), cA, 1, cG);
    if (wr == 1) PG8_BAR;
    PG8_WAIT_V(2); PG8_BAR;
    PG8_STAGE(PG8_SB(1, 0), cB + kstep, voffB); PG8_STAGE_A(PG8_SA(1, 0), cA + kstep, 0, cG); PG8_STAGE(PG8_SB(1, 1), cB + hstep + kstep, voffB);
    PG8_WAIT_V(6); PG8_BAR;
    if constexpr (Epi::NSTORES > 0) {
        unsigned* dp = dump + (size_t)blockIdx.x * 512 + tid;
#pragma unroll
        for (int i = 0; i < Epi::NSTORES; ++i) asm volatile("global_store_dword %0, %1, off" :: "v"(dp), "v"(i) : "memory"); }
    for (;;) {
        const bool has_next = S.next(ui + 1, nxt);
        const char* nA = has_next ? S.a_base(nxt) : cA; const char* nB = has_next ? S.b_base(nxt) : cB;
        const PG8_LAS float* eb = (const PG8_LAS float*)(lds + EPI_BUF_OFF + (ui & 1) * EPI_BUF_BYTES);
        if constexpr (Epi::PREF) E.prefetch(cur, (PG8_LAS unsigned char*)eb, wid);
        if constexpr (GATHER) { if (has_next && wid == 3) S.stage_idx(nxt, lds + 2 * STAGE_BYTES / 2, lane); }
#pragma unroll 1
        for (int t = 0; t < nt; t += 2) {
            const bool last = (t == nt - 2);
            const char* a1 = cA + (size_t)(t + 1) * kstep;
            const char* a2 = last ? nA : cA + (size_t)(t + 2) * kstep; const char* b2 = last ? nB : cB + (size_t)(t + 2) * kstep;
            const char* a3 = a2 + kstep; const char* b3 = b2 + kstep;
            if constexpr (GATHER) {
                if (last) { if (has_next) S.gather_lds(nxt, gR, gC, K, nG, (const PG8_LAS int*)(lds + 2 * STAGE_BYTES / 2)); else { nG[0][0] = cG[0][0]; nG[0][1] = cG[0][1]; nG[1][0] = cG[1][0]; nG[1][1] = cG[1][1]; }
                    asm volatile("" : "+v"(nG[0][0]), "+v"(nG[0][1]), "+v"(nG[1][0]), "+v"(nG[1][1])); }
                sG[0][0] = last ? nG[0][0] : cG[0][0]; sG[0][1] = last ? nG[0][1] : cG[0][1]; sG[1][0] = last ? nG[1][0] : cG[1][0]; sG[1][1] = last ? nG[1][1] : cG[1][1]; }
            PG8_LDB(B0, 0, 0); PG8_LDB(B1, 0, 1); PG8_SCHED; PG8_LDA(At, 0, 0); PG8_STAGE_A(PG8_SA(1, 1), a1, 1, cG);
            PG8_WAIT_V8R(t); PG8_WAIT_L(0); PG8_BAR; PG8_MMA(0, 0, At, B0); PG8_MMA(0, 1, At, B1); PG8_BAR; PG8_SCHED;
            PG8_LDA(At, 0, 1); PG8_STAGE(PG8_SB(0, 0), b2, voffB); PG8_STAGE(PG8_SB(0, 1), b2 + hstep, voffB); PG8_STAGE_A(PG8_SA(0, 0), a2, 0, sG);
            PG8_WAIT_V8R(t); PG8_WAIT_L(0); PG8_BAR; PG8_MMA(1, 0, At, B0); PG8_MMA(1, 1, At, B1); PG8_BAR; PG8_SCHED;
            PG8_LDB(B0, 1, 0); PG8_LDB(B1, 1, 1); PG8_SCHED; PG8_LDA(At, 1, 0); PG8_STAGE_A(PG8_SA(0, 1), a2, 1, sG);
            PG8_WAIT_V(8); PG8_WAIT_L(0); PG8_BAR; PG8_MMA(0, 0, At, B0); PG8_MMA(0, 1, At, B1); PG8_BAR; PG8_SCHED;
            PG8_LDA(At, 1, 1); PG8_STAGE(PG8_SB(1, 0), b3, voffB); PG8_STAGE(PG8_SB(1, 1), b3 + hstep, voffB); PG8_STAGE_A(PG8_SA(1, 0), a3, 0, sG);
            PG8_WAIT_V(8); PG8_WAIT_L(0); PG8_BAR; PG8_MMA(1, 0, At, B0); PG8_MMA(1, 1, At, B1); PG8_BAR; PG8_SCHED;
            if constexpr (Epi::HAS_MID) { if (t == 6 || t == 14) E.mid(acc, cur, wr, wc, fr, fq, (t + 2) >> 3); }
        }
        if constexpr (ALIGN_EPI) { if (wr == 0) PG8_BAR; }
        E(acc, cur, wr, wc, fr, fq, eb);
#if defined(EPI_TWICE)
        if constexpr (Epi::TWICE) { asm volatile("" ::: "memory"); E(acc, cur, wr, wc, fr, fq, eb); }
#endif
        if constexpr (Epi::DRAIN_AFTER) __builtin_amdgcn_s_waitcnt(0x0F70);
        if (!has_next) break;
#pragma unroll
        for (int a = 0; a < 2; ++a)
#pragma unroll
            for (int b = 0; b < 2; ++b)
#pragma unroll
                for (int m = 0; m < 4; ++m)
#pragma unroll
                    for (int n = 0; n < 2; ++n) acc[a][b][m][n] = (f32x4){0.f, 0.f, 0.f, 0.f};
        cur = nxt; cA = nA; cB = nB; ++ui;
        if constexpr (GATHER) { cG[0][0] = nG[0][0]; cG[0][1] = nG[0][1]; cG[1][0] = nG[1][0]; cG[1][1] = nG[1][1]; }
        if constexpr (ALIGN_EPI) { if (wr == 1) PG8_BAR; }
    }
    PG8_WAIT_V(0);
    if constexpr (!ALIGN_EPI) { if (wr == 0) PG8_BAR; }
    PG8_BAR;
#undef PG8_SA
#undef PG8_SB
#undef PG8_STAGE
#undef PG8_STAGE_A
#undef PG8_LDA
#undef PG8_LDB
#undef PG8_MMA
#undef PG8_WAIT_V
#undef PG8_WAIT_V8R
#undef PG8_WAIT_L
#undef PG8_BAR
#undef PG8_SCHED
}

struct DenseOrder {
    const char* A; const char* Bt; int nM, nN, G, c, K;
    __device__ __forceinline__ bool next(int i, Unit& u) const { u.e = 0; u.rt = 0; return tile_order((long)i * G + c, nM, nN, u.pm, u.pn); }
    __device__ __forceinline__ const char* a_base(const Unit& u) const { return A + (size_t)u.pm * BM * K * 2; }
    __device__ __forceinline__ const char* b_base(const Unit& u) const { return Bt + (size_t)u.pn * BM * K * 2; }
};
struct PanelOrder {
    const char* A; const char* Bt; int nM, nN, G, c, v, K; bool own;
    __device__ __forceinline__ bool next(int i, Unit& u) const { u.e = 0; u.rt = 0; if (own) { u.pm = v; u.pn = i; return i < nN; } return tile_order((long)i * G + c, nM, nN, u.pm, u.pn); }
    __device__ __forceinline__ const char* a_base(const Unit& u) const { return A + (size_t)u.pm * BM * K * 2; }
    __device__ __forceinline__ const char* b_base(const Unit& u) const { return Bt + (size_t)u.pn * BM * K * 2; }
};
struct MoeOrder {
    const char* A; const char* Wt; int nN, NT, G, c, K; size_t wstride;
    const PG8_LAS int* toff; const PG8_LAS int* lcnt; const int* perm;
    __device__ __forceinline__ bool next(int i, Unit& u) const {
        if (!tile_order((long)i * G + c, NT, nN, u.pm, u.pn)) return false;
        const int j = (int)__builtin_amdgcn_mbcnt_lo(~0u, 0u);
        const int e = __builtin_popcountll(__builtin_amdgcn_ballot_w64(j >= 1 && j < NE && toff[j] <= u.pm));
        u.e = e; u.rt = u.pm - toff[e]; return true;
    }
    __device__ __forceinline__ const char* a_base(const Unit& u) const { return A; }
    __device__ __forceinline__ const char* a_dense(const Unit& u) const { return A + (size_t)u.pm * BM * K * 2; }
    __device__ __forceinline__ const char* b_base(const Unit& u) const { return Wt + (size_t)u.e * wstride + (size_t)u.pn * BM * K * 2; }
    __device__ __forceinline__ void stage_idx(const Unit& u, PG8_LAS unsigned char* dst, int lane) const {
        const unsigned off = ((unsigned)(u.e * T + u.rt * BM) + (unsigned)lane_opaque() * 4u) * 4u;
        __builtin_amdgcn_global_load_lds((const unsigned*)((const char*)perm + off), (PG8_LAS unsigned*)dst, 16, 0, 0); }
    __device__ __forceinline__ void gather_lds(const Unit& u, const int (&gR)[2], const int (&gC)[2], int K_, unsigned (&Gv)[2][2], const PG8_LAS int* idx) const {
        const int n = lcnt[u.e] - u.rt * BM;
#pragma unroll
        for (int h = 0; h < 2; ++h)
#pragma unroll
            for (int i = 0; i < 2; ++i) { const int r = h * HALF + gR[i]; const int tok = (r < n) ? (idx[r] >> 2) : 0; Gv[h][i] = (unsigned)tok * (unsigned)(K_ * 2) + (unsigned)gC[i]; }
    }
    __device__ __forceinline__ void gather(const Unit& u, const int (&gR)[2], const int (&gC)[2], int K_, unsigned (&Gv)[2][2]) const {
        const int n = lcnt[u.e] - u.rt * BM; const int* p = perm + (size_t)u.e * T + u.rt * BM;
#pragma unroll
        for (int h = 0; h < 2; ++h)
#pragma unroll
            for (int i = 0; i < 2; ++i) { const int r = h * HALF + gR[i]; const int tok = (r < n) ? (p[r] >> 2) : 0; Gv[h][i] = (unsigned)tok * (unsigned)(K_ * 2) + (unsigned)gC[i]; }
    }
};
struct MoeDenseOrder : MoeOrder {
    __device__ __forceinline__ const char* a_base(const Unit& u) const { return a_dense(u); }
};

template <bool Q8> struct EpiProjT {
    static constexpr bool PERM = true, DRAIN_AFTER = false, TWICE = (EPI_TWICE_SEL == 1), HAS_MID = false; static constexpr int NSTORES = TWICE ? 0 : 16;
    static constexpr bool PREF = Q8;
    bf16_t* O; int ldc; const float* bias; int act_from; int qscale_upto;
    unsigned char* G8;
    const float* sxr; const float* swc;
    __device__ __forceinline__ void prefetch(const Unit& u, PG8_LAS unsigned char* buf, int wid) const {
        const int colt = u.pn * BM, ln4 = lane_opaque() * 4;
        if (wid == 0) { if (colt >= act_from) __builtin_amdgcn_global_load_lds((const unsigned*)(bias + (colt - act_from) + ln4), (PG8_LAS unsigned*)buf, 16, 0, 0); }
        else if (wid == 1) __builtin_amdgcn_global_load_lds((const unsigned*)(swc + colt + ln4), (PG8_LAS unsigned*)(buf + 1024), 16, 0, 0);
        else if (wid == 2) __builtin_amdgcn_global_load_lds((const unsigned*)(sxr + u.pm * BM + ln4), (PG8_LAS unsigned*)(buf + 2048), 16, 0, 0); }
    __device__ __forceinline__ void operator()(const f32x4 (&acc)[2][2][4][2], const Unit& u, int wr, int wc, int fr, int fq, const PG8_LAS float* eb) const {
        const int row0 = u.pm * BM + wr * 64 + fr, colt = u.pn * BM, col0 = colt + wc * 32 + 8 * fq;
        const bool gate = colt >= act_from;
        float qs = 1.0f;
        if (colt < qscale_upto) { const int seg = colt / W; qs = (seg == 0 || seg == 3) ? 0.125f * 1.4426950408889634f : (seg == 6 ? 0.08838834764831845f * 1.4426950408889634f : 1.0f); }
        f32x4 bv[2][2], sw[2][2]; float rsc[2][4];
#pragma unroll
        for (int bj = 0; bj < 2; ++bj)
#pragma unroll
            for (int n = 0; n < 2; ++n) { const int cl = wc * 32 + 8 * fq + bj * HALF + 4 * n;
                if constexpr (Q8) { bv[bj][n] = gate ? *(const PG8_LAS f32x4*)(eb + cl) : (f32x4){0.f, 0.f, 0.f, 0.f}; sw[bj][n] = *(const PG8_LAS f32x4*)(eb + 256 + cl); }
                else { bv[bj][n] = gate ? *(const f32x4*)(bias + (col0 - act_from) + bj * HALF + 4 * n) : (f32x4){0.f, 0.f, 0.f, 0.f}; sw[bj][n] = (f32x4){1.f, 1.f, 1.f, 1.f}; } }
#pragma unroll
        for (int ai = 0; ai < 2; ++ai)
#pragma unroll
            for (int m = 0; m < 4; ++m) rsc[ai][m] = Q8 ? eb[512 + wr * 64 + fr + ai * HALF + m * 16] * qs : qs;
        if (gate) {
#pragma unroll
            for (int bj = 0; bj < 2; ++bj)
#pragma unroll
                for (int n = 0; n < 2; ++n) { bv[bj][n] = bv[bj][n] * -1.4426950408889634f; sw[bj][n] = sw[bj][n] * -1.4426950408889634f; } }
#pragma unroll
        for (int ai = 0; ai < 2; ++ai)
#pragma unroll
            for (int m = 0; m < 4; ++m) { bf16_t* rowp = O + (size_t)(row0 + ai * HALF + m * 16) * ldc + col0;
                const float rs = rsc[ai][m]; const f32x2 rs2 = (f32x2){rs, rs};
#pragma unroll
                for (int bj = 0; bj < 2; ++bj) {
                    f32x2 t[2][2];
#pragma unroll
                    for (int n = 0; n < 2; ++n) { const f32x4 a = acc[ai][bj][m][n];
                        if constexpr (Q8) { const i32x4 ia = __builtin_bit_cast(i32x4, a); t[n][0] = (f32x2){(float)ia[0], (float)ia[1]} * rs2; t[n][1] = (f32x2){(float)ia[2], (float)ia[3]} * rs2; }
                        else { t[n][0] = (f32x2){a[0], a[1]} * rs2; t[n][1] = (f32x2){a[2], a[3]} * rs2; } }
                    if (gate) {
                        unsigned g[2] = {0u, 0u};
#pragma unroll
                        for (int n = 0; n < 2; ++n)
#pragma unroll
                            for (int p = 0; p < 2; ++p) {
                                f32x2 e = t[n][p] * (f32x2){sw[bj][n][2 * p], sw[bj][n][2 * p + 1]} + (f32x2){bv[bj][n][2 * p], bv[bj][n][2 * p + 1]};
                                e.x = __builtin_amdgcn_exp2f(e.x); e.y = __builtin_amdgcn_exp2f(e.y);
                                e = e * (f32x2){1.0f / 255.0f, 1.0f / 255.0f} + (f32x2){1.0f / 255.0f, 1.0f / 255.0f};
                                g[n] = __builtin_amdgcn_cvt_pk_u8_f32(__builtin_rintf(__builtin_amdgcn_rcpf(e.x)), 2 * p, g[n]);
                                g[n] = __builtin_amdgcn_cvt_pk_u8_f32(__builtin_rintf(__builtin_amdgcn_rcpf(e.y)), 2 * p + 1, g[n]); }
                        *(v2u*)(G8 + (size_t)(row0 + ai * HALF + m * 16) * (3 * D) + (col0 - act_from) + bj * HALF) = (v2u){g[0], g[1]};
                        continue; }
                    u32x4 w;
                    { const f32x2 o0 = t[0][0] * (f32x2){sw[bj][0][0], sw[bj][0][1]}, o1 = t[0][1] * (f32x2){sw[bj][0][2], sw[bj][0][3]}, o2 = t[1][0] * (f32x2){sw[bj][1][0], sw[bj][1][1]}, o3 = t[1][1] * (f32x2){sw[bj][1][2], sw[bj][1][3]};
                      w.x = cvt_pk_bf16(o0.x, o0.y); w.y = cvt_pk_bf16(o1.x, o1.y); w.z = cvt_pk_bf16(o2.x, o2.y); w.w = cvt_pk_bf16(o3.x, o3.y); }
                    __builtin_nontemporal_store(w, (u32x4*)(rowp + bj * HALF)); } }
    }
};
typedef EpiProjT<false> EpiProj; typedef EpiProjT<true> EpiProjQ;
struct EpiBranch {
    static constexpr bool PERM = true, DRAIN_AFTER = false, TWICE = false, HAS_MID = true, PREF = false; static constexpr int NSTORES = 16;
    const unsigned char* G8; bf16_t* Mg;
    static __device__ __forceinline__ float ub(unsigned w, int i) { return (float)((w >> (8 * i)) & 0xffu); }
    __device__ __forceinline__ void mid(f32x4 (&acc)[2][2][4][2], const Unit& u, int wr, int wc, int fr, int fq, int seg  ) const {
        asm volatile("" : "+v"(fr), "+v"(fq));
        const int row0 = u.pm * BM + wr * 64 + fr, col0 = u.pn * BM + wc * 32 + 8 * fq;
        v2u gn[2][4][2], gd[2][4][2];
#pragma unroll
        for (int ai = 0; ai < 2; ++ai)
#pragma unroll
            for (int m = 0; m < 4; ++m) { const unsigned char* gp = G8 + (size_t)(row0 + ai * HALF + m * 16) * (3 * D) + (seg - 1) * D + col0;
#pragma unroll
                for (int bj = 0; bj < 2; ++bj) { gn[ai][m][bj] = *(const v2u*)(gp + bj * HALF); gd[ai][m][bj] = *(const v2u*)(gp + D + bj * HALF); } }
        asm volatile("" :: "v"(gn[0][0][0]), "v"(gn[0][0][1]), "v"(gn[0][1][0]), "v"(gn[0][1][1]), "v"(gn[0][2][0]), "v"(gn[0][2][1]), "v"(gn[0][3][0]), "v"(gn[0][3][1]),
                           "v"(gn[1][0][0]), "v"(gn[1][0][1]), "v"(gn[1][1][0]), "v"(gn[1][1][1]), "v"(gn[1][2][0]), "v"(gn[1][2][1]), "v"(gn[1][3][0]), "v"(gn[1][3][1]));
        asm volatile("" :: "v"(gd[0][0][0]), "v"(gd[0][0][1]), "v"(gd[0][1][0]), "v"(gd[0][1][1]), "v"(gd[0][2][0]), "v"(gd[0][2][1]), "v"(gd[0][3][0]), "v"(gd[0][3][1]),
                           "v"(gd[1][0][0]), "v"(gd[1][0][1]), "v"(gd[1][1][0]), "v"(gd[1][1][1]), "v"(gd[1][2][0]), "v"(gd[1][2][1]), "v"(gd[1][3][0]), "v"(gd[1][3][1]));
#pragma unroll
        for (int ai = 0; ai < 2; ++ai)
#pragma unroll
            for (int m = 0; m < 4; ++m)
#pragma unroll
                for (int bj = 0; bj < 2; ++bj) { const v2u n_ = gn[ai][m][bj], d_ = gd[ai][m][bj];
                    f32x4& a0 = acc[ai][bj][m][0]; f32x4& a1 = acc[ai][bj][m][1];
#pragma unroll
                    for (int j = 0; j < 4; ++j) { a0[j] *= ub(n_.x, j) * __builtin_amdgcn_rcpf(__builtin_fmaxf(ub(d_.x, j), 1.0f)); a1[j] *= ub(n_.y, j) * __builtin_amdgcn_rcpf(__builtin_fmaxf(ub(d_.y, j), 1.0f)); } }
    }
    __device__ __forceinline__ void operator()(const f32x4 (&acc)[2][2][4][2], const Unit& u, int wr, int wc, int fr, int fq, const PG8_LAS float* eb) const {
        const int row0 = u.pm * BM + wr * 64 + fr, col0 = u.pn * BM + wc * 32 + 8 * fq;
        v2u gl[2][4][2];
#pragma unroll
        for (int ai = 0; ai < 2; ++ai)
#pragma unroll
            for (int m = 0; m < 4; ++m) { const unsigned char* gp = G8 + (size_t)(row0 + ai * HALF + m * 16) * (3 * D) + 2 * D + col0;
#pragma unroll
                for (int bj = 0; bj < 2; ++bj) gl[ai][m][bj] = *(const v2u*)(gp + bj * HALF); }
        asm volatile("" :: "v"(gl[0][0][0]), "v"(gl[0][0][1]), "v"(gl[0][1][0]), "v"(gl[0][1][1]), "v"(gl[0][2][0]), "v"(gl[0][2][1]), "v"(gl[0][3][0]), "v"(gl[0][3][1]),
                           "v"(gl[1][0][0]), "v"(gl[1][0][1]), "v"(gl[1][1][0]), "v"(gl[1][1][1]), "v"(gl[1][2][0]), "v"(gl[1][2][1]), "v"(gl[1][3][0]), "v"(gl[1][3][1]));
#pragma unroll
        for (int ai = 0; ai < 2; ++ai)
#pragma unroll
            for (int m = 0; m < 4; ++m) { const size_t row = (size_t)(row0 + ai * HALF + m * 16);
                bf16_t* mp = Mg + row * D + col0;
#pragma unroll
                for (int bj = 0; bj < 2; ++bj) {
                    const v2u g = gl[ai][m][bj]; const f32x4 a0 = acc[ai][bj][m][0], a1 = acc[ai][bj][m][1];
                    float r0[4], r1[4];
#pragma unroll
                    for (int j = 0; j < 4; ++j) { r0[j] = __builtin_fmaxf(ub(g.x, j), 1.0f) * (1.0f / 255.0f) * a0[j]; r1[j] = __builtin_fmaxf(ub(g.y, j), 1.0f) * (1.0f / 255.0f) * a1[j]; }
                    u32x4 w; w.x = cvt_pk_bf16(r0[0], r0[1]); w.y = cvt_pk_bf16(r0[2], r0[3]); w.z = cvt_pk_bf16(r1[0], r1[1]); w.w = cvt_pk_bf16(r1[2], r1[3]);
                    *(u32x4*)(mp + bj * HALF) = w; } }
    }
};
struct EpiOut {
    static constexpr bool PERM = false, DRAIN_AFTER = false, TWICE = (EPI_TWICE_SEL == 4), HAS_MID = false, PREF = false; static constexpr int NSTORES = TWICE ? 0 : 32;
    const float* X; float* V1;
    __device__ __forceinline__ void operator()(const f32x4 (&acc)[2][2][4][2], const Unit& u, int wr, int wc, int fr, int fq, const PG8_LAS float* eb) const {
        const int row0 = u.pm * BM + wr * 64 + fr, col0 = u.pn * BM + wc * 32 + 4 * fq;
#pragma unroll
        for (int ai = 0; ai < 2; ++ai)
#pragma unroll
            for (int m = 0; m < 4; ++m) { const size_t off = (size_t)(row0 + ai * HALF + m * 16) * D + col0;
#pragma unroll
                for (int bj = 0; bj < 2; ++bj)
#pragma unroll
                    for (int n = 0; n < 2; ++n) { const f32x4 xv = *(const f32x4*)(X + off + bj * HALF + n * 16); *(f32x4*)(V1 + off + bj * HALF + n * 16) = xv * DN_ALPHA + acc[ai][bj][m][n]; } }
    }
};
template <bool Q8> struct EpiGateUpT {
    static constexpr bool PERM = true, DRAIN_AFTER = false, TWICE = (EPI_TWICE_SEL == 6), HAS_MID = false, PREF = Q8; static constexpr int NSTORES = TWICE ? 0 : 8;
    bf16_t* Act; const float* bgu;
    const float* sxp; const float* swr;
    __device__ __forceinline__ void prefetch(const Unit& u, PG8_LAS unsigned char* buf, int wid) const {
        const int ln = lane_opaque();
        if (wid == 0) __builtin_amdgcn_global_load_lds((const unsigned*)(bgu + (size_t)u.e * 2 * DFF + (ln >> 5) * DFF + u.pn * HALF + (ln & 31) * 4), (PG8_LAS unsigned*)buf, 16, 0, 0);
        else if (wid == 1) __builtin_amdgcn_global_load_lds((const unsigned*)(swr + (size_t)u.e * 2 * DFF + u.pn * BM + ln * 4), (PG8_LAS unsigned*)(buf + 1024), 16, 0, 0);
        else if (wid == 2) __builtin_amdgcn_global_load_lds((const unsigned*)(sxp + (size_t)u.e * T + u.rt * BM + ln * 4), (PG8_LAS unsigned*)(buf + 2048), 16, 0, 0); }
    __device__ __forceinline__ void operator()(const f32x4 (&acc)[2][2][4][2], const Unit& u, int wr, int wc, int fr, int fq, const PG8_LAS float* eb) const {
        const int row0 = u.pm * BM + wr * 64 + fr, c0 = u.pn * HALF + wc * 32 + 8 * fq;
        f32x4 bg0, bg1, bu0, bu1, sg0 = (f32x4){1.f, 1.f, 1.f, 1.f}, sg1 = sg0, su0 = sg0, su1 = sg0;
        float rsc[2][4];
        if constexpr (Q8) { const PG8_LAS float* lp = eb + wc * 32 + 8 * fq;
            bg0 = *(const PG8_LAS f32x4*)(lp); bg1 = *(const PG8_LAS f32x4*)(lp + 4); bu0 = *(const PG8_LAS f32x4*)(lp + HALF); bu1 = *(const PG8_LAS f32x4*)(lp + HALF + 4);
            sg0 = *(const PG8_LAS f32x4*)(lp + 256); sg1 = *(const PG8_LAS f32x4*)(lp + 260); su0 = *(const PG8_LAS f32x4*)(lp + 256 + HALF); su1 = *(const PG8_LAS f32x4*)(lp + 260 + HALF); }
        else { const float* bg = bgu + (size_t)u.e * 2 * DFF + c0; bg0 = *(const f32x4*)(bg); bg1 = *(const f32x4*)(bg + 4); bu0 = *(const f32x4*)(bg + DFF); bu1 = *(const f32x4*)(bg + DFF + 4); }
#pragma unroll
        for (int ai = 0; ai < 2; ++ai)
#pragma unroll
            for (int m = 0; m < 4; ++m) rsc[ai][m] = Q8 ? eb[512 + wr * 64 + fr + ai * HALF + m * 16] : 1.0f;
        const f32x4 bgv[2] = {bg0, bg1}, buv[2] = {bu0, bu1}, sgv[2] = {sg0, sg1}, suv[2] = {su0, su1};
#pragma unroll
        for (int ai = 0; ai < 2; ++ai)
#pragma unroll
            for (int m = 0; m < 4; ++m) {
                const float rs = rsc[ai][m]; const f32x2 rs2 = (f32x2){rs, rs};
                unsigned wv[4];
#pragma unroll
                for (int h = 0; h < 2; ++h) { const f32x4 ga4 = acc[ai][0][m][h], ua4 = acc[ai][1][m][h];
#pragma unroll
                    for (int p = 0; p < 2; ++p) {
                        f32x2 g, uu;
                        if constexpr (Q8) { const i32x4 gi = __builtin_bit_cast(i32x4, ga4), ui = __builtin_bit_cast(i32x4, ua4);
                            g = (f32x2){(float)gi[2 * p], (float)gi[2 * p + 1]} * rs2; uu = (f32x2){(float)ui[2 * p], (float)ui[2 * p + 1]} * rs2; }
                        else { g = (f32x2){ga4[2 * p], ga4[2 * p + 1]}; uu = (f32x2){ua4[2 * p], ua4[2 * p + 1]}; }
                        g = g * (f32x2){sgv[h][2 * p], sgv[h][2 * p + 1]} + (f32x2){bgv[h][2 * p], bgv[h][2 * p + 1]};
                        uu = uu * (f32x2){suv[h][2 * p], suv[h][2 * p + 1]} + (f32x2){buv[h][2 * p], buv[h][2 * p + 1]};
                        g.x = __builtin_fminf(g.x, 7.0f); g.y = __builtin_fminf(g.y, 7.0f);
                        uu.x = __builtin_fminf(__builtin_fmaxf(uu.x, -7.0f), 7.0f); uu.y = __builtin_fminf(__builtin_fmaxf(uu.y, -7.0f), 7.0f);
                        f32x2 e = g * (f32x2){-1.702f * 1.4426950408889634f, -1.702f * 1.4426950408889634f};
                        e.x = __builtin_amdgcn_exp2f(e.x); e.y = __builtin_amdgcn_exp2f(e.y);
                        e = e + (f32x2){1.0f, 1.0f};
                        e.x = __builtin_amdgcn_rcpf(e.x); e.y = __builtin_amdgcn_rcpf(e.y);
                        const f32x2 o = (uu + (f32x2){1.0f, 1.0f}) * (g * e);
                        wv[2 * h + p] = cvt_pk_bf16(o.x, o.y); } }
                *(u32x4*)(Act + (size_t)(row0 + ai * HALF + m * 16) * DFF + c0) = (u32x4){wv[0], wv[1], wv[2], wv[3]}; }
    }
};
typedef EpiGateUpT<false> EpiGateUp; typedef EpiGateUpT<true> EpiGateUpQ;
struct EpiDown {
    static constexpr bool PERM = true, DRAIN_AFTER = false, TWICE = (EPI_TWICE_SEL == 7), HAS_MID = false, PREF = true; static constexpr int NSTORES = TWICE ? 0 : 16;
    bf16_t* C; const float* bd;
    __device__ __forceinline__ void prefetch(const Unit& u, PG8_LAS unsigned char* buf, int wid) const {
        if (wid == 0) __builtin_amdgcn_global_load_lds((const unsigned*)(bd + (size_t)u.e * D + u.pn * BM + lane_opaque() * 4), (PG8_LAS unsigned*)buf, 16, 0, 0); }
    __device__ __forceinline__ void operator()(const f32x4 (&acc)[2][2][4][2], const Unit& u, int wr, int wc, int fr, int fq, const PG8_LAS float* eb) const {
        const int row0 = u.pm * BM + wr * 64 + fr, col0 = u.pn * BM + wc * 32 + 8 * fq;
        f32x4 bv[2][2];
#pragma unroll
        for (int bj = 0; bj < 2; ++bj)
#pragma unroll
            for (int nn = 0; nn < 2; ++nn) bv[bj][nn] = *(const PG8_LAS f32x4*)(eb + wc * 32 + 8 * fq + bj * HALF + 4 * nn);
#pragma unroll
        for (int ai = 0; ai < 2; ++ai)
#pragma unroll
            for (int m = 0; m < 4; ++m) { bf16_t* rowp = C + (size_t)(row0 + ai * HALF + m * 16) * D + col0;
#pragma unroll
                for (int bj = 0; bj < 2; ++bj) { const f32x4 v0 = acc[ai][bj][m][0] + bv[bj][0], v1 = acc[ai][bj][m][1] + bv[bj][1];
                    u32x4 w; w.x = cvt_pk_bf16(v0[0], v0[1]); w.y = cvt_pk_bf16(v0[2], v0[3]); w.z = cvt_pk_bf16(v1[0], v1[1]); w.w = cvt_pk_bf16(v1[2], v1[3]);
                    *(u32x4*)(rowp + bj * HALF) = w; } }
    }
};
}

#define XB_TMO      128
#define XB_XCNT(j)  (256  + 64 * (j))
#define XB_XSUB(j)  (1280 + 64 * (j))
#define XB_XGEN(j)  (2304 + 64 * (j))
#define XB_TOP      3328
#define XB_TOPGEN   3392
#define XCD_BAR_WORDS 3456
#define XB_SPIN_CAP (1u << 18)
__device__ __forceinline__ unsigned xb_ld(unsigned* p)              { return __hip_atomic_load(p, __ATOMIC_RELAXED, __HIP_MEMORY_SCOPE_AGENT); }
__device__ __forceinline__ unsigned xb_add(unsigned* p, unsigned v) { return __hip_atomic_fetch_add(p, v, __ATOMIC_RELAXED, __HIP_MEMORY_SCOPE_AGENT); }
__device__ __forceinline__ unsigned xb_xcc_id() { return (unsigned)__builtin_amdgcn_s_getreg((3 << 11) | 20) & 0xFu; }
#define XB_SPIN(cond, bar) do { unsigned _sp = 0; while (cond) { __builtin_amdgcn_s_sleep(1); \
    if ((++_sp & 255u) == 0u) { if (xb_ld(&(bar)[XB_TMO])) break; if (_sp > XB_SPIN_CAP) { atomicAdd(&(bar)[XB_TMO], 1u); break; } } } } while (0)
struct XcdBarrier { unsigned* bar; unsigned x; volatile LAS unsigned* st; };
__device__ __forceinline__ XcdBarrier xcd_barrier_post(unsigned* bar, volatile LAS unsigned* st) {
    XcdBarrier b; b.bar = bar; b.x = xb_xcc_id(); b.st = st;
    if (threadIdx.x == 0) (void)xb_add(&bar[XB_XCNT(b.x)], 1u);
    return b;
}
__device__ __forceinline__ void xcd_barrier_complete(unsigned* bar, unsigned x, unsigned& nloc, unsigned& nx) {
    const unsigned G = gridDim.x * gridDim.y * gridDim.z;
    unsigned sum, cnt, mine, sp = 0u;
    for (;;) {
        sum = 0u; cnt = 0u; mine = 0u;
#pragma unroll
        for (unsigned j = 0; j < 16; ++j) { const unsigned c = xb_ld(&bar[XB_XCNT(j)]); sum += c; cnt += (c > 0u) ? 1u : 0u; mine = (j == x) ? c : mine; }
        if (sum == G) break;
        __builtin_amdgcn_s_sleep(1);
        if ((++sp & 255u) == 0u) { if (xb_ld(&bar[XB_TMO])) break; if (sp > XB_SPIN_CAP) { atomicAdd(&bar[XB_TMO], 1u); break; } }
    }
    nloc = mine > 0u ? mine : 1u; nx = cnt > 0u ? cnt : 1u;
}
__device__ __forceinline__ void xcd_barrier(const XcdBarrier& b) {
    asm volatile("s_waitcnt vmcnt(0)" ::: "memory");
    __syncthreads();
    if (threadIdx.x == 0) {
        unsigned* bar = b.bar;
        __builtin_amdgcn_s_waitcnt(0);
        unsigned nloc = b.st[0], nx = b.st[1];
        if (nloc == 0u) { xcd_barrier_complete(bar, b.x, nloc, nx); b.st[0] = nloc; b.st[1] = nx; }
        const unsigned old = xb_add(&bar[XB_XSUB(b.x)], 1u);
        const unsigned gen = old / nloc;
        if (old + 1u == (gen + 1u) * nloc) {
            __builtin_amdgcn_fence(__ATOMIC_RELEASE, "agent");
            asm volatile("s_waitcnt vmcnt(0)" ::: "memory");
            const unsigned og = xb_add(&bar[XB_TOP], 1u);
            const unsigned tg = og / nx;
            if (og + 1u == (tg + 1u) * nx) xb_add(&bar[XB_TOPGEN], 1u);
            else XB_SPIN(xb_ld(&bar[XB_TOPGEN]) == tg, bar);
            __builtin_amdgcn_fence(__ATOMIC_ACQUIRE, "agent");
            xb_add(&bar[XB_XGEN(b.x)], 1u);
            asm volatile("s_waitcnt vmcnt(0)" ::: "memory");
        } else {
            XB_SPIN(xb_ld(&bar[XB_XGEN(b.x)]) == gen, bar);
            __builtin_amdgcn_fence(__ATOMIC_ACQUIRE, "agent");
            asm volatile("s_waitcnt vmcnt(0)" ::: "memory");
        }
    }
    __syncthreads();
}

template <int CTRL> __device__ __forceinline__ float dppf(float v) { return __int_as_float(__builtin_amdgcn_update_dpp(0, __float_as_int(v), CTRL, 0xf, 0xf, true)); }
__device__ __forceinline__ float wave_sum(float v) {
    v += dppf<0xB1>(v); v += dppf<0x4E>(v); v += dppf<0x141>(v); v += dppf<0x140>(v);
    { auto rr = __builtin_amdgcn_permlane16_swap(__float_as_uint(v), __float_as_uint(v), false, false); v = __uint_as_float(rr[0]) + __uint_as_float(rr[1]); }
    { auto rr = __builtin_amdgcn_permlane32_swap(__float_as_uint(v), __float_as_uint(v), false, false); v = __uint_as_float(rr[0]) + __uint_as_float(rr[1]); }
    return v;
}
__device__ __forceinline__ float wave_max(float v) {
    asm volatile("s_nop 1\n\tv_max_f32_dpp %0, %0, %0 quad_perm:[1,0,3,2] row_mask:0xf bank_mask:0xf\n\ts_nop 1\n\t"
                 "v_max_f32_dpp %0, %0, %0 quad_perm:[2,3,0,1] row_mask:0xf bank_mask:0xf\n\ts_nop 1\n\t"
                 "v_max_f32_dpp %0, %0, %0 row_half_mirror row_mask:0xf bank_mask:0xf\n\ts_nop 1\n\t"
                 "v_max_f32_dpp %0, %0, %0 row_mirror row_mask:0xf bank_mask:0xf" : "+v"(v));
    { auto rr = __builtin_amdgcn_permlane16_swap(__float_as_uint(v), __float_as_uint(v), false, false); float a = __uint_as_float(rr[0]), b = __uint_as_float(rr[1]); asm volatile("v_max_f32 %0, %1, %2" : "=v"(v) : "v"(a), "v"(b)); }
    { auto rr = __builtin_amdgcn_permlane32_swap(__float_as_uint(v), __float_as_uint(v), false, false); float a = __uint_as_float(rr[0]), b = __uint_as_float(rr[1]); asm volatile("v_max_f32 %0, %1, %2" : "=v"(v) : "v"(a), "v"(b)); }
    return v;
}
__device__ __forceinline__ unsigned q4(f32x4 x, float inv) {
    unsigned w = 0u;
    w = __builtin_amdgcn_cvt_pk_u8_f32(__builtin_rintf(__builtin_fmaf(x.x, inv, 128.0f)), 0, w); w = __builtin_amdgcn_cvt_pk_u8_f32(__builtin_rintf(__builtin_fmaf(x.y, inv, 128.0f)), 1, w);
    w = __builtin_amdgcn_cvt_pk_u8_f32(__builtin_rintf(__builtin_fmaf(x.z, inv, 128.0f)), 2, w); w = __builtin_amdgcn_cvt_pk_u8_f32(__builtin_rintf(__builtin_fmaf(x.w, inv, 128.0f)), 3, w);
    return w ^ 0x80808080u;
}
__device__ __forceinline__ void quant_row(const f32x4 (&v)[4], signed char* qrow, float* sc, int lane) {
    float am = 0.f;
#pragma unroll
    for (int j = 0; j < 4; ++j) am = __builtin_fmaxf(am, __builtin_fmaxf(__builtin_fmaxf(__builtin_fabsf(v[j].x), __builtin_fabsf(v[j].y)), __builtin_fmaxf(__builtin_fabsf(v[j].z), __builtin_fabsf(v[j].w))));
    am = wave_max(am);
    const float inv = am > 0.f ? 127.0f / am : 0.f;
    GAS unsigned* o = (GAS unsigned*)qrow + lane;
#pragma unroll
    for (int j = 0; j < 4; ++j) o[64 * j] = q4(v[j], inv);
    if (lane == 0) *sc = am * (1.0f / 127.0f);
}
constexpr int WT_STRIDE = D + 4;

struct Args { const float* in[20]; float* out; unsigned char* ws; int ph_lo, ph_hi; };
typedef const __attribute__((address_space(4))) Args* KArgs;

__device__ __forceinline__ KArgs ka_opaque() { unsigned long long p = (unsigned long long)__builtin_amdgcn_kernarg_segment_ptr(); asm volatile("" : "+s"(p)); return (KArgs)p; }


__device__ __forceinline__ void p0_transpose_item(const float* Wsrc, int K, int N, bf16* WT, int drow0, int k0, int n0, int dpitch, int dcol0, LAS float* scr, int lane) {
#pragma unroll 8
    for (int i = 0; i < 32; ++i) { const int kk = 2 * i + (lane >> 5); scr[kk * 33 + (lane & 31)] = Wsrc[(size_t)(k0 + kk) * N + n0 + (lane & 31)]; }
    LDS_WAIT(); asm volatile("" ::: "memory");
    const int c = lane & 7;
#pragma unroll
    for (int j = 0; j < 4; ++j) { const int n = (lane >> 3) + 8 * j; const LAS float* s = scr + (8 * c) * 33 + n;
        v4u o; o.x = pk2(s[0 * 33], s[1 * 33]); o.y = pk2(s[2 * 33], s[3 * 33]); o.z = pk2(s[4 * 33], s[5 * 33]); o.w = pk2(s[6 * 33], s[7 * 33]);
        *(GAS v4u*)(WT + (size_t)(drow0 + n) * dpitch + dcol0 + k0 + 8 * c) = o; }
    LDS_WAIT(); asm volatile("" ::: "memory");
}
__device__ __forceinline__ void p0_quant_strip_wg(const float* Wsrc, int N, signed char* WQ, float* SC, int drow0, int n0, LAS float* scr  , LAS float* pmax  , int wave, int lane) {
    constexpr int K = 1024;
    LAS float* mine = scr + wave * 128 * 32;
    float am = 0.f;
#pragma unroll 8
    for (int i = 0; i < 64; ++i) { const int kk = 2 * i + (lane >> 5); const float x = Wsrc[(size_t)(128 * wave + kk) * N + n0 + (lane & 31)];
        am = __builtin_fmaxf(am, __builtin_fabsf(x)); mine[kk * 32 + ((lane & 31) ^ (kk & 31))] = x; }
    am = __builtin_fmaxf(am, __shfl_xor(am, 32));
    if (lane < 32) pmax[wave * 32 + lane] = am;
    __syncthreads();
    float cm = 0.f;
#pragma unroll
    for (int w = 0; w < 8; ++w) cm = __builtin_fmaxf(cm, pmax[w * 32 + (lane & 31)]);
    const float inv = cm > 0.f ? 127.0f / cm : 0.f;
    if (wave == 0 && lane < 32) SC[drow0 + lane] = cm * (1.0f / 127.0f);
    const int c = lane & 3;
#pragma unroll
    for (int kb = 0; kb < 2; ++kb)
#pragma unroll
        for (int j = 0; j < 2; ++j) { const int n = (lane >> 2) + 16 * j; const float invn = __shfl(inv, n);
            float x[16];
#pragma unroll
            for (int t = 0; t < 16; ++t) { const int kk = 64 * kb + 16 * c + t; x[t] = mine[kk * 32 + (n ^ (kk & 31))]; }
            v4u o; o.x = q4((f32x4){x[0], x[1], x[2], x[3]}, invn); o.y = q4((f32x4){x[4], x[5], x[6], x[7]}, invn); o.z = q4((f32x4){x[8], x[9], x[10], x[11]}, invn); o.w = q4((f32x4){x[12], x[13], x[14], x[15]}, invn);
            *(GAS v4u*)(WQ + (size_t)(drow0 + n) * K + 128 * wave + 64 * kb + 16 * c) = o; }
    __syncthreads();
}
__device__ __forceinline__ bool p0_matrix(int& r, const float* src, int K, int N, bf16* dst, bool gu_rows, LAS float* scr, int lane, int dpitch = 0, int dcol0 = 0) {
    const int nblk = N / 32, items = (K / 64) * nblk;
    if (r >= items) { r -= items; return false; }
    const int kb = r / nblk, nb = r % nblk, n0 = 32 * nb;
    int drow0 = n0;
    if (gu_rows) { const int cc = (n0 >= DFF) ? n0 - DFF : n0; drow0 = (cc >> 7) * 256 + (n0 >= DFF ? 128 : 0) + (cc & 127); }
    p0_transpose_item(src, K, N, dst, drow0, 64 * kb, n0, dpitch ? dpitch : K, dcol0, scr, lane);
    return true;
}
__device__ __forceinline__ void row_to_bf16(const float* xrow, bf16* orow, int lane) {
    const GAS f32x4* xr = (const GAS f32x4*)xrow + lane; GAS unsigned long long* o8 = (GAS unsigned long long*)orow + lane;
    f32x4 v[4];
#pragma unroll
    for (int j = 0; j < 4; ++j) v[j] = xr[64 * j];
    asm volatile("" :: "v"(v[0]), "v"(v[1]), "v"(v[2]), "v"(v[3]));
#pragma unroll
    for (int j = 0; j < 4; ++j) o8[64 * j] = (unsigned long long)pk2(v[j].x, v[j].y) | ((unsigned long long)pk2(v[j].z, v[j].w) << 32);
}

__device__ __forceinline__ int t5_bucket(int rel) {
    const int n = rel < 0 ? -rel : rel;
    int b;
    if (n < 8) b = n; else b = 8 + (n >= 12) + (n >= 16) + (n >= 23) + (n >= 32) + (n >= 46) + (n >= 64) + (n >= 91);
    return (rel > 0 ? 16 : 0) + b;
}
namespace att {
typedef float f32x16 __attribute__((ext_vector_type(16)));
typedef short s16x4 __attribute__((ext_vector_type(4)));
typedef short v4i16_t __attribute__((ext_vector_type(4)));
typedef __bf16 bf16x2_t __attribute__((ext_vector_type(2)));
constexpr float LOG2E = 1.4426950408889634f;
constexpr int YP = 3 * W;
constexpr int SLOT = 16384, LDS_K = 0, LDS_V = 2 * SLOT, LDS_STG = 4 * SLOT, STG_W = 8192;
constexpr int LW_MSTG = 3072;
constexpr int LW_WSF = 320, LW_FLAG = 832, LW_TAB = 896;
__device__ __forceinline__ int crow(int r, int hi) { return (r & 3) + 8 * (r >> 2) + 4 * hi; }
__device__ __forceinline__ void glds16(const void* gsrc, unsigned lds_dst) { unsigned keep;
    asm volatile("s_mov_b32 %0, m0\n\ts_mov_b32 m0, %2\n\ts_nop 0\n\tglobal_load_lds_dwordx4 %1, off\n\ts_mov_b32 m0, %0" : "=&s"(keep) : "v"(gsrc), "s"(lds_dst) : "memory"); }
__device__ __forceinline__ unsigned cvtpk(float lo, float hi) { f32x2 v = {lo, hi}; bf16x2_t b = __builtin_convertvector(v, bf16x2_t); return __builtin_bit_cast(unsigned, b); }
template <int N> __device__ __forceinline__ void wait_bar() {
    if constexpr (N == 0) asm volatile("s_waitcnt vmcnt(0) lgkmcnt(0)\n\ts_barrier" ::: "memory");
    else if constexpr (N == 2) asm volatile("s_waitcnt vmcnt(2) lgkmcnt(0)\n\ts_barrier" ::: "memory");
    else if constexpr (N == 3) asm volatile("s_waitcnt vmcnt(3) lgkmcnt(0)\n\ts_barrier" ::: "memory");
    else asm volatile("s_waitcnt vmcnt(4) lgkmcnt(0)\n\ts_barrier" ::: "memory");
}
__device__ __forceinline__ void lds_bar() { asm volatile("s_waitcnt lgkmcnt(0)\n\ts_barrier" ::: "memory"); }
typedef LAS const char* lptr;
template <int ND0, int BT = 4> __device__ __forceinline__ void qkt(f32x16& p0, f32x16& p1, lptr kslot, const bf16x8* qr, int r32, int hi) {
    lptr kb = kslot + hi * 1024 + r32 * 16;
    p0 = (f32x16){}; p1 = (f32x16){};
    bf16x8 b0[BT], b1[BT];
#pragma unroll
    for (int g = 0; g < ND0 / BT; ++g) {
#pragma unroll
        for (int d = 0; d < BT; ++d) { b0[d] = *(const LAS bf16x8*)(kb + (BT * g + d) * 2048); b1[d] = *(const LAS bf16x8*)(kb + (BT * g + d) * 2048 + 512); }
        __builtin_amdgcn_sched_barrier(0);
#pragma unroll
        for (int d = 0; d < BT; ++d) { p0 = __builtin_amdgcn_mfma_f32_32x32x16_bf16(b0[d], qr[BT * g + d], p0, 0, 0, 0); p1 = __builtin_amdgcn_mfma_f32_32x32x16_bf16(b1[d], qr[BT * g + d], p1, 0, 0, 0); }
        __builtin_amdgcn_sched_barrier(0);
    }
}
__device__ __forceinline__ s16x4 vtr(lptr p) { return __builtin_bit_cast(s16x4, __builtin_amdgcn_ds_read_tr16_b64_v4i16((LAS v4i16_t*)p)); }
template <int NDB> __device__ __forceinline__ void pv(f32x16* o, lptr vb, v4u pw0, v4u pw1, v4u pw2, v4u pw3) {
    s16x4 lo[2][4], hh[2][4];
#pragma unroll
    for (int ks = 0; ks < 4; ++ks) { lo[0][ks] = vtr(vb + ks * 1024); hh[0][ks] = vtr(vb + ks * 1024 + 512); }
#pragma unroll
    for (int db = 0; db < NDB; ++db) {
        if (db + 1 < NDB) {
#pragma unroll
            for (int ks = 0; ks < 4; ++ks) { lo[(db + 1) & 1][ks] = vtr(vb + (db + 1) * 4096 + ks * 1024); hh[(db + 1) & 1][ks] = vtr(vb + (db + 1) * 4096 + ks * 1024 + 512); }
        }
        __builtin_amdgcn_sched_barrier(0);
#pragma unroll
        for (int ks = 0; ks < 4; ++ks) {
            const s16x4 l_ = lo[db & 1][ks], h_ = hh[db & 1][ks];
            const bf16x8 vf = (bf16x8){l_[0], l_[1], l_[2], l_[3], h_[0], h_[1], h_[2], h_[3]};
            const v4u pw = ks == 0 ? pw0 : ks == 1 ? pw1 : ks == 2 ? pw2 : pw3;
            o[db] = __builtin_amdgcn_mfma_f32_32x32x16_bf16(__builtin_bit_cast(bf16x8, pw), vf, o[db], 0, 0, 0); }
        __builtin_amdgcn_sched_barrier(0);
    }
}
__device__ __forceinline__ void pack_p(const f32x16& p0, const f32x16& p1, v4u& pw0, v4u& pw1, v4u& pw2, v4u& pw3) {
    pw0 = (v4u){cvtpk(p0[0], p0[1]), cvtpk(p0[2], p0[3]), cvtpk(p0[4], p0[5]), cvtpk(p0[6], p0[7])};
    pw1 = (v4u){cvtpk(p0[8], p0[9]), cvtpk(p0[10], p0[11]), cvtpk(p0[12], p0[13]), cvtpk(p0[14], p0[15])};
    pw2 = (v4u){cvtpk(p1[0], p1[1]), cvtpk(p1[2], p1[3]), cvtpk(p1[4], p1[5]), cvtpk(p1[6], p1[7])};
    pw3 = (v4u){cvtpk(p1[8], p1[9]), cvtpk(p1[10], p1[11]), cvtpk(p1[12], p1[13]), cvtpk(p1[14], p1[15])};
}
__device__ __forceinline__ float half_swap(float x, int hi) {
    auto rr = __builtin_amdgcn_permlane32_swap(__float_as_uint(x), __float_as_uint(x), false, false);
    return __uint_as_float(hi ? rr[0] : rr[1]);
}
__device__ __forceinline__ float rowmax32(const f32x16& p0, const f32x16& p1, int hi) {
    float a = __builtin_fmaxf(p0[0], p1[0]);
#pragma unroll
    for (int r = 1; r < 16; ++r) a = __builtin_fmaxf(a, __builtin_fmaxf(p0[r], p1[r]));
    return __builtin_fmaxf(a, half_swap(a, hi));
}
template <int NKC  , int NVP  >
__device__ __forceinline__ void dma_tile(const bf16* Kt, const bf16* Vt, int pitch, unsigned kdst, unsigned vdst, int wid, int lane) {
#pragma unroll
    for (int i = 0; i < NKC; ++i) { const int c = wid + 8 * i; glds16(Kt + (size_t)lane * pitch + c * 8, (unsigned)__builtin_amdgcn_readfirstlane(kdst + c * 1024)); }
#pragma unroll
    for (int i = 0; i < NVP; ++i) { const int pc = wid + 8 * i, dh = pc >> 2, rg = pc & 3;
        glds16(Vt + (size_t)(16 * rg + (lane >> 2)) * pitch + dh * 32 + (lane & 3) * 8, (unsigned)__builtin_amdgcn_readfirstlane(vdst + pc * 1024)); }
}
template <int NDB> __device__ __forceinline__ void store_o(const f32x16* o, const float* rsc  , LAS unsigned char* stg, bf16* Yw  , int lane, int r32, int hi) {
    LAS bf16* st = (LAS bf16*)stg;
#pragma unroll
    for (int r = 0; r < 16; ++r) { const int orow = crow(r, hi);
#pragma unroll
        for (int db = 0; db < NDB; ++db) st[orow * (NDB * 32) + db * 32 + r32] = (bf16)f2bf(o[db][r] * rsc[r]); }
    LDS_WAIT();
    constexpr int CPR = NDB * 4;
#pragma unroll
    for (int i = 0; i < (32 * CPR) / 64; ++i) { const int idx = i * 64 + lane, row = idx / CPR, ch = idx % CPR;
        const v4u v = *(const LAS v4u*)(stg + row * (NDB * 64) + ch * 16); *(v4u*)(Yw + (size_t)row * YP + ch * 8) = v; }
    LDS_WAIT();
}

template <int NKC> __device__ __forceinline__ void dma_k(const bf16* Kt, int pitch, unsigned kdst, int wid, int lane) {
#pragma unroll
    for (int i = 0; i < NKC; ++i) { const int c = wid + 8 * i; glds16(Kt + (size_t)lane * pitch + c * 8, (unsigned)__builtin_amdgcn_readfirstlane(kdst + c * 1024)); }
}
template <int NVP> __device__ __forceinline__ void dma_v(const bf16* Vt, int pitch, unsigned vdst, int wid, int lane) {
#pragma unroll
    for (int i = 0; i < NVP; ++i) { const int pc = wid + 8 * i, dh = pc >> 2, rg = pc & 3;
        glds16(Vt + (size_t)(16 * rg + (lane >> 2)) * pitch + dh * 32 + (lane & 3) * 8, (unsigned)__builtin_amdgcn_readfirstlane(vdst + pc * 1024)); }
}
template <int NDB> __device__ __forceinline__ void store_rows(const f32x16* o, const float* rsc, LAS unsigned char* stg, bf16* Yw, int lane, int r32, int hi) {
    constexpr int RPP = 2048 / (NDB * 64), RH = RPP / 2, NP = 32 / RPP, CPR = NDB * 4, NIT = RPP * CPR / 64;
    LAS bf16* st = (LAS bf16*)stg;
#pragma unroll
    for (int g = 0; g < NP; ++g) {
#pragma unroll
        for (int rp = 0; rp < RH; ++rp)
#pragma unroll
            for (int db = 0; db < NDB; ++db) st[crow(rp, hi) * (NDB * 32) + db * 32 + r32] = (bf16)f2bf(o[db][g * RH + rp] * rsc[g * RH + rp]);
        LDS_WAIT();
#pragma unroll
        for (int i = 0; i < NIT; ++i) { const int idx = i * 64 + lane, row = idx / CPR, ch = idx % CPR;
            const v4u v = *(const LAS v4u*)(stg + row * (NDB * 64) + ch * 16); *(v4u*)(Yw + (size_t)(g * RPP + row) * YP + ch * 8) = v; }
        LDS_WAIT();
    }
}
__device__ __forceinline__ float mul1(float a, float b) { float r; asm("v_mul_f32 %0, %1, %2" : "=v"(r) : "v"(a), "v"(b)); return r; }
__device__ __forceinline__ void sb_tile(f32x16* o, float& R, lptr kslot, lptr vbt, const bf16x8* qr, int delta  , int r32, int hi) {
    f32x16 p0, p1;
    qkt<4>(p0, p1, kslot, qr, r32, hi);
    if (delta < 64 + 31) {
#pragma unroll
        for (int r = 0; r < 16; ++r) { const int kv = crow(r, hi) - r32; if (!(kv < delta)) p0[r] = -INFINITY; if (!(kv + 32 < delta)) p1[r] = -INFINITY; }
    }
#pragma unroll
    for (int r = 0; r < 16; ++r) { p0[r] = __builtin_amdgcn_rcpf(1.0f + __builtin_amdgcn_exp2f(p0[r])); p1[r] = __builtin_amdgcn_rcpf(1.0f + __builtin_amdgcn_exp2f(p1[r])); }
    float To[8], Tp[8], F[8];
#pragma unroll
    for (int g = 0; g < 4; ++g) { To[g] = mul1(mul1(p0[4 * g + 3], p0[4 * g + 2]), mul1(p0[4 * g + 1], p0[4 * g])); To[4 + g] = mul1(mul1(p1[4 * g + 3], p1[4 * g + 2]), mul1(p1[4 * g + 1], p1[4 * g])); }
#pragma unroll
    for (int g = 0; g < 8; ++g) Tp[g] = half_swap(To[g], hi);
    F[7] = 1.0f;
#pragma unroll
    for (int g = 6; g >= 0; --g) F[g] = mul1(F[g + 1], mul1(To[g + 1], Tp[g + 1]));
    const float total = mul1(F[0], mul1(To[0], Tp[0]));
#pragma unroll
    for (int g = 0; g < 8; ++g) { const float E = mul1(mul1(R, F[g]), (hi == 0 ? Tp[g] : 1.0f));
        f32x16& pp = (g < 4) ? p0 : p1; const int q = 4 * (g & 3);
        f32x4 x;
        x[3] = E; x[2] = mul1(E, pp[q + 3]); x[1] = mul1(x[2], pp[q + 2]); x[0] = mul1(x[1], pp[q + 1]);
        const f32x2 w01 = ((f32x2){1.0f, 1.0f} - (f32x2){pp[q], pp[q + 1]}) * (f32x2){x[0], x[1]}, w23 = ((f32x2){1.0f, 1.0f} - (f32x2){pp[q + 2], pp[q + 3]}) * (f32x2){x[2], x[3]};
        pp[q] = w01.x; pp[q + 1] = w01.y; pp[q + 2] = w23.x; pp[q + 3] = w23.y; }
    R *= total;
    v4u pw0, pw1, pw2, pw3; pack_p(p0, p1, pw0, pw1, pw2, pw3);
    pv<2>(o, vbt, pw0, pw1, pw2, pw3);
}
__device__ __forceinline__ void sb_unit(LAS unsigned char* lds, volatile LAS unsigned* LWv, const bf16* proj, bf16* ysb, int b, int h, int qt, bool pre, int nb, int nh, int nqt) {
    const int tid_ = tid_opaque(), lane = tid_ & 63, wid = __builtin_amdgcn_readfirstlane(tid_ >> 6);
    const int r32 = lane & 31, hi = lane >> 5, q0 = qt * 256, qw0 = q0 + 32 * wid;
    const size_t rowb = (size_t)b * SEQ;
    const bf16* Qw = proj + (rowb + qw0) * PP + h * 64; const bf16* Kh = proj + rowb * PP + W + h * 64; const bf16* Vh = proj + rowb * PP + 2 * W + h * 64;
    const unsigned lds0 = (unsigned)(uintptr_t)lds;
    constexpr int WK = 0, WV = 4 * SLOT, TB = 8192;
    const int jhi = q0 / 64 + 3, jlo = jhi >= 7 ? jhi - 7 : 0;
    if (!pre) {
#pragma unroll 1
        for (int j = jhi; j >= jlo; --j) dma_tile<1, 1>(Kh + (size_t)j * 64 * PP, Vh + (size_t)j * 64 * PP, PP, lds0 + WK + (jhi - j) * TB, lds0 + WV + (jhi - j) * TB, wid, lane); }
    bf16x8 qr[4];
#pragma unroll
    for (int d0 = 0; d0 < 4; ++d0) qr[d0] = *(const bf16x8*)(Qw + (size_t)r32 * PP + d0 * 16 + hi * 8);
    asm volatile("" : "+v"(qr[0]), "+v"(qr[1]), "+v"(qr[2]), "+v"(qr[3]));
    f32x16 o[2]; o[0] = (f32x16){}; o[1] = (f32x16){};
    float R = 1.0f;
    const float RTH = 5.4210109e-20f;
    bool done = false;
    lptr vb = (lptr)lds + WV + ((lane >> 4) & 1) * 32 + (lane & 3) * 8 + (4 * hi + ((lane & 15) >> 2)) * 64;
    wait_bar<0>();
#pragma unroll 1
    for (int j = jhi; j >= jlo; --j) {
        const int delta = qw0 - 64 * j;
        if (delta <= -31) continue;
        sb_tile(o, R, (lptr)lds + WK + (jhi - j) * TB, vb + (jhi - j) * TB, qr, delta, r32, hi);
        done = __all(R < RTH);
        if (done) break;
    }
    if (lane == 0) LWv[LW_FLAG + wid] = (!done && jlo > 0) ? 1u : 0u;
    lds_bar();
    unsigned more = 0u;
#pragma unroll
    for (int w = 0; w < 8; ++w) more |= LWv[LW_FLAG + w];
    if (more) {
        lds_bar();
        dma_tile<1, 1>(Kh + (size_t)(jlo - 1) * 64 * PP, Vh + (size_t)(jlo - 1) * 64 * PP, PP, lds0 + WK, lds0 + WV, wid, lane);
        int slot = 0;
#pragma unroll 1
        for (int j = jlo - 1; j >= 0; --j) {
            if (j > 0) { dma_tile<1, 1>(Kh + (size_t)(j - 1) * 64 * PP, Vh + (size_t)(j - 1) * 64 * PP, PP, lds0 + WK + (slot ^ 1) * TB, lds0 + WV + (slot ^ 1) * TB, wid, lane); wait_bar<2>(); }
            else wait_bar<0>();
            if (!done) { sb_tile(o, R, (lptr)lds + WK + slot * TB, vb + slot * TB, qr, qw0 - 64 * j, r32, hi); done = __all(R < RTH); }
            if (lane == 0) LWv[LW_FLAG + wid] = (done || j == 0) ? 1u : 0u;
            lds_bar();
            unsigned alld = 1u;
#pragma unroll
            for (int w = 0; w < 8; ++w) alld &= LWv[LW_FLAG + w];
            slot ^= 1;
            if (alld) break;
        }
        wait_bar<0>();
    }
    if (nqt >= 0) {
        const bf16* nK = proj + (size_t)nb * SEQ * PP + W + nh * 64; const bf16* nV = proj + (size_t)nb * SEQ * PP + 2 * W + nh * 64;
        const int njhi = nqt * 4 + 3, njlo = njhi >= 7 ? njhi - 7 : 0;
#pragma unroll 1
        for (int j = njhi; j >= njlo; --j) dma_tile<1, 1>(nK + (size_t)j * 64 * PP, nV + (size_t)j * 64 * PP, PP, lds0 + WK + (njhi - j) * TB, lds0 + WV + (njhi - j) * TB, wid, lane); }
    float ones[16];
#pragma unroll
    for (int r = 0; r < 16; ++r) ones[r] = 1.0f;
    store_rows<2>(o, ones, (LAS unsigned char*)(LWv + LW_MSTG) + wid * 2048, ysb + (rowb + qw0) * YP + h * 64, lane, r32, hi);
    lds_bar();
}

template <int NDB> __device__ __forceinline__ void softmax_tile(f32x16& p0, f32x16& p1, f32x16* o, float& m, float& l, float cb, const LAS float* tabp, volatile LAS float* wsf, int r32, int hi) {
    if (tabp) {
#pragma unroll
        for (int r = 0; r < 16; ++r) { p0[r] += tabp[crow(r, 0)] - cb; p1[r] += tabp[32 + crow(r, 0)] - cb; }
    }
    float a = __builtin_fmaxf(__builtin_fmaxf(p0[0], p0[1]), p1[0]), b = __builtin_fmaxf(__builtin_fmaxf(p0[2], p0[3]), p1[1]); a = __builtin_fmaxf(__builtin_fmaxf(a, p1[2]), p1[3]);
#pragma unroll
    for (int r = 4; r < 16; r += 4) { a = __builtin_fmaxf(__builtin_fmaxf(a, p0[r]), p0[r + 1]); b = __builtin_fmaxf(__builtin_fmaxf(b, p0[r + 2]), p0[r + 3]); a = __builtin_fmaxf(__builtin_fmaxf(a, p1[r]), p1[r + 1]); b = __builtin_fmaxf(__builtin_fmaxf(b, p1[r + 2]), p1[r + 3]); }
    float rm = __builtin_fmaxf(a, b); rm = __builtin_fmaxf(rm, half_swap(rm, hi));
    if (__any(rm > m + 8.0f)) {
        const float mn = __builtin_fmaxf(m, rm), f = __builtin_amdgcn_exp2f(m - mn);
        l *= f; m = mn;
        if (hi == 0) wsf[r32] = f;
        LDS_WAIT();
#pragma unroll
        for (int r = 0; r < 16; ++r) { const float fr_ = wsf[crow(r, hi)];
#pragma unroll
            for (int db = 0; db < NDB; ++db) o[db][r] *= fr_; }
        LDS_WAIT();
    }
    float s = 0.f;
#pragma unroll
    for (int r = 0; r < 16; ++r) { p0[r] = __builtin_amdgcn_exp2f(p0[r] - m); p1[r] = __builtin_amdgcn_exp2f(p1[r] - m); s += p0[r] + p1[r]; }
    l += s;
}
__device__ __forceinline__ void row_inv_l(float l, float* rli, volatile LAS float* wsf, int r32, int hi) {
    l += half_swap(l, hi);
    if (hi == 0) wsf[r32] = l;
    LDS_WAIT();
#pragma unroll
    for (int r = 0; r < 16; ++r) rli[r] = __builtin_amdgcn_rcpf(wsf[crow(r, hi)]);
    LDS_WAIT();
}

__device__ __forceinline__ bool sm_decide(f32x16& p0, f32x16& p1, float& m, float& f, float cb, const LAS float* tabp, int hi) {
    if (tabp) {
#pragma unroll
        for (int r = 0; r < 16; ++r) { p0[r] += tabp[crow(r, 0)] - cb; p1[r] += tabp[32 + crow(r, 0)] - cb; }
    }
    float a = __builtin_fmaxf(__builtin_fmaxf(p0[0], p0[1]), p1[0]), b = __builtin_fmaxf(__builtin_fmaxf(p0[2], p0[3]), p1[1]); a = __builtin_fmaxf(__builtin_fmaxf(a, p1[2]), p1[3]);
#pragma unroll
    for (int r = 4; r < 16; r += 4) { a = __builtin_fmaxf(__builtin_fmaxf(a, p0[r]), p0[r + 1]); b = __builtin_fmaxf(__builtin_fmaxf(b, p0[r + 2]), p0[r + 3]); a = __builtin_fmaxf(__builtin_fmaxf(a, p1[r]), p1[r + 1]); b = __builtin_fmaxf(__builtin_fmaxf(b, p1[r + 2]), p1[r + 3]); }
    float rm = __builtin_fmaxf(a, b); rm = __builtin_fmaxf(rm, half_swap(rm, hi));
    f = 1.0f;
    if (__any(rm > m + 8.0f)) { const float mn = __builtin_fmaxf(m, rm); f = __builtin_amdgcn_exp2f(m - mn); m = mn; return true; }
    return false;
}
__device__ __forceinline__ void pv_exp(f32x16* o, lptr vbp, v4u pw0, v4u pw1, v4u pw2, v4u pw3, f32x16& p0, f32x16& p1, float m) {
    asm volatile("" : "+v"(p0), "+v"(p1));
    s16x4 lo[3], hh[3];
#pragma unroll
    for (int g = 0; g < 2; ++g) { lo[g] = vtr(vbp + (g >> 2) * 4096 + (g & 3) * 1024); hh[g] = vtr(vbp + (g >> 2) * 4096 + (g & 3) * 1024 + 512); }
    __builtin_amdgcn_sched_barrier(0);
#pragma unroll
    for (int g = 0; g < 16; ++g) {
        const int db = g >> 2, ks = g & 3;
        if (g + 2 < 16) { const int gn = g + 2; lo[gn % 3] = vtr(vbp + (gn >> 2) * 4096 + (gn & 3) * 1024); hh[gn % 3] = vtr(vbp + (gn >> 2) * 4096 + (gn & 3) * 1024 + 512); }
        const s16x4 l_ = lo[g % 3], h_ = hh[g % 3];
        const bf16x8 vf = (bf16x8){l_[0], l_[1], l_[2], l_[3], h_[0], h_[1], h_[2], h_[3]};
        const v4u pw = ks == 0 ? pw0 : ks == 1 ? pw1 : ks == 2 ? pw2 : pw3;
        o[db] = __builtin_amdgcn_mfma_f32_32x32x16_bf16(__builtin_bit_cast(bf16x8, pw), vf, o[db], 0, 0, 0);
        if (g < 8) { float e0_ = __builtin_amdgcn_exp2f(p0[2 * g] - m), e1_ = __builtin_amdgcn_exp2f(p0[2 * g + 1] - m); asm volatile("" : "+v"(e0_), "+v"(e1_)); p0[2 * g] = e0_; p0[2 * g + 1] = e1_; }
        else { float e0_ = __builtin_amdgcn_exp2f(p1[2 * g - 16] - m), e1_ = __builtin_amdgcn_exp2f(p1[2 * g - 15] - m); asm volatile("" : "+v"(e0_), "+v"(e1_)); p1[2 * g - 16] = e0_; p1[2 * g - 15] = e1_; }
        __builtin_amdgcn_sched_barrier(0);
    }
}

__device__ __forceinline__ void df_unit(LAS unsigned char* lds, volatile LAS unsigned* LWv, const bf16* proj, bf16* ydf, const float* subg, float lam, float outscale, int b, int H, int qt, int, int) {
    const int tid_ = tid_opaque(), lane = tid_ & 63, wid = __builtin_amdgcn_readfirstlane(tid_ >> 6);
    const int r32 = lane & 31, hi = lane >> 5, q0 = qt * 256, qw0 = q0 + 32 * wid;
    const size_t rowb = (size_t)b * SEQ;
    const bf16* Vh = proj + rowb * PP + 5 * W + H * 128;
    const unsigned lds0 = (unsigned)(uintptr_t)lds;
    volatile LAS float* wsf = (volatile LAS float*)(LWv + LW_WSF + wid * 64);
    LAS unsigned char* stg = lds + LDS_STG + wid * STG_W;
    constexpr int DK = 0, DV = SLOT, KSL = 8192;
    lptr vb = (lptr)lds + DV + ((lane >> 4) & 1) * 32 + (lane & 3) * 8 + (4 * hi + ((lane & 15) >> 2)) * 64;
    const int jmax = q0 / 64 + 3, jw = qw0 / 64;
    f32x16 o[4];
#pragma unroll 1
    for (int mp = 0; mp < 2; ++mp) {
        const int h2 = 2 * H + mp;
        const bf16* Qw = proj + (rowb + qw0) * PP + 3 * W + h2 * 64; const bf16* Kh = proj + rowb * PP + 4 * W + h2 * 64;
        const LAS float* tab = (const LAS float*)(LWv + LW_TAB) + h2 * 256;
        const float cfar = tab[0];
        bf16x8 qr[4];
#pragma unroll
        for (int d0 = 0; d0 < 4; ++d0) qr[d0] = *(const bf16x8*)(Qw + (size_t)r32 * PP + d0 * 16 + hi * 8);
#pragma unroll
        for (int db = 0; db < 4; ++db) o[db] = (f32x16){};
        float m = -INFINITY, l = 0.f;
        v4u pw0 = (v4u){0u, 0u, 0u, 0u}, pw1 = pw0, pw2 = pw0, pw3 = pw0; bool have = false;
        dma_k<1>(Kh, PP, lds0 + DK, wid, lane); dma_v<2>(Vh, PP, lds0 + DV, wid, lane);
        asm volatile("" : "+v"(qr[0]), "+v"(qr[1]), "+v"(qr[2]), "+v"(qr[3]));
        int vs = 0, vprev = 0;
#pragma unroll 1
        for (int j = 0; j <= jmax + 1; ++j) {
            wait_bar<0>();
            const int vnext = (vs == 2) ? 0 : vs + 1;
            if (j < jmax) { dma_k<1>(Kh + (size_t)(j + 1) * 64 * PP, PP, lds0 + DK + ((j + 1) & 1) * KSL, wid, lane); dma_v<2>(Vh + (size_t)(j + 1) * 64 * PP, PP, lds0 + DV + vnext * SLOT, wid, lane); }
            if (j <= jw) {
                f32x16 p0, p1;
                qkt<4, 4>(p0, p1, (lptr)lds + DK + (j & 1) * KSL, qr, r32, hi);
                const int relmax = 64 * j + 63 - qw0;
                const LAS float* tabp = (relmax > -91) ? tab + (64 * j - qw0 + 192 + 4 * hi - r32) : nullptr;
                float f; const bool resc = sm_decide(p0, p1, m, f, cfar, tabp, hi);
                if (have) pv_exp(o, vb + vprev * SLOT, pw0, pw1, pw2, pw3, p0, p1, m);
                else {
#pragma unroll
                    for (int r = 0; r < 16; ++r) { p0[r] = __builtin_amdgcn_exp2f(p0[r] - m); p1[r] = __builtin_amdgcn_exp2f(p1[r] - m); } }
                if (resc) {
                    if (hi == 0) wsf[r32] = f;
                    LDS_WAIT();
#pragma unroll
                    for (int r = 0; r < 16; ++r) { const float fr_ = wsf[crow(r, hi)];
#pragma unroll
                        for (int db = 0; db < 4; ++db) o[db][r] *= fr_; }
                    LDS_WAIT();
                }
                float sacc = 0.f;
#pragma unroll
                for (int r = 0; r < 16; ++r) sacc += p0[r] + p1[r];
                l = l * f + sacc;
                pack_p(p0, p1, pw0, pw1, pw2, pw3); have = true;
            } else if (have) { pv<4>(o, vb + vprev * SLOT, pw0, pw1, pw2, pw3); have = false; }
            vprev = vs; vs = vnext;
        }
        lds_bar();
        float rli[16]; row_inv_l(l, rli, wsf, r32, hi);
        LAS bf16* st = (LAS bf16*)stg;
        if (mp == 0) {
#pragma unroll
            for (int r = 0; r < 16; ++r) { const int orow = crow(r, hi);
#pragma unroll
                for (int db = 0; db < 4; ++db) st[orow * 128 + db * 32 + r32] = (bf16)f2bf(o[db][r] * rli[r]); }
            LDS_WAIT();
        } else {
            float ss[16];
#pragma unroll
            for (int r = 0; r < 16; ++r) { const int orow = crow(r, hi); float q = 0.f;
#pragma unroll
                for (int db = 0; db < 4; ++db) { const float a = bf2f(st[orow * 128 + db * 32 + r32]) - lam * (o[db][r] * rli[r]); o[db][r] = a; q += a * a; }
                ss[r] = q; }
#pragma unroll
            for (int r = 0; r < 16; ++r) { float q = ss[r];
#pragma unroll
                for (int x = 1; x < 32; x <<= 1) q += __shfl_xor(q, x);
                ss[r] = __builtin_amdgcn_rsqf(q * (1.0f / 128.0f) + RMS_EPS) * outscale; }
            float g4[4];
#pragma unroll
            for (int db = 0; db < 4; ++db) g4[db] = subg[db * 32 + r32];
            asm volatile("" :: "v"(g4[0]), "v"(g4[1]), "v"(g4[2]), "v"(g4[3]));
#pragma unroll
            for (int db = 0; db < 4; ++db) {
#pragma unroll
                for (int r = 0; r < 16; ++r) o[db][r] *= g4[db]; }
            LDS_WAIT();
            store_o<4>(o, ss, stg, ydf + (rowb + qw0) * YP + H * 128, lane, r32, hi);
        }
    }
    lds_bar();
}

__device__ __forceinline__ void mem_unit(LAS unsigned char* lds, volatile LAS unsigned* LWv, const bf16* proj, const bf16* memkv, bf16* ymem, int b, int h, int qq, int, int) {
    const int tid_ = tid_opaque(), lane = tid_ & 63, wid = __builtin_amdgcn_readfirstlane(tid_ >> 6);
    const int r32 = lane & 31, hi = lane >> 5;
    const size_t rowb = (size_t)b * SEQ;
    const bf16* Kh = memkv + (size_t)b * MEML * 2048 + h * 128; const bf16* Vh = Kh + W;
    const unsigned lds0 = (unsigned)(uintptr_t)lds;
    volatile LAS float* wsf = (volatile LAS float*)(LWv + LW_WSF + wid * 64);
    LAS unsigned char* stg = (LAS unsigned char*)(LWv + LW_MSTG) + wid * 2048;
    constexpr int MK = 0, MV = 4 * SLOT;
#pragma unroll
    for (int j = 0; j < MEML / 64; ++j) dma_tile<2, 2>(Kh + (size_t)j * 64 * 2048, Vh + (size_t)j * 64 * 2048, 2048, lds0 + MK + j * SLOT, lds0 + MV + j * SLOT, wid, lane);
    wait_bar<0>();
    lptr vb = (lptr)lds + MV + ((lane >> 4) & 1) * 32 + (lane & 3) * 8 + (4 * hi + ((lane & 15) >> 2)) * 64;
#pragma unroll 1
    for (int qs = 0; qs < 4; ++qs) {
        const int qw0 = 1024 * qq + 256 * qs + 32 * wid;
        const bf16* Qw = proj + (rowb + qw0) * PP + 6 * W + h * 128;
        bf16x8 qr[8];
#pragma unroll
        for (int d0 = 0; d0 < 8; ++d0) qr[d0] = *(const bf16x8*)(Qw + (size_t)r32 * PP + d0 * 16 + hi * 8);
        f32x16 o[4];
#pragma unroll
        for (int db = 0; db < 4; ++db) o[db] = (f32x16){};
        float m = -INFINITY, l = 0.f;
#pragma unroll 1
        for (int j = 0; j < MEML / 64; ++j) {
            f32x16 p0, p1;
            qkt<8>(p0, p1, (lptr)lds + MK + j * SLOT, qr, r32, hi);
            softmax_tile<4>(p0, p1, o, m, l, 0.f, nullptr, wsf, r32, hi);
            v4u pw0, pw1, pw2, pw3; pack_p(p0, p1, pw0, pw1, pw2, pw3);
            pv<4>(o, vb + j * SLOT, pw0, pw1, pw2, pw3);
        }
        float rli[16]; row_inv_l(l, rli, wsf, r32, hi);
        LAS bf16* st = (LAS bf16*)stg; bf16* Yw = ymem + (rowb + qw0) * YP + h * 128;
#pragma unroll
        for (int g = 0; g < 4; ++g) {
#pragma unroll
            for (int i = 0; i < 4; ++i)
#pragma unroll
                for (int db = 0; db < 4; ++db) st[(4 * hi + i) * 128 + db * 32 + r32] = (bf16)f2bf(o[db][4 * g + i] * rli[4 * g + i]);
            LDS_WAIT();
#pragma unroll
            for (int i = 0; i < 2; ++i) { const int idx = i * 64 + lane, row = idx >> 4, ch = idx & 15;
                const v4u v = *(const LAS v4u*)(stg + row * 256 + ch * 16); *(v4u*)(Yw + (size_t)(8 * g + row) * YP + ch * 8) = v; }
            LDS_WAIT();
        }
    }
    lds_bar();
}
}

#define PH_LOCALS() KArgs ka = ka_opaque(); unsigned char* ws = ka->ws; const int tid = tid_opaque(), lane = tid & 63, wave = __builtin_amdgcn_readfirstlane(tid >> 6); \
    const int G = gridDim.x, bx = blockIdx.x, vcu = (G % 8 == 0) ? (bx % 8) * (G / 8) + bx / 8 : bx, gw = vcu * NWAVES + wave, NGW = G * NWAVES; \
    (void)ws; (void)lane; (void)wave; (void)gw; (void)NGW; (void)vcu; (void)bx
__global__ void __launch_bounds__(NWAVES * 64, 2) mk_fwd(Args args) {
    extern __shared__ __attribute__((aligned(16))) unsigned char lds_raw[];
    LAS unsigned char* lds = (LAS unsigned char*)lds_raw;
    volatile LAS unsigned* LW = (volatile LAS unsigned*)(lds + LDSCTL_OFF);
    for (int u = threadIdx.x; u < (LDS_BYTES - LDSCTL_OFF) / 4; u += NWAVES * 64) ((LAS unsigned*)(lds + LDSCTL_OFF))[u] = 0u;
    __syncthreads();
#if MK_ONE_LAUNCH
    XcdBarrier bar = xcd_barrier_post((unsigned*)((gu32*)(args.ws + WS_CTL) + CW_BAR), LW + LW_BAR);
#define GRID_BAR() xcd_barrier(bar)
#else
#define GRID_BAR() do {} while (0)
#endif
    const int lo = args.ph_lo, hi = args.ph_hi;
#define IN(k) (lo <= (k) && (k) < hi)
#define BOTH(k) (IN(k) && IN((k) + 1))

    if (PH_EN(0) && IN(0)) REP(0) {
        PH_LOCALS();
        LAS float* scr = (LAS float*)(lds + RING_OFF + wave * 16384);
        constexpr int I_IN = 16 * (INW / 32), I_SQ = 16 * 32, I_BR = 8 * 32, I_GU = 16 * 64, I_D = 16 * 32;
        constexpr int PER_LAYER = I_IN + I_SQ + 3 * I_BR + I_SQ + NE * I_GU + NE * I_D;
        constexpr int S_IN = I8_P1 ? INW / 32 : 0, S_GU = I8_P6 ? NE * (2 * DFF / 32) : 0, SPL = S_IN + S_GU, NS = DEPTH * SPL;
#pragma unroll 1
        for (int st = vcu; st < NS; st += G) {
            const int l = st / SPL; int r = st % SPL;
            LAS float* pmax = (LAS float*)(lds + LDSCTL_OFF) + LW_RSLOT;
            if (r < S_IN) { p0_quant_strip_wg(ka->in[2] + (size_t)l * D * INW, INW, (signed char*)(ws + WS_WIN) + (size_t)l * INW * D, (float*)(ws + WS_SWIN) + (size_t)l * INW, 32 * r, 32 * r, (LAS float*)(lds + RING_OFF), pmax, wave, lane); continue; }
            r -= S_IN;
            { const int e = r / (2 * DFF / 32), n0 = 32 * (r % (2 * DFF / 32)); const int cc = (n0 >= DFF) ? n0 - DFF : n0, drow0 = (cc >> 7) * 256 + (n0 >= DFF ? 128 : 0) + (cc & 127);
              p0_quant_strip_wg(ka->in[14] + ((size_t)l * NE + e) * D * 2 * DFF, 2 * DFF, (signed char*)(ws + WS_WGU) + ((size_t)l * NE + e) * 2 * DFF * D, (float*)(ws + WS_SWGU) + ((size_t)l * NE + e) * 2 * DFF, drow0, n0, (LAS float*)(lds + RING_OFF), pmax, wave, lane); }
        }
#pragma unroll 1
        for (int it = gw; it < DEPTH * PER_LAYER; it += NGW) {
            const int l = it / PER_LAYER; int r = it % PER_LAYER;
            if (r < I_IN) { if (!I8_P1) p0_matrix(r, ka->in[2] + (size_t)l * D * INW, D, INW, (bf16*)(ws + WS_WIN) + (size_t)l * INW * D, false, scr, lane); continue; }
            r -= I_IN;
            if (p0_matrix(r, ka->in[7] + (size_t)l * D * 1024, D, 1024, (bf16*)(ws + WS_WMEMKV) + (size_t)l * 1024 * D, false, scr, lane)) continue;
            if (r < 3 * I_BR) { const int b = r / I_BR; int rr = r % I_BR;
                p0_matrix(rr, ka->in[8] + ((size_t)l * 3 + b) * W * D, W, D, (bf16*)(ws + WS_WBR) + (size_t)l * D * 3 * W, false, scr, lane, 3 * W, b * W); continue; }
            r -= 3 * I_BR;
            if (p0_matrix(r, ka->in[9] + (size_t)l * D * D, D, D, (bf16*)(ws + WS_WOUT) + (size_t)l * D * D, false, scr, lane)) continue;
            if (r < NE * I_GU) { if (!I8_P6) { const int e = r / I_GU; int rr = r % I_GU;
                p0_matrix(rr, ka->in[14] + ((size_t)l * NE + e) * D * 2 * DFF, D, 2 * DFF, (bf16*)(ws + WS_WGU) + ((size_t)l * NE + e) * 2 * DFF * D, true, scr, lane); } continue; }
            r -= NE * I_GU;
            { const int e = r / I_D; int rr = r % I_D;
                p0_matrix(rr, ka->in[16] + ((size_t)l * NE + e) * DFF * D, DFF, D, (bf16*)(ws + WS_WD) + ((size_t)l * NE + e) * D * DFF, false, scr, lane); }
        }
        { const float* x_in = ka->in[0]; bf16* XN = (bf16*)(ws + WS_XN); signed char* XQ = (signed char*)(ws + WS_XQ); float* SX = (float*)(ws + WS_SX);
#pragma unroll 1
          for (int m = gw; m < T; m += 2 * NGW) {
              const int mb = (m + NGW < T) ? m + NGW : m;
              if (!(I8_P1 && I8_P6)) { row_to_bf16(x_in + (size_t)m * D, XN + (size_t)m * D, lane); row_to_bf16(x_in + (size_t)mb * D, XN + (size_t)mb * D, lane); }
              if (I8_P1 || I8_P6) { f32x4 v[4], w[4];
#pragma unroll
                  for (int j = 0; j < 4; ++j) { v[j] = ((const GAS f32x4*)(x_in + (size_t)m * D) + lane)[64 * j]; w[j] = ((const GAS f32x4*)(x_in + (size_t)mb * D) + lane)[64 * j]; }
                  quant_row(v, XQ + (size_t)m * D, SX + m, lane); quant_row(w, XQ + (size_t)mb * D, SX + mb, lane); } } }
        { const float* mem_in = ka->in[1]; bf16* MEMB = (bf16*)(ws + WS_MEMB);
#pragma unroll 1
          for (int m = gw; m < MEMT; m += NGW) row_to_bf16(mem_in + (size_t)m * D, MEMB + (size_t)m * D, lane); }
        if (BOTH(0)) GRID_BAR();
    }

#pragma unroll 1
    for (int l = 0; l < DEPTH; ++l) {
        const int pb = 1 + 8 * l;
        if (PH_EN(1) && IN(pb + 0)) REP(1) {
            { PH_LOCALS();
#if I8_P1
              pg8::DenseOrder S{(const char*)(ws + WS_XQ), (const char*)(ws + WS_WIN) + (size_t)l * INW * D, T / 256, INW / 256, G, bx, D / 2};
              pg8::EpiProjQ E{(bf16*)(ws + WS_PROJ), PP, ka->in[3] + (size_t)l * 3 * D, GATE0, GATE0, (unsigned char*)(ws + WS_G8), (const float*)(ws + WS_SX), (const float*)(ws + WS_SWIN) + (size_t)l * INW};
              pg8::gemm_phase<pg8::EpiProjQ, pg8::DenseOrder, false, true, true>(lds + RING_OFF, D / 2, S, E, (unsigned*)(ws + WS_DUMP)); }
#else
              pg8::DenseOrder S{(const char*)(ws + WS_XN), (const char*)((bf16*)(ws + WS_WIN) + (size_t)l * INW * D), T / 256, INW / 256, G, bx, D};
              pg8::EpiProj E{(bf16*)(ws + WS_PROJ), PP, ka->in[3] + (size_t)l * 3 * D, GATE0, GATE0, (unsigned char*)(ws + WS_G8), nullptr, nullptr};
              pg8::gemm_phase<pg8::EpiProj, pg8::DenseOrder, false, true>(lds + RING_OFF, D, S, E, (unsigned*)(ws + WS_DUMP)); }
#endif
            if (l == 0) { PH_LOCALS();
              pg8::DenseOrder S{(const char*)(ws + WS_MEMB), (const char*)(ws + WS_WMEMKV), MEMT / 256, 2048 / 256, G, bx, D};
              pg8::EpiProj E{(bf16*)(ws + WS_MEMKV2), 2048, nullptr, 1 << 30, 0, nullptr, nullptr, nullptr};
              pg8::gemm_phase<pg8::EpiProj, pg8::DenseOrder, false, true>(lds + RING_OFF, D, S, E, (unsigned*)(ws + WS_DUMP)); }
            if (BOTH(pb + 0)) GRID_BAR();
        }
        if (PH_EN(2) && IN(pb + 1)) REP(2) {
            PH_LOCALS();
            const bf16* PROJ = (const bf16*)(ws + WS_PROJ); bf16* YB = (bf16*)(ws + WS_Y);
            { LAS float* tab = (LAS float*)(lds + LDSCTL_OFF) + att::LW_TAB; const float* rel_bias = ka->in[6];
              for (int i = tid; i < 8 * 256; i += NWAVES * 64) tab[i] = rel_bias[t5_bucket((i & 255) - 192) * 8 + (i >> 8)] * att::LOG2E; }
            float lam, outscale;
            { const float* dl = ka->in[4] + (size_t)l * 256; float s1 = 0.f, s2 = 0.f;
              for (int i = 0; i < 64; ++i) { s1 += dl[i] * dl[64 + i]; s2 += dl[128 + i] * dl[192 + i]; }
              const float lam_init = 0.8f - 0.6f * expf(-0.3f * (float)l); lam = expf(s1) - expf(s2) + lam_init; outscale = 1.0f - lam_init; }
            __syncthreads();
            const float* subg = ka->in[5] + (size_t)l * 128;
#pragma unroll 1
            REP(9) for (int it = vcu; ATT_EN(0) && it < BATCH * 4 * 8; it += G) { const int bH = it >> 3, s8 = it & 7;
#pragma unroll 1
                for (int z = 0; z < 2; ++z) att::df_unit(lds, LW, PROJ, YB + W, subg, lam, outscale, bH >> 2, bH & 3, z ? s8 : 15 - s8, wave, lane); }
#pragma unroll 1
            REP(10) for (int u = vcu; ATT_EN(1) && u < BATCH * 8 * 16; u += G) { const int bh = u >> 4, un = u + G, nbh = un >> 4; const bool hn = un < BATCH * 8 * 16;
                att::sb_unit(lds, LW, PROJ, YB, bh >> 3, bh & 7, u & 15, u != vcu, nbh >> 3, nbh & 7, hn ? (un & 15) : -1); }
#pragma unroll 1
            REP(11) for (int u = vcu; ATT_EN(2) && u < BATCH * 4 * 4; u += G) { const int bh = u >> 2; att::mem_unit(lds, LW, PROJ, (const bf16*)(ws + WS_MEMKV2) + l * 1024, YB + 2 * W, bh >> 2, bh & 3, u & 3, wave, lane); }
            if (BOTH(pb + 1)) GRID_BAR();
        }
        if (PH_EN(3) && IN(pb + 2)) REP(3) {
            PH_LOCALS();
            pg8::EpiBranch E{(const unsigned char*)(ws + WS_G8), (bf16*)(ws + WS_MERGED)};
            { pg8::PanelOrder S{(const char*)(ws + WS_Y), (const char*)((bf16*)(ws + WS_WBR) + (size_t)l * D * 3 * W), T / 256, D / 256, G, bx, vcu, 3 * W, false};
              pg8::gemm_phase<pg8::EpiBranch, pg8::PanelOrder, false, true>(lds + RING_OFF, 3 * W, S, E, (unsigned*)(ws + WS_DUMP)); }
            if (BOTH(pb + 2)) GRID_BAR();
        }
        if (PH_EN(4) && IN(pb + 3)) REP(4) {
            PH_LOCALS();
            const float* xprev = (l == 0) ? ka->in[0] : ka->out;
            pg8::EpiOut E{xprev, (float*)(ws + WS_X1)};
            { pg8::PanelOrder S{(const char*)(ws + WS_MERGED), (const char*)((bf16*)(ws + WS_WOUT) + (size_t)l * D * D), T / 256, D / 256, G, bx, vcu, D, false};
              pg8::gemm_phase<pg8::EpiOut, pg8::PanelOrder, false, true>(lds + RING_OFF, D, S, E, (unsigned*)(ws + WS_DUMP)); }
            if (BOTH(pb + 3)) GRID_BAR();
        }
        if (PH_EN(5) && IN(pb + 4)) {
            PH_LOCALS();
            gu32* ctl = (gu32*)(ws + WS_CTL); float* X1 = (float*)(ws + WS_X1); bf16* XN = (bf16*)(ws + WS_XN); int* PERM = (int*)(ws + WS_PERM); float* SLOTW = (float*)(ws + WS_SLOTW); unsigned* SLOTPOS = (unsigned*)(ws + WS_SLOTPOS); float* STATS = (float*)(ws + WS_STATS); signed char* XQ = (signed char*)(ws + WS_XQ); float* SX = (float*)(ws + WS_SX); float* SXP = (float*)(ws + WS_SXP);
            LAS float* WT = (LAS float*)(lds + RING_OFF);
            const float* rw = ka->in[12] + (size_t)l * D * NE; const float* rb = ka->in[13] + (size_t)l * NE;
            { f32x4 wv[16];
#pragma unroll
              for (int it = 0; it < 16; ++it) wv[it] = *(const f32x4*)(rw + tid * 4 + it * (NWAVES * 64 * 4));
              asm volatile("" :: "v"(wv[0]), "v"(wv[1]), "v"(wv[2]), "v"(wv[3]), "v"(wv[4]), "v"(wv[5]), "v"(wv[6]), "v"(wv[7]), "v"(wv[8]), "v"(wv[9]), "v"(wv[10]), "v"(wv[11]), "v"(wv[12]), "v"(wv[13]), "v"(wv[14]), "v"(wv[15]));
#pragma unroll
              for (int it = 0; it < 16; ++it) { const int i = tid * 4 + it * (NWAVES * 64 * 4), k = i >> 5, e = i & 31;
#pragma unroll
                  for (int c = 0; c < 4; ++c) WT[(e + c) * WT_STRIDE + k] = wv[it][c]; } }
            if (tid < NE) LW[LW_RCNT + tid] = 0u;
            __syncthreads();
            const float* g1 = ka->in[10] + (size_t)l * D; const float* b1 = ka->in[11] + (size_t)l * D;
            f32x4 gv[4], bv[4];
#pragma unroll
            for (int j = 0; j < 4; ++j) { gv[j] = *(const f32x4*)(g1 + 256 * j + 4 * lane); bv[j] = *(const f32x4*)(b1 + 256 * j + 4 * lane); }
            const int rows_per_wg = (T + G - 1) / G, rows_per_wave = (((rows_per_wg + NWAVES - 1) / NWAVES) + 1) & ~1;
            const int rbase = vcu * rows_per_wg + wave * rows_per_wave;
            const int myexp = (lane >> 1) & 31;
            const float myrb = rb[myexp];
#pragma unroll 1
            for (int ri = 0; ri < rows_per_wave; ri += 2) {
                const int m0 = rbase + ri;
                const bool ok0 = (m0 < T) && (wave * rows_per_wave + ri) < rows_per_wg, ok1 = (m0 + 1 < T) && (wave * rows_per_wave + ri + 1) < rows_per_wg;
                if (!ok0) break;
                const int m1 = ok1 ? m0 + 1 : m0;
                GAS f32x4* xr0 = (GAS f32x4*)(X1 + (size_t)m0 * D) + lane; GAS f32x4* xr1 = (GAS f32x4*)(X1 + (size_t)m1 * D) + lane;
                f32x4 v0[4], v1[4]; float s0 = 0.f, s1 = 0.f;
#pragma unroll
                for (int j = 0; j < 4; ++j) { v0[j] = xr0[64 * j]; v1[j] = xr1[64 * j]; }
#pragma unroll
                for (int j = 0; j < 4; ++j) { s0 += (v0[j].x + v0[j].y) + (v0[j].z + v0[j].w); s1 += (v1[j].x + v1[j].y) + (v1[j].z + v1[j].w); }
                const float mean0 = wave_sum(s0) * (1.f / D), mean1 = wave_sum(s1) * (1.f / D); float q0 = 0.f, q1 = 0.f;
#pragma unroll
                for (int j = 0; j < 4; ++j) { v0[j] = v0[j] - mean0; v1[j] = v1[j] - mean1;
                    q0 += (v0[j].x * v0[j].x + v0[j].y * v0[j].y) + (v0[j].z * v0[j].z + v0[j].w * v0[j].w); q1 += (v1[j].x * v1[j].x + v1[j].y * v1[j].y) + (v1[j].z * v1[j].z + v1[j].w * v1[j].w); }
                const float rstd0 = 1.f / sqrtf(wave_sum(q0) * (1.f / D) + LN_EPS), rstd1 = 1.f / sqrtf(wave_sum(q1) * (1.f / D) + LN_EPS);
                GAS unsigned long long* o80 = (GAS unsigned long long*)(XN + (size_t)m0 * D) + lane; GAS unsigned long long* o81 = (GAS unsigned long long*)(XN + (size_t)m1 * D) + lane;
#pragma unroll
                for (int j = 0; j < 4; ++j) { v0[j] = v0[j] * rstd0 * gv[j] + bv[j]; v1[j] = v1[j] * rstd1 * gv[j] + bv[j];
                    if (!I8_P6) { o80[64 * j] = (unsigned long long)pk2(v0[j].x, v0[j].y) | ((unsigned long long)pk2(v0[j].z, v0[j].w) << 32);
                        if (ok1) o81[64 * j] = (unsigned long long)pk2(v1[j].x, v1[j].y) | ((unsigned long long)pk2(v1[j].z, v1[j].w) << 32); } }
                if (I8_P6) { quant_row(v0, XQ + (size_t)m0 * D, SX + m0, lane); quant_row(v1, XQ + (size_t)m1 * D, SX + m1, lane); }
                if (lane == 0) { STATS[2 * (size_t)m0] = mean0; STATS[2 * (size_t)m0 + 1] = rstd0; if (ok1) { STATS[2 * (size_t)m1] = mean1; STATS[2 * (size_t)m1 + 1] = rstd1; } }
                float pa[NE], pb[NE];
                {
#pragma unroll
                  for (int e = 0; e < NE; e += 2) { f32x4 w[2][4];
#pragma unroll
                      for (int u = 0; u < 2; ++u)
#pragma unroll
                          for (int j = 0; j < 4; ++j) w[u][j] = *(const LAS f32x4*)(WT + (e + u) * WT_STRIDE + 256 * j + 4 * lane);
                      f32x2 alo[2][2], ahi[2][2];
#pragma unroll
                      for (int u = 0; u < 2; ++u) {
                          alo[0][u] = (f32x2){v0[0].x, v0[0].y} * (f32x2){w[u][0].x, w[u][0].y}; ahi[0][u] = (f32x2){v0[0].z, v0[0].w} * (f32x2){w[u][0].z, w[u][0].w};
                          alo[1][u] = (f32x2){v1[0].x, v1[0].y} * (f32x2){w[u][0].x, w[u][0].y}; ahi[1][u] = (f32x2){v1[0].z, v1[0].w} * (f32x2){w[u][0].z, w[u][0].w}; }
#pragma unroll
                      for (int j = 1; j < 4; ++j)
#pragma unroll
                          for (int u = 0; u < 2; ++u) {
                              alo[0][u] = (f32x2){v0[j].x, v0[j].y} * (f32x2){w[u][j].x, w[u][j].y} + alo[0][u]; ahi[0][u] = (f32x2){v0[j].z, v0[j].w} * (f32x2){w[u][j].z, w[u][j].w} + ahi[0][u];
                              alo[1][u] = (f32x2){v1[j].x, v1[j].y} * (f32x2){w[u][j].x, w[u][j].y} + alo[1][u]; ahi[1][u] = (f32x2){v1[j].z, v1[j].w} * (f32x2){w[u][j].z, w[u][j].w} + ahi[1][u]; }
#pragma unroll
                      for (int u = 0; u < 2; ++u) { const f32x2 ta = alo[0][u] + ahi[0][u], tb = alo[1][u] + ahi[1][u]; pa[e + u] = ta.x + ta.y; pb[e + u] = tb.x + tb.y; } } }
#define RT_SWAP(P, n, SW) _Pragma("unroll") for (int e = 0; e < n; ++e) { auto rr = SW(__float_as_uint(P[e]), __float_as_uint(P[e + n]), false, false); P[e] = __uint_as_float(rr[0]) + __uint_as_float(rr[1]); }
                RT_SWAP(pa, 16, __builtin_amdgcn_permlane32_swap) RT_SWAP(pb, 16, __builtin_amdgcn_permlane32_swap)
                RT_SWAP(pa, 8, __builtin_amdgcn_permlane16_swap) RT_SWAP(pb, 8, __builtin_amdgcn_permlane16_swap)
#undef RT_SWAP
#pragma unroll
                for (int e = 0; e < 4; ++e) { const bool up = (lane & 8) != 0; const float ka_ = up ? pa[e + 4] : pa[e], sa_ = up ? pa[e] : pa[e + 4], kb_ = up ? pb[e + 4] : pb[e], sb_ = up ? pb[e] : pb[e + 4];
                    pa[e] = ka_ + dppf<0x128>(sa_); pb[e] = kb_ + dppf<0x128>(sb_); }
#pragma unroll
                for (int e = 0; e < 2; ++e) { const bool up = (lane & 4) != 0; const float ka_ = up ? pa[e + 2] : pa[e], sa_ = up ? pa[e] : pa[e + 2], kb_ = up ? pb[e + 2] : pb[e], sb_ = up ? pb[e] : pb[e + 2];
                    pa[e] = ka_ + __shfl_xor(sa_, 4); pb[e] = kb_ + __shfl_xor(sb_, 4); }
                { const bool up = (lane & 2) != 0; const float ka_ = up ? pa[1] : pa[0], sa_ = up ? pa[0] : pa[1], kb_ = up ? pb[1] : pb[0], sb_ = up ? pb[0] : pb[1];
                    pa[0] = ka_ + dppf<0x4E>(sa_); pb[0] = kb_ + dppf<0x4E>(sb_); }
                const float la = pa[0] + dppf<0xB1>(pa[0]) + myrb, lb = pb[0] + dppf<0xB1>(pb[0]) + myrb;
                float tva[TOPK], tvb[TOPK]; int tea[TOPK], teb[TOPK];
                { float ca = la, cb = lb;
#pragma unroll
                  for (int k = 0; k < TOPK; ++k) {
                      const float mxa = wave_max(ca), mxb = wave_max(cb);
                      const unsigned long long ma = __ballot(ca == mxa), mb = __ballot(cb == mxb);
                      const int lna = ma ? (int)__builtin_ctzll(ma) : 0, lnb = mb ? (int)__builtin_ctzll(mb) : 0;
                      tea[k] = lna >> 1; teb[k] = lnb >> 1; tva[k] = mxa; tvb[k] = mxb;
                      ca = (myexp == tea[k]) ? -INFINITY : ca; cb = (myexp == teb[k]) ? -INFINITY : cb; } }
                float ewa[TOPK], ewb[TOPK], esa = 0.f, esb = 0.f;
#pragma unroll
                for (int k = 0; k < TOPK; ++k) { ewa[k] = fast_exp(tva[k] - tva[0]); esa += ewa[k]; ewb[k] = fast_exp(tvb[k] - tvb[0]); esb += ewb[k]; }
                const float inva = 1.0f / esa, invb = 1.0f / esb;
                if (lane < 2 * TOPK && (lane < TOPK || ok1)) {
                    const int kk = lane & 3; const bool second = lane >= TOPK;
                    const int ek = second ? (kk == 0 ? teb[0] : kk == 1 ? teb[1] : kk == 2 ? teb[2] : teb[3]) : (kk == 0 ? tea[0] : kk == 1 ? tea[1] : kk == 2 ? tea[2] : tea[3]);
                    const float wk = second ? (kk == 0 ? ewb[0] : kk == 1 ? ewb[1] : kk == 2 ? ewb[2] : ewb[3]) * invb : (kk == 0 ? ewa[0] : kk == 1 ? ewa[1] : kk == 2 ? ewa[2] : ewa[3]) * inva;
                    const unsigned lr = __hip_atomic_fetch_add((LAS unsigned*)(LW + LW_RCNT + ek), 1u, __ATOMIC_RELAXED, __HIP_MEMORY_SCOPE_WORKGROUP);
                    LW[LW_RSLOT + wave * RSLOT_STRIDE + ri * 4 + lane] = ((unsigned)ek << 16) | lr;
                    SLOTW[(size_t)m0 * 4 + lane] = wk;
                }
            }
            __syncthreads();
            if (tid < NE) { const unsigned c = LW[LW_RCNT + tid]; LW[LW_RBASE + tid] = c ? __hip_atomic_fetch_add(ctl + CW_CNT + (l * NE + tid) * 64, c, RLX_AGENT) : 0u; }
            __syncthreads();
            for (int q = lane; q < rows_per_wave * 4; q += 64) { const int ri = q >> 2, m = rbase + ri;
                if (m < T && (wave * rows_per_wave + ri) < rows_per_wg) { const unsigned ent = LW[LW_RSLOT + wave * RSLOT_STRIDE + q]; const unsigned e = ent >> 16, lr = ent & 0xffffu;
                    const unsigned rk = LW[LW_RBASE + e] + lr; PERM[(size_t)e * T + rk] = m * 4 + (q & 3); SLOTPOS[(size_t)m * 4 + (q & 3)] = (e << 16) | rk;
                    if (I8_P6) SXP[(size_t)e * T + rk] = SX[m]; } }
            if (BOTH(pb + 4)) GRID_BAR();
        }
        if ((PH_EN(6) && IN(pb + 5)) || (PH_EN(7) && IN(pb + 6)) || (PH_EN(8) && IN(pb + 7))) {
            PH_LOCALS();
            gu32* ctl = (gu32*)(ws + WS_CTL);
            __syncthreads();
            if (tid < 64) {
                const int c = (tid < NE) ? (int)__hip_atomic_load(ctl + CW_CNT + (l * NE + tid) * 64, RLX_AGENT) : 0;
                int tl = (c + 255) >> 8, inc = tl;
#pragma unroll
                for (int o_ = 1; o_ < 32; o_ <<= 1) { const int nb = __shfl_up(inc, o_); if ((tid & 31) >= o_) inc += nb; }
                if (tid < NE) { LW[LW_LCNT + tid] = (unsigned)c; LW[LW_TOFF + tid] = (unsigned)(inc - tl); if (tid == NE - 1) LW[LW_TOFF + NE] = (unsigned)inc; }
            }
            __syncthreads();
        }
        if (PH_EN(6) && IN(pb + 5)) REP(6) {
            PH_LOCALS();
            const LAS int* toff = (const LAS int*)(lds + LDSCTL_OFF) + LW_TOFF; const LAS int* lcnt = (const LAS int*)(lds + LDSCTL_OFF) + LW_LCNT;
#if I8_P6
            pg8::MoeOrder S{(const char*)(ws + WS_XQ), (const char*)(ws + WS_WGU) + (size_t)l * NE * 2 * DFF * D, 2 * DFF / 256, __builtin_amdgcn_readfirstlane(toff[NE]), G, bx, D / 2, (size_t)2 * DFF * D, toff, lcnt, (const int*)(ws + WS_PERM)};
            pg8::EpiGateUpQ E{(bf16*)(ws + WS_ACT), ka->in[15] + (size_t)l * NE * 2 * DFF, (const float*)(ws + WS_SXP), (const float*)(ws + WS_SWGU) + (size_t)l * NE * 2 * DFF};
            pg8::gemm_phase<pg8::EpiGateUpQ, pg8::MoeOrder, true, true, true>(lds + RING_OFF, D / 2, S, E, (unsigned*)(ws + WS_DUMP));
#else
            pg8::MoeOrder S{(const char*)(ws + WS_XN), (const char*)((bf16*)(ws + WS_WGU) + (size_t)l * NE * 2 * DFF * D), 2 * DFF / 256, __builtin_amdgcn_readfirstlane(toff[NE]), G, bx, D, (size_t)2 * DFF * D * 2, toff, lcnt, (const int*)(ws + WS_PERM)};
            pg8::EpiGateUp E{(bf16*)(ws + WS_ACT), ka->in[15] + (size_t)l * NE * 2 * DFF, nullptr, nullptr};
            pg8::gemm_phase<pg8::EpiGateUp, pg8::MoeOrder, true, true>(lds + RING_OFF, D, S, E, (unsigned*)(ws + WS_DUMP));
#endif
            if (BOTH(pb + 5)) GRID_BAR();
        }
        if (PH_EN(7) && IN(pb + 6)) REP(7) {
            PH_LOCALS();
            const LAS int* toff = (const LAS int*)(lds + LDSCTL_OFF) + LW_TOFF; const LAS int* lcnt = (const LAS int*)(lds + LDSCTL_OFF) + LW_LCNT;
            pg8::MoeDenseOrder S{{(const char*)(ws + WS_ACT), (const char*)((bf16*)(ws + WS_WD) + (size_t)l * NE * D * DFF), D / 256, __builtin_amdgcn_readfirstlane(toff[NE]), G, bx, DFF, (size_t)D * DFF * 2, toff, lcnt, (const int*)(ws + WS_PERM)}};
            pg8::EpiDown E{(bf16*)(ws + WS_CONTRIB), ka->in[17] + (size_t)l * NE * D};
            pg8::gemm_phase<pg8::EpiDown, pg8::MoeDenseOrder, false, true>(lds + RING_OFF, DFF, S, E, (unsigned*)(ws + WS_DUMP));
            if (BOTH(pb + 6)) GRID_BAR();
        }
        if (PH_EN(8) && IN(pb + 7)) REP(8) {
            PH_LOCALS();
            const float* X1 = (const float*)(ws + WS_X1); bf16* XN = (bf16*)(ws + WS_XN); const bf16* CONTRIB = (const bf16*)(ws + WS_CONTRIB); float* outp = ka->out; const unsigned* SLOTPOS = (const unsigned*)(ws + WS_SLOTPOS); const float* SLOTW = (const float*)(ws + WS_SLOTW);
            const float* g2 = ka->in[18] + (size_t)l * D; const float* b2 = ka->in[19] + (size_t)l * D; const float* g1 = ka->in[10] + (size_t)l * D; const float* b1 = ka->in[11] + (size_t)l * D;
            const float* STATS = (const float*)(ws + WS_STATS);
            f32x4 gv[4], bv[4], g1v[4], b1v[4];
#pragma unroll
            for (int j = 0; j < 4; ++j) { gv[j] = *(const f32x4*)(g2 + 256 * j + 4 * lane); bv[j] = *(const f32x4*)(b2 + 256 * j + 4 * lane); g1v[j] = *(const f32x4*)(g1 + 256 * j + 4 * lane); b1v[j] = *(const f32x4*)(b1 + 256 * j + 4 * lane); }
#pragma unroll 1
            for (int m = gw; m < T; m += NGW) {
                const GAS f32x4* xr = (const GAS f32x4*)(X1 + (size_t)m * D) + lane;
                f32x4 v[4]; float s = 0.f;
#pragma unroll
                for (int j = 0; j < 4; ++j) v[j] = xr[64 * j];
                { const float mean1 = STATS[2 * (size_t)m], rstd1 = STATS[2 * (size_t)m + 1];
#pragma unroll
                  for (int j = 0; j < 4; ++j) v[j] = (((v[j] - mean1) * rstd1) * g1v[j] + b1v[j]) * DN_ALPHA; }
#pragma unroll
                for (int k = 0; k < TOPK; ++k) { const unsigned sp = SLOTPOS[(size_t)m * 4 + k]; const float cw = SLOTW[(size_t)m * 4 + k];
                    const size_t srow = (size_t)LW[LW_TOFF + (sp >> 16)] * 256 + (sp & 0xffffu);
                    const GAS v2u* cr = (const GAS v2u*)(CONTRIB + srow * D) + lane;
#pragma unroll
                    for (int j = 0; j < 4; ++j) { const v2u c = cr[64 * j]; v[j].x += cw * bflo(c.x); v[j].y += cw * bfhi(c.x); v[j].z += cw * bflo(c.y); v[j].w += cw * bfhi(c.y); } }
#pragma unroll
                for (int j = 0; j < 4; ++j) s += (v[j].x + v[j].y) + (v[j].z + v[j].w);
                const float mean = wave_sum(s) * (1.f / D); float s2 = 0.f;
#pragma unroll
                for (int j = 0; j < 4; ++j) { v[j] = v[j] - mean; s2 += (v[j].x * v[j].x + v[j].y * v[j].y) + (v[j].z * v[j].z + v[j].w * v[j].w); }
                const float rstd = 1.f / sqrtf(wave_sum(s2) * (1.f / D) + LN_EPS);
                GAS f32x4* orow = (GAS f32x4*)(outp + (size_t)m * D) + lane;
                GAS unsigned long long* o8 = (GAS unsigned long long*)(XN + (size_t)m * D) + lane;
#pragma unroll
                for (int j = 0; j < 4; ++j) { v[j] = v[j] * rstd * gv[j] + bv[j]; orow[64 * j] = v[j];
                    if (l + 1 < DEPTH && !I8_P1) o8[64 * j] = (unsigned long long)pk2(v[j].x, v[j].y) | ((unsigned long long)pk2(v[j].z, v[j].w) << 32); }
                if (l + 1 < DEPTH && I8_P1) quant_row(v, (signed char*)(ws + WS_XQ) + (size_t)m * D, (float*)(ws + WS_SX) + m, lane);
            }
            if (BOTH(pb + 7)) GRID_BAR();
        }
    }
#undef IN
#undef BOTH
}

extern "C" void kernel_launch(void* const* d_in, const int* in_sizes, int n_in, void* d_out, int out_size, void* d_ws, size_t ws_size, hipStream_t stream) {
    static int grid = 0;
    if (grid == 0) {
        if (n_in != 20 || in_sizes[0] != T * D || out_size != T * D || ws_size < WS_END) { fprintf(stderr, "kernel_launch: unexpected shapes / workspace (n_in %d, ws %zu, need %zu)\n", n_in, ws_size, (size_t)WS_END); grid = -1; return; }
        int dev = 0, cus = 0, per_cu = 0;
        if (hipGetDevice(&dev) != hipSuccess || hipDeviceGetAttribute(&cus, hipDeviceAttributeMultiprocessorCount, dev) != hipSuccess) { grid = -1; return; }
        if (hipFuncSetAttribute((const void*)mk_fwd, hipFuncAttributeMaxDynamicSharedMemorySize, LDS_BYTES) != hipSuccess) { fprintf(stderr, "kernel_launch: hipFuncSetAttribute failed\n"); grid = -1; return; }
        if (hipOccupancyMaxActiveBlocksPerMultiprocessor(&per_cu, (const void*)mk_fwd, NWAVES * 64, LDS_BYTES) != hipSuccess || per_cu < 1) fprintf(stderr, "kernel_launch: occupancy query reports %d\n", per_cu);
        (void)hipGetLastError();
        grid = cus;
    }
    if (grid < 0) return;
    (void)hipMemsetAsync((char*)d_ws + WS_CTL, 0, CTL_ZERO_BYTES, stream);
    Args a{};
    for (int i = 0; i < 20; ++i) a.in[i] = (const float*)d_in[i];
    a.out = (float*)d_out; a.ws = (unsigned char*)d_ws;
#if MK_ONE_LAUNCH
    a.ph_lo = 0; a.ph_hi = 1 + 8 * DEPTH;
    hipLaunchKernelGGL(mk_fwd, dim3(grid), dim3(NWAVES * 64), LDS_BYTES, stream, a);
#else
    for (int ph = 0; ph < 1 + 8 * DEPTH; ++ph) {
        a.ph_lo = ph; a.ph_hi = ph + 1;
        hipLaunchKernelGGL(mk_fwd, dim3(grid), dim3(NWAVES * 64), LDS_BYTES, stream, a);
    }
#endif
}
```
